# Optimizing an MI355X kernel written in HIP

```python
import jax
import jax.numpy as jnp
from jax import lax
import numpy as np

D_MODEL = 1024
BATCH = 8
SEQ = 4096
DEPTH = 2

N_EVEN = (DEPTH + 1) // 2
N_ODD = DEPTH // 2
ROPE_THETA = 10000.0
RMS_EPS = 1e-6
NEG_INF = -1e30
FORCE_SCORE = 1e4

NSA_HEADS = 8
NSA_KV_GROUPS = 2
NSA_HPG = NSA_HEADS // NSA_KV_GROUPS
NSA_HEAD_DIM = 64
NSA_WIDTH = NSA_HEADS * NSA_HEAD_DIM
NSA_KV_WIDTH = NSA_KV_GROUPS * NSA_HEAD_DIM
CMP_BLOCK = 32
CMP_STRIDE = 16
CMP_HIDDEN = 2 * NSA_HEAD_DIM
SLC_BLOCK = 64
SLC_TOPK = 16
WINDOW = 512
NSA_QBLOCK = 64

CONV_WIDTH = D_MODEL - NSA_WIDTH
CONV_K = 3

IN_A_SIZES = (NSA_WIDTH, NSA_KV_WIDTH, NSA_KV_WIDTH, NSA_KV_WIDTH, NSA_KV_WIDTH, NSA_KV_WIDTH, NSA_KV_WIDTH,
              3 * NSA_HEADS, NSA_WIDTH, CONV_WIDTH, CONV_WIDTH, CONV_WIDTH, CONV_WIDTH)
IN_A_WIDTH = 2 * NSA_WIDTH + 6 * NSA_KV_WIDTH + 3 * NSA_HEADS + 4 * CONV_WIDTH

MLA_HEADS = 8
MLA_NOPE_DIM = 128
MLA_ROPE_DIM = 64
MLA_V_DIM = 128
MLA_Q_RANK = 256
MLA_KV_RANK = 256
MLA_WIDTH = MLA_HEADS * MLA_V_DIM
MLA_QBLOCK = 128
IN_C_SIZES = (MLA_Q_RANK, MLA_KV_RANK, MLA_ROPE_DIM, MLA_WIDTH)
IN_C_WIDTH = MLA_Q_RANK + MLA_KV_RANK + MLA_ROPE_DIM + MLA_WIDTH

kernel_name = 'hybrid_nsa_shortconv_mla'


def _split(t, sizes):
    return jnp.split(t, np.cumsum(sizes)[:-1].tolist(), axis=-1)


def rms_norm(x, g):
    xf = x.astype(jnp.float32)
    y = xf * lax.rsqrt(jnp.mean(xf * xf, axis=-1, keepdims=True) + RMS_EPS)
    return (y * g.astype(jnp.float32)).astype(x.dtype)


def rope(x, pos):
    half = x.shape[-1] // 2
    inv_freq = ROPE_THETA ** (-jnp.arange(half, dtype=jnp.float32) / half)
    ang = pos.astype(jnp.float32)[..., None] * inv_freq
    cos = jnp.cos(ang)[:, :, None, :]
    sin = jnp.sin(ang)[:, :, None, :]
    x1 = x[..., :half].astype(jnp.float32)
    x2 = x[..., half:].astype(jnp.float32)
    out = jnp.concatenate([x1 * cos - x2 * sin, x2 * cos + x1 * sin], axis=-1)
    return out.astype(x.dtype)


def masked_softmax(s, valid):
    s = jnp.where(valid, s.astype(jnp.float32), NEG_INF)
    return jnp.where(valid, jax.nn.softmax(s, axis=-1), 0.0)


def nsa_attention(q, k_cmp_raw, v_cmp_raw, k_slc, v_slc, k_win, v_win, gates, positions,
                  pe_k, pe_v, w_ck1, w_ck2, w_cv1, w_cv2):
    B, S = q.shape[:2]
    G, HPG, hd, QB = NSA_KV_GROUPS, NSA_HPG, NSA_HEAD_DIM, NSA_QBLOCK
    scale = hd ** -0.5
    q = rope(q, positions).reshape(B, S, G, HPG, hd)
    k_slc = rope(k_slc, positions)
    k_win = rope(k_win, positions)

    n_cmp = (S - CMP_BLOCK) // CMP_STRIDE + 1
    cmp_starts = jnp.arange(n_cmp) * CMP_STRIDE
    cmp_idx = cmp_starts[:, None] + jnp.arange(CMP_BLOCK)[None, :]
    cmp_ends = cmp_starts + CMP_BLOCK - 1

    def compress(raw, pe, w1, w2):
        blk = raw[:, cmp_idx] + pe[None, None, :, None, :]
        blk = blk.transpose(0, 1, 3, 2, 4).reshape(B, n_cmp, G, CMP_BLOCK * hd)
        return jax.nn.silu(blk @ w1) @ w2

    k_cmp = rope(compress(k_cmp_raw, pe_k, w_ck1, w_ck2), positions[:, cmp_ends])
    v_cmp = compress(v_cmp_raw, pe_v, w_cv1, w_cv2)

    n_slc = S // SLC_BLOCK
    n_top = min(SLC_TOPK, n_slc)
    slc_starts = jnp.arange(n_slc) * SLC_BLOCK
    overlap = ((cmp_starts[:, None] < slc_starts[None, :] + SLC_BLOCK) &
               (cmp_starts[:, None] + CMP_BLOCK > slc_starts[None, :])).astype(jnp.float32)
    k_blocks = k_slc.reshape(B, n_slc, SLC_BLOCK, G, hd).transpose(0, 3, 1, 2, 4)
    v_blocks = v_slc.reshape(B, n_slc, SLC_BLOCK, G, hd).transpose(0, 3, 1, 2, 4)

    k_pad = jnp.pad(k_win, ((0, 0), (WINDOW, 0), (0, 0), (0, 0)))
    v_pad = jnp.pad(v_win, ((0, 0), (WINDOW, 0), (0, 0), (0, 0)))

    gates = gates.reshape(B, S, G, HPG, 3)
    bi = jnp.arange(B)[:, None, None, None]
    gi = jnp.arange(G)[None, :, None, None]
    blk_id = jnp.arange(n_slc)[None, :]

    def block(qi):
        t0 = qi * QB
        tq = t0 + jnp.arange(QB)
        qb = lax.dynamic_slice_in_dim(q, t0, QB, axis=1)
        gb = lax.dynamic_slice_in_dim(gates, t0, QB, axis=1)

        s_c = jnp.einsum('bqghd,bcgd->bghqc', qb, k_cmp) * scale
        p_c = masked_softmax(s_c, cmp_ends[None, :] <= tq[:, None])
        o_c = jnp.einsum('bghqc,bcgd->bqghd', p_c.astype(v_cmp.dtype), v_cmp)

        imp = jnp.einsum('bghqc,cn->bgqn', p_c, overlap)
        blk_valid = slc_starts[None, :] <= tq[:, None]
        cur = (tq // SLC_BLOCK)[:, None]
        forced = (blk_id == 0) | (blk_id == cur) | (blk_id == cur - 1)
        imp = jnp.where(blk_valid, jnp.where(forced, FORCE_SCORE, imp), -1.0)
        sel = lax.top_k(imp, n_top)[1]
        ks = k_blocks[bi, gi, sel]
        vs = v_blocks[bi, gi, sel]
        tok = sel[..., None] * SLC_BLOCK + jnp.arange(SLC_BLOCK)
        valid_s = (tok <= tq[None, None, :, None, None]).reshape(B, G, 1, QB, n_top * SLC_BLOCK)
        s_s = jnp.einsum('bqghd,bgqnld->bghqnl', qb, ks) * scale
        p_s = masked_softmax(s_s.reshape(B, G, HPG, QB, n_top * SLC_BLOCK), valid_s)
        p_s = p_s.reshape(B, G, HPG, QB, n_top, SLC_BLOCK)
        o_s = jnp.einsum('bghqnl,bgqnld->bqghd', p_s.astype(vs.dtype), vs)

        kw = lax.dynamic_slice_in_dim(k_pad, t0, WINDOW + QB, axis=1)
        vw = lax.dynamic_slice_in_dim(v_pad, t0, WINDOW + QB, axis=1)
        kpos = t0 - WINDOW + jnp.arange(WINDOW + QB)
        valid_w = ((kpos[None, :] <= tq[:, None]) & (kpos[None, :] > tq[:, None] - WINDOW) &
                   (kpos[None, :] >= 0))
        s_w = jnp.einsum('bqghd,bkgd->bghqk', qb, kw) * scale
        p_w = masked_softmax(s_w, valid_w)
        o_w = jnp.einsum('bghqk,bkgd->bqghd', p_w.astype(vw.dtype), vw)

        o = gb[..., 0:1] * o_c + gb[..., 1:2] * o_s + gb[..., 2:3] * o_w
        return o.reshape(B, QB, G * HPG * hd)

    out = lax.map(block, jnp.arange(S // QB))
    return out.transpose(1, 0, 2, 3).reshape(B, S, NSA_WIDTH)


def short_conv(b_gate, c_gate, h, w):
    S = h.shape[1]
    u = c_gate * h
    up = jnp.pad(u, ((0, 0), (CONV_K - 1, 0), (0, 0)))
    y = sum(w[k] * up[:, k:k + S] for k in range(CONV_K))
    return b_gate * y


def mla_attention(c_q, c_kv, k_rope_raw, positions, q_norm, kv_norm, w_uq, w_ukv):
    B, S = c_q.shape[:2]
    H, QB = MLA_HEADS, MLA_QBLOCK
    q = (rms_norm(c_q, q_norm) @ w_uq).reshape(B, S, H, MLA_NOPE_DIM + MLA_ROPE_DIM)
    q = jnp.concatenate([q[..., :MLA_NOPE_DIM], rope(q[..., MLA_NOPE_DIM:], positions)], axis=-1)
    kv = (rms_norm(c_kv, kv_norm) @ w_ukv).reshape(B, S, H, MLA_NOPE_DIM + MLA_V_DIM)
    k_nope, v = kv[..., :MLA_NOPE_DIM], kv[..., MLA_NOPE_DIM:]
    k_pe = rope(k_rope_raw[:, :, None, :], positions)
    k = jnp.concatenate([k_nope, jnp.broadcast_to(k_pe, (B, S, H, MLA_ROPE_DIM))], axis=-1)
    scale = (MLA_NOPE_DIM + MLA_ROPE_DIM) ** -0.5
    kpos = jnp.arange(S)

    def block(qi):
        t0 = qi * QB
        qb = lax.dynamic_slice_in_dim(q, t0, QB, axis=1)
        s = jnp.einsum('bqhd,bkhd->bhqk', qb, k) * scale
        p = masked_softmax(s, kpos[None, :] <= (t0 + jnp.arange(QB))[:, None])
        return jnp.einsum('bhqk,bkhd->bqhd', p.astype(v.dtype), v).reshape(B, QB, MLA_WIDTH)

    out = lax.map(block, jnp.arange(S // QB))
    return out.transpose(1, 0, 2, 3).reshape(B, S, MLA_WIDTH)


def even_layer(x, positions, norm_g, w_in, pe_k, pe_v, w_ck1, w_ck2, w_cv1, w_cv2, conv_w, w_out):
    B, S = x.shape[:2]
    proj = rms_norm(x, norm_g) @ w_in
    (q, kc, vc, ksl, vsl, kw, vw, gate_logits, gate_a,
     cb, cc, ch, gate_b) = _split(proj, IN_A_SIZES)
    heads = lambda t, n: t.reshape(B, S, n, NSA_HEAD_DIM)
    o_a = nsa_attention(heads(q, NSA_HEADS), heads(kc, NSA_KV_GROUPS), heads(vc, NSA_KV_GROUPS),
                        heads(ksl, NSA_KV_GROUPS), heads(vsl, NSA_KV_GROUPS),
                        heads(kw, NSA_KV_GROUPS), heads(vw, NSA_KV_GROUPS),
                        jax.nn.sigmoid(gate_logits).reshape(B, S, NSA_HEADS, 3), positions,
                        pe_k, pe_v, w_ck1, w_ck2, w_cv1, w_cv2)
    o_b = short_conv(cb, cc, ch, conv_w)
    mixed = jnp.concatenate([jax.nn.silu(gate_a) * o_a, jax.nn.silu(gate_b) * o_b], axis=-1)
    return x + mixed @ w_out


def odd_layer(x, positions, norm_g, w_in, q_norm, kv_norm, w_uq, w_ukv, w_out):
    proj = rms_norm(x, norm_g) @ w_in
    c_q, c_kv, k_rope_raw, gate = _split(proj, IN_C_SIZES)
    o = mla_attention(c_q, c_kv, k_rope_raw, positions, q_norm, kv_norm, w_uq, w_ukv)
    return x + (jax.nn.silu(gate) * o) @ w_out


def _normal(key, shape, scale):
    return jax.random.normal(key, shape, jnp.float32) * scale


def setup_inputs(seed: int = 0) -> dict:
    key = jax.random.key(seed)
    ks = jax.random.split(key, 20)
    hd = NSA_HEAD_DIM
    x = jax.random.normal(ks[0], (BATCH, SEQ, D_MODEL), jnp.float32)
    offset = jax.random.randint(ks[1], (BATCH, 1), 0, 1024, dtype=jnp.int32)
    positions = (offset + jnp.arange(SEQ, dtype=jnp.int32)[None, :]).astype(jnp.int32)
    return {
        'x': x,
        'positions': positions,
        'a_norm': 1.0 + _normal(ks[2], (N_EVEN, D_MODEL), 0.02),
        'a_w_in': _normal(ks[3], (N_EVEN, D_MODEL, IN_A_WIDTH), D_MODEL ** -0.5),
        'a_pe_k': _normal(ks[4], (N_EVEN, CMP_BLOCK, hd), 0.02),
        'a_pe_v': _normal(ks[5], (N_EVEN, CMP_BLOCK, hd), 0.02),
        'a_w_ck1': _normal(ks[6], (N_EVEN, CMP_BLOCK * hd, CMP_HIDDEN), (CMP_BLOCK * hd) ** -0.5),
        'a_w_ck2': _normal(ks[7], (N_EVEN, CMP_HIDDEN, hd), CMP_HIDDEN ** -0.5),
        'a_w_cv1': _normal(ks[8], (N_EVEN, CMP_BLOCK * hd, CMP_HIDDEN), (CMP_BLOCK * hd) ** -0.5),
        'a_w_cv2': _normal(ks[9], (N_EVEN, CMP_HIDDEN, hd), CMP_HIDDEN ** -0.5),
        'a_conv_w': _normal(ks[10], (N_EVEN, CONV_K, CONV_WIDTH), CONV_K ** -0.5),
        'a_w_out': _normal(ks[11], (N_EVEN, NSA_WIDTH + CONV_WIDTH, D_MODEL), (NSA_WIDTH + CONV_WIDTH) ** -0.5),
        'c_norm': 1.0 + _normal(ks[12], (N_ODD, D_MODEL), 0.02),
        'c_w_in': _normal(ks[13], (N_ODD, D_MODEL, IN_C_WIDTH), D_MODEL ** -0.5),
        'c_q_norm': 1.0 + _normal(ks[14], (N_ODD, MLA_Q_RANK), 0.02),
        'c_kv_norm': 1.0 + _normal(ks[15], (N_ODD, MLA_KV_RANK), 0.02),
        'c_w_uq': _normal(ks[16], (N_ODD, MLA_Q_RANK, MLA_HEADS * (MLA_NOPE_DIM + MLA_ROPE_DIM)), MLA_Q_RANK ** -0.5),
        'c_w_ukv': _normal(ks[17], (N_ODD, MLA_KV_RANK, MLA_HEADS * (MLA_NOPE_DIM + MLA_V_DIM)), MLA_KV_RANK ** -0.5),
        'c_w_out': _normal(ks[18], (N_ODD, MLA_WIDTH, D_MODEL), MLA_WIDTH ** -0.5),
        'final_norm': 1.0 + _normal(ks[19], (D_MODEL,), 0.02),
    }


def reference(x, positions, a_norm, a_w_in, a_pe_k, a_pe_v, a_w_ck1, a_w_ck2, a_w_cv1, a_w_cv2,
              a_conv_w, a_w_out, c_norm, c_w_in, c_q_norm, c_kv_norm, c_w_uq, c_w_ukv, c_w_out,
              final_norm):
    for i in range(DEPTH):
        j = i // 2
        if i % 2 == 0:
            x = even_layer(x, positions, a_norm[j], a_w_in[j], a_pe_k[j], a_pe_v[j],
                           a_w_ck1[j], a_w_ck2[j], a_w_cv1[j], a_w_cv2[j], a_conv_w[j], a_w_out[j])
        else:
            x = odd_layer(x, positions, c_norm[j], c_w_in[j], c_q_norm[j], c_kv_norm[j],
                          c_w_uq[j], c_w_ukv[j], c_w_out[j])
    return rms_norm(x, final_norm)
```

```cpp
#include <hip/hip_runtime.h>
#include <cstdio>
#include <cstdint>
#include <cmath>

#ifndef MK_ONE_LAUNCH
#define MK_ONE_LAUNCH 1
#endif

constexpr int BATCH = 8, SEQ = 4096, DM = 1024, M = BATCH * SEQ;
constexpr int NIN_A = 3864, NIN_C = 1600;
constexpr int PA_LD = 4096;
constexpr int PC_LD = 1792;
constexpr int PA_Q = 0, PA_KC = 512, PA_VC = 640, PA_KS = 768, PA_VS = 896, PA_KW = 1024, PA_VW = 1152,
              PA_GA = 1280, PA_CB = 1792, PA_CC = 2304, PA_CH = 2816, PA_GB = 3328, PA_GL = 3840;
constexpr int PC_CQ = 0, PC_CKV = 256, PC_G = 512, PC_KR = 1536;
constexpr float LOG2E = 1.4426950408889634f;
constexpr float QSCALE_A = 0.125f * LOG2E;
constexpr float QSCALE_C = 0.07216878364870323f * LOG2E;
constexpr float RMS_EPS = 1e-6f;

constexpr size_t MiB = 1u << 20;
constexpr size_t WS_CTL = 0, CTL_BYTES = 1 * MiB;
constexpr size_t WS_CS = 1 * MiB;
constexpr size_t WS_KCMP = 9 * MiB;
constexpr size_t WS_VCMP = 9 * MiB + 512 * 1024;
constexpr size_t WS_XN = 48 * MiB;
constexpr size_t WS_PA = 112 * MiB;
constexpr size_t WS_MIX = 368 * MiB;
constexpr size_t WS_PC = 112 * MiB;
constexpr size_t WS_Q1 = 224 * MiB;
constexpr size_t WS_KV1 = 320 * MiB;
constexpr size_t WS_CQN = 448 * MiB;
constexpr size_t WS_CKVN = 464 * MiB;
constexpr size_t WS_KPE = 480 * MiB;
constexpr size_t WS_O1 = 48 * MiB;
constexpr size_t WS_END = 484 * MiB;

constexpr int LDS_BYTES = 147456;
constexpr int NTHR = 512, NWV = 8;

typedef unsigned short bf16_t;
#define LAS __attribute__((address_space(3)))

__device__ __forceinline__ float bf2f(bf16_t v) { return __uint_as_float(((unsigned)v) << 16); }
__device__ __forceinline__ bf16_t f2bf(float f) { unsigned u = __float_as_uint(f); return (bf16_t)((u + 0x7fffu + ((u >> 16) & 1u)) >> 16); }
__device__ __forceinline__ float wave_sum(float v) {
#pragma unroll
    for (int o = 1; o < 64; o <<= 1) v += __shfl_xor(v, o);
    return v;
}
__device__ __forceinline__ float wave_max(float v) {
#pragma unroll
    for (int o = 1; o < 64; o <<= 1) v = fmaxf(v, __shfl_xor(v, o));
    return v;
}
#define WSYNC() asm volatile("s_waitcnt lgkmcnt(0)" ::: "memory")
__device__ __forceinline__ float siluf(float x) { return x / (1.f + __expf(-x)); }
__device__ __forceinline__ float sigmoidf_(float x) { return 1.f / (1.f + __expf(-x)); }

#define XB_TMO      128
#define XB_XCNT(j)  (256  + 64 * (j))
#define XB_XSUB(j)  (1280 + 64 * (j))
#define XB_XGEN(j)  (2304 + 64 * (j))
#define XB_TOP      3328
#define XB_TOPGEN   3392
#define XCD_BAR_WORDS 3456
#define XB_SPIN_CAP (1u << 24)
__device__ __forceinline__ unsigned xb_ld(unsigned* p)              { return __hip_atomic_load(p, __ATOMIC_RELAXED, __HIP_MEMORY_SCOPE_AGENT); }
__device__ __forceinline__ unsigned xb_add(unsigned* p, unsigned v) { return __hip_atomic_fetch_add(p, v, __ATOMIC_RELAXED, __HIP_MEMORY_SCOPE_AGENT); }
__device__ __forceinline__ unsigned xb_xcc_id() { return (unsigned)__builtin_amdgcn_s_getreg((3 << 11) | 20) & 0xFu; }
#define XB_SPIN(cond, bar) do { unsigned _sp = 0; while (cond) { __builtin_amdgcn_s_sleep(1); \
    if ((++_sp & 255u) == 0u) { if (xb_ld(&(bar)[XB_TMO])) break; if (_sp > XB_SPIN_CAP) { atomicAdd(&(bar)[XB_TMO], 1u); break; } } } } while (0)
struct XcdBarrier { unsigned* bar; unsigned x; volatile LAS unsigned* st; };
__device__ __forceinline__ XcdBarrier xcd_barrier_post(unsigned* bar, volatile LAS unsigned* st) {
    XcdBarrier b; b.bar = bar; b.x = xb_xcc_id(); b.st = st;
    if (threadIdx.x == 0) (void)xb_add(&bar[XB_XCNT(b.x)], 1u);
    return b;
}
__device__ __forceinline__ void xcd_barrier_complete(unsigned* bar, unsigned x, unsigned& nloc, unsigned& nx) {
    const unsigned G = gridDim.x * gridDim.y * gridDim.z;
    unsigned sum, cnt, mine, sp = 0u;
    for (;;) {
        sum = 0u; cnt = 0u; mine = 0u;
#pragma unroll
        for (unsigned j = 0; j < 16; ++j) { const unsigned c = xb_ld(&bar[XB_XCNT(j)]); sum += c; cnt += (c > 0u) ? 1u : 0u; mine = (j == x) ? c : mine; }
        if (sum == G) break;
        __builtin_amdgcn_s_sleep(1);
        if ((++sp & 255u) == 0u) { if (xb_ld(&bar[XB_TMO])) break; if (sp > XB_SPIN_CAP) { atomicAdd(&bar[XB_TMO], 1u); break; } }
    }
    nloc = mine > 0u ? mine : 1u; nx = cnt > 0u ? cnt : 1u;
}
__device__ __forceinline__ void xcd_barrier(const XcdBarrier& b) {
    asm volatile("s_waitcnt vmcnt(0)" ::: "memory");
    __syncthreads();
    if (threadIdx.x == 0) {
        unsigned* bar = b.bar;
        __builtin_amdgcn_s_waitcnt(0);
        unsigned nloc = b.st[0], nx = b.st[1];
        if (nloc == 0u) { xcd_barrier_complete(bar, b.x, nloc, nx); b.st[0] = nloc; b.st[1] = nx; }
        const unsigned old = xb_add(&bar[XB_XSUB(b.x)], 1u);
        const unsigned gen = old / nloc;
        if (old + 1u == (gen + 1u) * nloc) {
            __builtin_amdgcn_fence(__ATOMIC_RELEASE, "agent");
            asm volatile("s_waitcnt vmcnt(0)" ::: "memory");
            const unsigned og = xb_add(&bar[XB_TOP], 1u);
            const unsigned tg = og / nx;
            if (og + 1u == (tg + 1u) * nx) xb_add(&bar[XB_TOPGEN], 1u);
            else XB_SPIN(xb_ld(&bar[XB_TOPGEN]) == tg, bar);
            __builtin_amdgcn_fence(__ATOMIC_ACQUIRE, "agent");
            xb_add(&bar[XB_XGEN(b.x)], 1u);
            asm volatile("s_waitcnt vmcnt(0)" ::: "memory");
        } else {
            XB_SPIN(xb_ld(&bar[XB_XGEN(b.x)]) == gen, bar);
            __builtin_amdgcn_fence(__ATOMIC_ACQUIRE, "agent");
            asm volatile("s_waitcnt vmcnt(0)" ::: "memory");
        }
    }
    __syncthreads();
}

struct Args { const void* in[20]; float* out; unsigned char* ws; int lo, hi; };
struct Ctx {
    const float* x; const int* pos; const float* a_norm; const float* a_w_in; const float* pe_k; const float* pe_v;
    const float* w_ck1; const float* w_ck2; const float* w_cv1; const float* w_cv2; const float* conv_w; const float* a_w_out;
    const float* c_norm; const float* c_w_in; const float* q_norm; const float* kv_norm; const float* w_uq; const float* w_ukv; const float* c_w_out; const float* final_norm;
    float* out; unsigned char* ws;
    float2* CS; bf16_t* KCMP; bf16_t* VCMP; bf16_t* XN; bf16_t* PA; bf16_t* MIX; bf16_t* PC; bf16_t* Q1; bf16_t* KV1; bf16_t* CQN; bf16_t* CKVN; bf16_t* KPE; bf16_t* O1;
};

__device__ __forceinline__ void sincos_acc(float angf, float& s, float& c) {
    const double x = (double)angf;
    const double k = rint(x * 0.6366197723675814);
    double r = fma(-k, 1.5707963267948966, x);
    r = fma(-k, 6.123233995736766e-17, r);
    const double r2 = r * r;
    double sp = -1.0 / 1307674368000.0;
    sp = fma(sp, r2, 1.0 / 6227020800.0);
    sp = fma(sp, r2, -1.0 / 39916800.0);
    sp = fma(sp, r2, 1.0 / 362880.0);
    sp = fma(sp, r2, -1.0 / 5040.0);
    sp = fma(sp, r2, 1.0 / 120.0);
    sp = fma(sp, r2, -1.0 / 6.0);
    const double sn = fma(sp * r2, r, r);
    double cp = 1.0 / 20922789888000.0;
    cp = fma(cp, r2, -1.0 / 87178291200.0);
    cp = fma(cp, r2, 1.0 / 479001600.0);
    cp = fma(cp, r2, -1.0 / 3628800.0);
    cp = fma(cp, r2, 1.0 / 40320.0);
    cp = fma(cp, r2, -1.0 / 720.0);
    cp = fma(cp, r2, 1.0 / 24.0);
    cp = fma(cp, r2, -0.5);
    const double cs = fma(cp, r2, 1.0);
    const int q = ((int)(long long)k) & 3;
    const double ss = (q == 0) ? sn : (q == 1) ? cs : (q == 2) ? -sn : -cs;
    const double cc = (q == 0) ? cs : (q == 1) ? -sn : (q == 2) ? -cs : sn;
    s = (float)ss; c = (float)cc;
}

__device__ __forceinline__ void rms_row_f32(const float* xr, const float* g, bf16_t* orow, int lane) {
    float4 v[4]; float s = 0.f;
#pragma unroll
    for (int j = 0; j < 4; ++j) { v[j] = *(const float4*)(xr + 4 * lane + 256 * j); s += (v[j].x * v[j].x + v[j].y * v[j].y) + (v[j].z * v[j].z + v[j].w * v[j].w); }
    const float rstd = 1.f / sqrtf(wave_sum(s) * (1.f / DM) + RMS_EPS);
#pragma unroll
    for (int j = 0; j < 4; ++j) {
        const float4 gg = *(const float4*)(g + 4 * lane + 256 * j);
        ushort4 o; o.x = f2bf(v[j].x * rstd * gg.x); o.y = f2bf(v[j].y * rstd * gg.y); o.z = f2bf(v[j].z * rstd * gg.z); o.w = f2bf(v[j].w * rstd * gg.w);
        *(ushort4*)(orow + 4 * lane + 256 * j) = o;
    }
}

template <class Epi>
__device__ __forceinline__ void gemm_naive(const bf16_t* A, int lda, const float* W, int K, int N, unsigned char* lds, Epi epi) {
    float (*As)[132] = (float (*)[132])lds;
    float (*Bs)[128] = (float (*)[128])(lds + 16 * 132 * 4);
    const int tid = threadIdx.x, tx = tid & 31, ty = tid >> 5;
    const int ntm = M / 128, ntn = (N + 127) / 128;
    for (int tile = blockIdx.x; tile < ntm * ntn; tile += gridDim.x) {
        const int tm = tile / ntn, tn = tile % ntn;
        float acc[8][4];
#pragma unroll
        for (int i = 0; i < 8; ++i)
#pragma unroll
            for (int j = 0; j < 4; ++j) acc[i][j] = 0.f;
        for (int k0 = 0; k0 < K; k0 += 16) {
            {   const int r = tid >> 2, kq = (tid & 3) * 4;
                const ushort4 v = *(const ushort4*)(A + (size_t)(tm * 128 + r) * lda + k0 + kq);
                As[kq + 0][r] = bf2f(v.x); As[kq + 1][r] = bf2f(v.y); As[kq + 2][r] = bf2f(v.z); As[kq + 3][r] = bf2f(v.w); }
            {   const int kk = tid >> 5, n4 = (tid & 31) * 4; const int n = tn * 128 + n4;
                const float* wp = W + (size_t)(k0 + kk) * N + n;
                float4 v;
                v.x = (n + 0 < N) ? wp[0] : 0.f; v.y = (n + 1 < N) ? wp[1] : 0.f; v.z = (n + 2 < N) ? wp[2] : 0.f; v.w = (n + 3 < N) ? wp[3] : 0.f;
                *(float4*)&Bs[kk][n4] = v; }
            __syncthreads();
#pragma unroll 2
            for (int kk = 0; kk < 16; ++kk) {
                const float4 a0 = *(const float4*)&As[kk][ty * 8], a1 = *(const float4*)&As[kk][ty * 8 + 4];
                const float4 b = *(const float4*)&Bs[kk][tx * 4];
                const float a[8] = {a0.x, a0.y, a0.z, a0.w, a1.x, a1.y, a1.z, a1.w};
                const float bb[4] = {b.x, b.y, b.z, b.w};
#pragma unroll
                for (int i = 0; i < 8; ++i)
#pragma unroll
                    for (int j = 0; j < 4; ++j) acc[i][j] = fmaf(a[i], bb[j], acc[i][j]);
            }
            __syncthreads();
        }
#pragma unroll
        for (int i = 0; i < 8; ++i)
#pragma unroll
            for (int j = 0; j < 4; ++j) { const int m = tm * 128 + ty * 8 + i, n = tn * 128 + tx * 4 + j; if (n < N) epi(m, n, acc[i][j]); }
    }
}

__device__ __forceinline__ void ph0_prologue(const Ctx& c) {
    for (int idx = blockIdx.x * NTHR + threadIdx.x; idx < M * 32; idx += gridDim.x * NTHR) {
        const int m = idx >> 5, i = idx & 31;
        const float invf = (float)exp2(-(double)i * (13.287712379549449 / 32.0));
        const float ang = (float)c.pos[m] * invf;
        float s, co; sincos_acc(ang, s, co);
        c.CS[idx] = make_float2(co, s);
    }
    const int lane = threadIdx.x & 63, gw = blockIdx.x * NWV + (threadIdx.x >> 6), NGW = gridDim.x * NWV;
    for (int m = gw; m < M; m += NGW) rms_row_f32(c.x + (size_t)m * DM, c.a_norm, c.XN + (size_t)m * DM, lane);
}
__device__ __forceinline__ int pa_col(int n) { return n < 1280 ? n : (n < 1304 ? PA_GL + (n - 1280) : n - 24); }
__device__ __forceinline__ int pc_col(int n) { return n < 512 ? n : (n < 576 ? PC_KR + (n - 512) : n - 64); }

__device__ __forceinline__ void ph2_rope_a(const Ctx& c) {
    for (size_t idx = (size_t)blockIdx.x * NTHR + threadIdx.x; idx < (size_t)M * 12 * 32; idx += (size_t)gridDim.x * NTHR) {
        const int i = (int)(idx & 31); const size_t r = idx >> 5; const int slot = (int)(r % 12); const int m = (int)(r / 12);
        const int base = slot < 8 ? PA_Q + slot * 64 : (slot < 10 ? PA_KS + (slot - 8) * 64 : PA_KW + (slot - 10) * 64);
        const float sc = slot < 8 ? QSCALE_A : 1.f;
        bf16_t* p = c.PA + (size_t)m * PA_LD + base + i;
        const float x1 = bf2f(p[0]), x2 = bf2f(p[32]);
        const float2 cs = c.CS[(size_t)m * 32 + i];
        p[0] = f2bf((x1 * cs.x - x2 * cs.y) * sc); p[32] = f2bf((x2 * cs.x + x1 * cs.y) * sc);
    }
}

__device__ __forceinline__ void ph3_compress(const Ctx& c, unsigned char* lds) {
    float* blk = (float*)lds;
    float* part = blk + 8 * 2048;
    float* hid = part + 4 * 8 * 128;
    float* outp = hid + 8 * 128;
    float* outs = outp + 8 * 8 * 64;
    const int tid = threadIdx.x;
    for (int item = blockIdx.x; item < 2 * BATCH * 2 * 32; item += gridDim.x) {
        const int ct = item & 31, g = (item >> 5) & 1, b = (item >> 6) & 7, kv = item >> 9;
        const float* pe = kv ? c.pe_v : c.pe_k; const float* w1 = kv ? c.w_cv1 : c.w_ck1; const float* w2 = kv ? c.w_cv2 : c.w_ck2;
        const int col0 = (kv ? PA_VC : PA_KC) + g * 64;
        __syncthreads();
        for (int e = tid; e < 8 * 2048; e += NTHR) {
            const int ci = e >> 11, k = e & 2047, l = k >> 6, d = k & 63; const int cidx = ct * 8 + ci;
            float v = 0.f;
            if (cidx < 255) v = bf2f(c.PA[(size_t)(b * SEQ + 16 * cidx + l) * PA_LD + col0 + d]) + pe[l * 64 + d];
            blk[e] = v;
        }
        __syncthreads();
        {   const int j = tid & 127, pt = tid >> 7;
            float acc[8];
#pragma unroll
            for (int ci = 0; ci < 8; ++ci) acc[ci] = 0.f;
            for (int k = pt * 512; k < pt * 512 + 512; ++k) {
                const float w = w1[(size_t)k * 128 + j];
#pragma unroll
                for (int ci = 0; ci < 8; ++ci) acc[ci] = fmaf(blk[ci * 2048 + k], w, acc[ci]);
            }
#pragma unroll
            for (int ci = 0; ci < 8; ++ci) part[(pt * 8 + ci) * 128 + j] = acc[ci];
        }
        __syncthreads();
        for (int e = tid; e < 8 * 128; e += NTHR) { const int ci = e >> 7, j = e & 127; const float s = (part[(0 * 8 + ci) * 128 + j] + part[(1 * 8 + ci) * 128 + j]) + (part[(2 * 8 + ci) * 128 + j] + part[(3 * 8 + ci) * 128 + j]); hid[e] = siluf(s); }
        __syncthreads();
        {   const int d = tid & 63, pt = tid >> 6;
            float acc[8];
#pragma unroll
            for (int ci = 0; ci < 8; ++ci) acc[ci] = 0.f;
            for (int j = pt * 16; j < pt * 16 + 16; ++j) {
                const float w = w2[j * 64 + d];
#pragma unroll
                for (int ci = 0; ci < 8; ++ci) acc[ci] = fmaf(hid[ci * 128 + j], w, acc[ci]);
            }
#pragma unroll
            for (int ci = 0; ci < 8; ++ci) outp[(pt * 8 + ci) * 64 + d] = acc[ci];
        }
        __syncthreads();
        {   const int ci = tid >> 6, d = tid & 63; float s = 0.f;
#pragma unroll
            for (int pt = 0; pt < 8; ++pt) s += outp[(pt * 8 + ci) * 64 + d];
            outs[ci * 64 + d] = s; }
        __syncthreads();
        {   const int ci = tid >> 6, d = tid & 63; const int cidx = ct * 8 + ci;
            float v = outs[ci * 64 + d];
            if (kv == 0 && cidx < 255) {
                const int i = d & 31; const float2 cs = c.CS[(size_t)(b * SEQ + 16 * cidx + 31) * 32 + i];
                const float x1 = outs[ci * 64 + i], x2 = outs[ci * 64 + i + 32];
                v = (d < 32) ? (x1 * cs.x - x2 * cs.y) : (x2 * cs.x + x1 * cs.y);
            }
            if (cidx >= 255) v = 0.f;
            bf16_t* dst = (kv ? c.VCMP : c.KCMP) + ((size_t)(b * 2 + g) * 256 + cidx) * 64 + d;
            *dst = f2bf(v);
        }
    }
    __syncthreads();
}

__device__ __forceinline__ float dot64(const bf16_t* krow, const float* q) {
    float s = 0.f;
#pragma unroll
    for (int ch = 0; ch < 8; ++ch) {
        const uint4 v = *(const uint4*)(krow + ch * 8);
        const unsigned w[4] = {v.x, v.y, v.z, v.w};
#pragma unroll
        for (int e = 0; e < 4; ++e) { s = fmaf(__uint_as_float(w[e] << 16), q[ch * 8 + 2 * e], s); s = fmaf(__uint_as_float(w[e] & 0xffff0000u), q[ch * 8 + 2 * e + 1], s); }
    }
    return s;
}

__device__ __forceinline__ void ph4_nsa(const Ctx& c, unsigned char* lds) {
    const int lane = threadIdx.x & 63, wave = threadIdx.x >> 6;
    float* wq = (float*)(lds + wave * 12288);
    float* wp = wq + 64;
    float* wpc = wp + 1024;
    float* wres = wpc + 1024;
    const int gw = blockIdx.x * NWV + wave, NGW = gridDim.x * NWV;
    for (int item = gw; item < M * 2; item += NGW) {
        const int g = item & 1, m = item >> 1; const int b = m / SEQ, t = m % SEQ;
        const bf16_t* parow = c.PA + (size_t)m * PA_LD;
        const bf16_t* pab = c.PA + (size_t)b * SEQ * PA_LD;
        const bf16_t* kc = c.KCMP + (size_t)(b * 2 + g) * 256 * 64; const bf16_t* vc = c.VCMP + (size_t)(b * 2 + g) * 256 * 64;
        const int nvalid = t >= 31 ? min((t - 31) / 16 + 1, 255) : 0;
        for (int hh = 0; hh < 4; ++hh) {
            const int head = g * 4 + hh;
            WSYNC(); wq[lane] = bf2f(parow[PA_Q + head * 64 + lane]); WSYNC();
            float s[4]; float mx = -INFINITY;
#pragma unroll
            for (int jj = 0; jj < 4; ++jj) { const int ci = lane + 64 * jj; s[jj] = (ci < nvalid) ? dot64(kc + (size_t)ci * 64, wq) : -INFINITY; mx = fmaxf(mx, s[jj]); }
            mx = wave_max(mx);
            float sum = 0.f;
#pragma unroll
            for (int jj = 0; jj < 4; ++jj) { s[jj] = (nvalid > 0) ? exp2f(s[jj] - mx) : 0.f; sum += s[jj]; }
            sum = wave_sum(sum);
            const float inv = nvalid > 0 ? 1.f / sum : 0.f;
#pragma unroll
            for (int jj = 0; jj < 4; ++jj) wpc[hh * 256 + lane + 64 * jj] = s[jj] * inv;
            WSYNC();
            float o = 0.f;
            for (int ci = 0; ci < nvalid; ++ci) o = fmaf(wpc[hh * 256 + ci], bf2f(vc[(size_t)ci * 64 + lane]), o);
            wres[(hh * 3 + 0) * 64 + lane] = o;
        }
        unsigned long long selmask;
        {   const int n = lane; float imp = 0.f;
            const int c_lo = max(4 * n - 1, 0), c_hi = min(4 * n + 3, 254);
            for (int hh = 0; hh < 4; ++hh) for (int ci = c_lo; ci <= c_hi; ++ci) imp += wpc[hh * 256 + ci];
            const bool bv = (64 * n <= t); const int cur = t >> 6;
            const bool forced = (n == 0) || (n == cur) || (n == cur - 1);
            const float sc = bv ? (forced ? 1e4f : imp) : -1.f;
            int rank = 0;
            for (int mm = 0; mm < 64; ++mm) { const float o = __shfl(sc, mm); rank += (o > sc || (o == sc && mm < n)) ? 1 : 0; }
            selmask = __ballot(rank < 16 && bv);
        }
        for (int hh = 0; hh < 4; ++hh) {
            const int head = g * 4 + hh;
            WSYNC(); wq[lane] = bf2f(parow[PA_Q + head * 64 + lane]); WSYNC();
            {   unsigned long long sm = selmask; int slot = 0; float mx = -INFINITY;
                while (sm) { const int n = __builtin_ctzll(sm); sm &= sm - 1; const int tok = n * 64 + lane;
                    const float s = (tok <= t) ? dot64(pab + (size_t)tok * PA_LD + PA_KS + g * 64, wq) : -INFINITY;
                    wp[slot * 64 + lane] = s; mx = fmaxf(mx, s); ++slot; }
                mx = wave_max(mx);
                float sum = 0.f;
                for (int sl = 0; sl < slot; ++sl) { const float p = exp2f(wp[sl * 64 + lane] - mx); wp[sl * 64 + lane] = p; sum += p; }
                sum = wave_sum(sum); WSYNC();
                float o = 0.f; sm = selmask; slot = 0;
                while (sm) { const int n = __builtin_ctzll(sm); sm &= sm - 1;
                    const int kmax = min(63, t - n * 64);
                    for (int kk = 0; kk <= kmax; ++kk) o = fmaf(wp[slot * 64 + kk], bf2f(pab[(size_t)(n * 64 + kk) * PA_LD + PA_VS + g * 64 + lane]), o);
                    ++slot; }
                wres[(hh * 3 + 1) * 64 + lane] = o / sum; }
            WSYNC();
            {   float mx = -INFINITY;
                for (int j = 0; j < 8; ++j) { const int kp = t - 511 + 64 * j + lane;
                    const float s = (kp >= 0) ? dot64(pab + (size_t)kp * PA_LD + PA_KW + g * 64, wq) : -INFINITY;
                    wp[j * 64 + lane] = s; mx = fmaxf(mx, s); }
                mx = wave_max(mx);
                float sum = 0.f;
                for (int j = 0; j < 8; ++j) { const float p = exp2f(wp[j * 64 + lane] - mx); wp[j * 64 + lane] = p; sum += p; }
                sum = wave_sum(sum); WSYNC();
                float o = 0.f;
                const int k_lo = max(0, 511 - t);
                for (int kk = k_lo; kk < 512; ++kk) o = fmaf(wp[kk], bf2f(pab[(size_t)(t - 511 + kk) * PA_LD + PA_VW + g * 64 + lane]), o);
                wres[(hh * 3 + 2) * 64 + lane] = o / sum; }
        }
        for (int hh = 0; hh < 4; ++hh) {
            const int head = g * 4 + hh;
            const float g0 = sigmoidf_(bf2f(parow[PA_GL + head * 3 + 0])), g1 = sigmoidf_(bf2f(parow[PA_GL + head * 3 + 1])), g2 = sigmoidf_(bf2f(parow[PA_GL + head * 3 + 2]));
            const float o = g0 * wres[(hh * 3 + 0) * 64 + lane] + g1 * wres[(hh * 3 + 1) * 64 + lane] + g2 * wres[(hh * 3 + 2) * 64 + lane];
            const float ga = bf2f(parow[PA_GA + head * 64 + lane]);
            c.MIX[(size_t)m * DM + head * 64 + lane] = f2bf(siluf(ga) * o);
        }
    }
}

__device__ __forceinline__ void ph5_conv(const Ctx& c) {
    for (size_t idx = (size_t)blockIdx.x * NTHR + threadIdx.x; idx < (size_t)M * 512; idx += (size_t)gridDim.x * NTHR) {
        const int ch = (int)(idx & 511); const int m = (int)(idx >> 9); const int t = m % SEQ;
        const bf16_t* r0 = c.PA + (size_t)m * PA_LD;
        float y = c.conv_w[2 * 512 + ch] * bf2f(r0[PA_CC + ch]) * bf2f(r0[PA_CH + ch]);
        if (t >= 1) { const bf16_t* r1 = r0 - PA_LD; y += c.conv_w[1 * 512 + ch] * bf2f(r1[PA_CC + ch]) * bf2f(r1[PA_CH + ch]); }
        if (t >= 2) { const bf16_t* r2 = r0 - 2 * PA_LD; y += c.conv_w[0 * 512 + ch] * bf2f(r2[PA_CC + ch]) * bf2f(r2[PA_CH + ch]); }
        c.MIX[(size_t)m * DM + 512 + ch] = f2bf(siluf(bf2f(r0[PA_GB + ch])) * bf2f(r0[PA_CB + ch]) * y);
    }
}

__device__ __forceinline__ void ph7_norm1(const Ctx& c) {
    const int lane = threadIdx.x & 63, gw = blockIdx.x * NWV + (threadIdx.x >> 6), NGW = gridDim.x * NWV;
    for (int m = gw; m < M; m += NGW) rms_row_f32(c.out + (size_t)m * DM, c.c_norm, c.XN + (size_t)m * DM, lane);
}
__device__ __forceinline__ void ph_final(const Ctx& c) {
    const int lane = threadIdx.x & 63, gw = blockIdx.x * NWV + (threadIdx.x >> 6), NGW = gridDim.x * NWV;
    for (int m = gw; m < M; m += NGW) {
        float* xr = c.out + (size_t)m * DM;
        float4 v[4]; float s = 0.f;
#pragma unroll
        for (int j = 0; j < 4; ++j) { v[j] = *(const float4*)(xr + 4 * lane + 256 * j); s += (v[j].x * v[j].x + v[j].y * v[j].y) + (v[j].z * v[j].z + v[j].w * v[j].w); }
        const float rstd = 1.f / sqrtf(wave_sum(s) * (1.f / DM) + RMS_EPS);
#pragma unroll
        for (int j = 0; j < 4; ++j) { const float4 gg = *(const float4*)(c.final_norm + 4 * lane + 256 * j);
            float4 o; o.x = v[j].x * rstd * gg.x; o.y = v[j].y * rstd * gg.y; o.z = v[j].z * rstd * gg.z; o.w = v[j].w * rstd * gg.w;
            *(float4*)(xr + 4 * lane + 256 * j) = o; }
    }
}

__device__ __forceinline__ void ph9_lat_norm(const Ctx& c) {
    const int lane = threadIdx.x & 63, gw = blockIdx.x * NWV + (threadIdx.x >> 6), NGW = gridDim.x * NWV;
    for (int m = gw; m < M; m += NGW) {
        const bf16_t* r = c.PC + (size_t)m * PC_LD;
#pragma unroll
        for (int w = 0; w < 2; ++w) {
            const ushort4 v = *(const ushort4*)(r + (w ? PC_CKV : PC_CQ) + 4 * lane);
            const float a0 = bf2f(v.x), a1 = bf2f(v.y), a2 = bf2f(v.z), a3 = bf2f(v.w);
            const float rstd = 1.f / sqrtf(wave_sum(a0 * a0 + a1 * a1 + a2 * a2 + a3 * a3) * (1.f / 256.f) + RMS_EPS);
            const float4 gg = *(const float4*)((w ? c.kv_norm : c.q_norm) + 4 * lane);
            ushort4 o; o.x = f2bf(a0 * rstd * gg.x); o.y = f2bf(a1 * rstd * gg.y); o.z = f2bf(a2 * rstd * gg.z); o.w = f2bf(a3 * rstd * gg.w);
            *(ushort4*)((w ? c.CKVN : c.CQN) + (size_t)m * 256 + 4 * lane) = o;
        }
        if (lane < 32) {
            const float x1 = bf2f(r[PC_KR + lane]), x2 = bf2f(r[PC_KR + lane + 32]); const float2 cs = c.CS[(size_t)m * 32 + lane];
            c.KPE[(size_t)m * 64 + lane] = f2bf(x1 * cs.x - x2 * cs.y); c.KPE[(size_t)m * 64 + lane + 32] = f2bf(x2 * cs.x + x1 * cs.y);
        }
    }
}
__device__ __forceinline__ void ph11_rope_q1(const Ctx& c) {
    for (size_t idx = (size_t)blockIdx.x * NTHR + threadIdx.x; idx < (size_t)M * 8 * 96; idx += (size_t)gridDim.x * NTHR) {
        const int e = (int)(idx % 96); const size_t r = idx / 96; const int h = (int)(r & 7); const int m = (int)(r >> 3);
        bf16_t* q = c.Q1 + (size_t)m * 1536 + h * 192;
        if (e < 64) { q[e] = f2bf(bf2f(q[e]) * QSCALE_C); q[e + 64] = f2bf(bf2f(q[e + 64]) * QSCALE_C); }
        else { const int i = e - 64; const float2 cs = c.CS[(size_t)m * 32 + i];
            const float x1 = bf2f(q[128 + i]), x2 = bf2f(q[160 + i]);
            q[128 + i] = f2bf((x1 * cs.x - x2 * cs.y) * QSCALE_C); q[160 + i] = f2bf((x2 * cs.x + x1 * cs.y) * QSCALE_C); }
    }
}
__device__ __forceinline__ void ph12_mla(const Ctx& c, unsigned char* lds) {
    const int lane = threadIdx.x & 63, wave = threadIdx.x >> 6;
    float* wq = (float*)(lds + wave * 2048);
    float* wp = wq + 192;
    const int gw = blockIdx.x * NWV + wave, NGW = gridDim.x * NWV;
    for (int item = gw; item < M * 8; item += NGW) {
        const int h = item & 7, m = item >> 3; const int b = m / SEQ, t = m % SEQ;
        WSYNC();
        const bf16_t* qrow = c.Q1 + (size_t)m * 1536 + h * 192;
        wq[lane] = bf2f(qrow[lane]); wq[64 + lane] = bf2f(qrow[64 + lane]); wq[128 + lane] = bf2f(qrow[128 + lane]);
        WSYNC();
        float mrun = -1e30f, l = 0.f, o0 = 0.f, o1 = 0.f;
        const bf16_t* kvb = c.KV1 + (size_t)b * SEQ * 2048 + h * 256; const bf16_t* kpb = c.KPE + (size_t)b * SEQ * 64;
        for (int k0 = 0; k0 <= t; k0 += 64) {
            const int key = k0 + lane;
            float s = -INFINITY;
            if (key <= t) { const bf16_t* kr = kvb + (size_t)key * 2048; s = dot64(kr, wq) + dot64(kr + 64, wq + 64) + dot64(kpb + (size_t)key * 64, wq + 128); }
            const float cm = wave_max(s);
            const float mn = fmaxf(mrun, cm); const float alpha = exp2f(mrun - mn); mrun = mn;
            const float p = exp2f(s - mn);
            l = l * alpha + wave_sum(p); o0 *= alpha; o1 *= alpha;
            WSYNC(); wp[lane] = p; WSYNC();
            const int kmax = min(63, t - k0);
            for (int kk = 0; kk <= kmax; ++kk) { const bf16_t* vr = kvb + (size_t)(k0 + kk) * 2048 + 128; const float pp = wp[kk]; o0 = fmaf(pp, bf2f(vr[lane]), o0); o1 = fmaf(pp, bf2f(vr[64 + lane]), o1); }
        }
        const float inv = 1.f / l;
        const bf16_t* gr = c.PC + (size_t)m * PC_LD + PC_G + h * 128;
        c.O1[(size_t)m * DM + h * 128 + lane] = f2bf(siluf(bf2f(gr[lane])) * o0 * inv);
        c.O1[(size_t)m * DM + h * 128 + 64 + lane] = f2bf(siluf(bf2f(gr[64 + lane])) * o1 * inv);
    }
}

constexpr int NPHASE = 15;
__global__ void __launch_bounds__(NTHR, 2) mk_fwd(Args a) {
    extern __shared__ __attribute__((aligned(16))) unsigned char lds[];
    Ctx c;
    c.x = (const float*)a.in[0]; c.pos = (const int*)a.in[1]; c.a_norm = (const float*)a.in[2]; c.a_w_in = (const float*)a.in[3]; c.pe_k = (const float*)a.in[4]; c.pe_v = (const float*)a.in[5];
    c.w_ck1 = (const float*)a.in[6]; c.w_ck2 = (const float*)a.in[7]; c.w_cv1 = (const float*)a.in[8]; c.w_cv2 = (const float*)a.in[9]; c.conv_w = (const float*)a.in[10]; c.a_w_out = (const float*)a.in[11];
    c.c_norm = (const float*)a.in[12]; c.c_w_in = (const float*)a.in[13]; c.q_norm = (const float*)a.in[14]; c.kv_norm = (const float*)a.in[15]; c.w_uq = (const float*)a.in[16]; c.w_ukv = (const float*)a.in[17];
    c.c_w_out = (const float*)a.in[18]; c.final_norm = (const float*)a.in[19];
    c.out = a.out; c.ws = a.ws;
    c.CS = (float2*)(a.ws + WS_CS); c.KCMP = (bf16_t*)(a.ws + WS_KCMP); c.VCMP = (bf16_t*)(a.ws + WS_VCMP); c.XN = (bf16_t*)(a.ws + WS_XN); c.PA = (bf16_t*)(a.ws + WS_PA);
    c.MIX = (bf16_t*)(a.ws + WS_MIX); c.PC = (bf16_t*)(a.ws + WS_PC); c.Q1 = (bf16_t*)(a.ws + WS_Q1); c.KV1 = (bf16_t*)(a.ws + WS_KV1); c.CQN = (bf16_t*)(a.ws + WS_CQN);
    c.CKVN = (bf16_t*)(a.ws + WS_CKVN); c.KPE = (bf16_t*)(a.ws + WS_KPE); c.O1 = (bf16_t*)(a.ws + WS_O1);

    volatile LAS unsigned* misc = (volatile LAS unsigned*)((LAS unsigned char*)lds + (LDS_BYTES - 64));
    if (threadIdx.x < 16) misc[threadIdx.x] = 0u;
    __syncthreads();
    XcdBarrier bar; bar.bar = (unsigned*)(a.ws + WS_CTL) + 4096; bar.x = 0; bar.st = misc;
    const bool multi = (a.hi - a.lo) > 1;
    if (multi) bar = xcd_barrier_post((unsigned*)(a.ws + WS_CTL) + 4096, misc);

#define PHASE(k, ...) if (a.lo <= (k) && (k) < a.hi) { __VA_ARGS__; if ((k) + 1 < a.hi) xcd_barrier(bar); }
    PHASE(0, ph0_prologue(c))
    PHASE(1, { bf16_t* PA = c.PA; gemm_naive(c.XN, DM, c.a_w_in, DM, NIN_A, lds, [=](int m, int n, float v) { PA[(size_t)m * PA_LD + pa_col(n)] = f2bf(v); }); })
    PHASE(2, ph2_rope_a(c))
    PHASE(3, ph3_compress(c, lds))
    PHASE(4, ph4_nsa(c, lds))
    PHASE(5, ph5_conv(c))
    PHASE(6, { const float* x = c.x; float* o = c.out; gemm_naive(c.MIX, DM, c.a_w_out, DM, DM, lds, [=](int m, int n, float v) { o[(size_t)m * DM + n] = x[(size_t)m * DM + n] + v; }); })
    PHASE(7, ph7_norm1(c))
    PHASE(8, { bf16_t* PC = c.PC; gemm_naive(c.XN, DM, c.c_w_in, DM, NIN_C, lds, [=](int m, int n, float v) { PC[(size_t)m * PC_LD + pc_col(n)] = f2bf(v); }); })
    PHASE(9, ph9_lat_norm(c))
    PHASE(10, { bf16_t* Q1 = c.Q1; gemm_naive(c.CQN, 256, c.w_uq, 256, 1536, lds, [=](int m, int n, float v) { Q1[(size_t)m * 1536 + n] = f2bf(v); });
                bf16_t* KV1 = c.KV1; gemm_naive(c.CKVN, 256, c.w_ukv, 256, 2048, lds, [=](int m, int n, float v) { KV1[(size_t)m * 2048 + n] = f2bf(v); }); })
    PHASE(11, ph11_rope_q1(c))
    PHASE(12, ph12_mla(c, lds))
    PHASE(13, { float* o = c.out; gemm_naive(c.O1, DM, c.c_w_out, DM, DM, lds, [=](int m, int n, float v) { o[(size_t)m * DM + n] += v; }); })
    PHASE(14, ph_final(c))
#undef PHASE
}

extern "C" void kernel_launch(void* const* d_in, const int* in_sizes, int n_in, void* d_out, int out_size, void* d_ws, size_t ws_size, hipStream_t stream) {
    static int grid = 0;
    if (grid == 0) {
        if (n_in != 20 || in_sizes[0] != M * DM || out_size != M * DM || ws_size < WS_END) {
            fprintf(stderr, "kernel_launch: unexpected shapes (n_in %d, in0 %d, out %d, ws %zu)\n", n_in, n_in > 0 ? in_sizes[0] : -1, out_size, ws_size); grid = -1; return; }
        int dev = 0, cus = 0;
        if (hipGetDevice(&dev) != hipSuccess || hipDeviceGetAttribute(&cus, hipDeviceAttributeMultiprocessorCount, dev) != hipSuccess || cus <= 0) { grid = -1; return; }
        if (hipFuncSetAttribute((const void*)mk_fwd, hipFuncAttributeMaxDynamicSharedMemorySize, LDS_BYTES) != hipSuccess) { fprintf(stderr, "kernel_launch: hipFuncSetAttribute failed\n"); grid = -1; return; }
        (void)hipGetLastError();
        grid = cus;
    }
    if (grid < 0) return;
    (void)hipMemsetAsync((char*)d_ws + WS_CTL, 0, CTL_BYTES, stream);
    Args a{};
    for (int i = 0; i < 20; ++i) a.in[i] = d_in[i];
    a.out = (float*)d_out; a.ws = (unsigned char*)d_ws;
#if MK_ONE_LAUNCH
    a.lo = 0; a.hi = NPHASE;
    hipLaunchKernelGGL(mk_fwd, dim3(grid), dim3(NTHR), LDS_BYTES, stream, a);
#else
    for (int ph = 0; ph < NPHASE; ++ph) { a.lo = ph; a.hi = ph + 1; hipLaunchKernelGGL(mk_fwd, dim3(grid), dim3(NTHR), LDS_BYTES, stream, a); }
#endif
}
```

```cpp
#include <hip/hip_runtime.h>
#include <cstdio>
#include <cstdint>
#include <cmath>

#ifndef MK_ONE_LAUNCH
#define MK_ONE_LAUNCH 1
#endif

constexpr int BATCH = 8, SEQ = 4096, DM = 1024, M = BATCH * SEQ;
constexpr int NIN_A = 3864, NIN_C = 1600;
constexpr int PA_LD = 4096;
constexpr int PC_LD = 1792;
constexpr int PA_Q = 0, PA_KC = 512, PA_VC = 640, PA_KS = 768, PA_VS = 896, PA_KW = 1024, PA_VW = 1152,
              PA_GA = 1280, PA_CB = 1792, PA_CC = 2304, PA_CH = 2816, PA_GB = 3328, PA_GL = 3840;
constexpr int PC_CQ = 0, PC_CKV = 256, PC_G = 512, PC_KR = 1536;
constexpr float LOG2E = 1.4426950408889634f;
constexpr float QSCALE_A = 0.125f * LOG2E;
constexpr float QSCALE_C = 0.07216878364870323f * LOG2E;
constexpr float RMS_EPS = 1e-6f;

constexpr size_t MiB = 1u << 20;
constexpr size_t WS_CTL = 0, CTL_BYTES = 1 * MiB;
constexpr size_t WS_CS = 1 * MiB;
constexpr size_t WS_KCMP = 9 * MiB;
constexpr size_t WS_VCMP = 9 * MiB + 512 * 1024;
constexpr size_t WS_WTA = 16 * MiB;
constexpr size_t WS_WTOA = 24 * MiB;
constexpr size_t WS_WTC = 26 * MiB;
constexpr size_t WS_WTUQ = 30 * MiB;
constexpr size_t WS_WTUKV = 31 * MiB;
constexpr size_t WS_WTOC = 32 * MiB;
constexpr size_t WS_XN = 48 * MiB;
constexpr size_t WS_PA = 112 * MiB;
constexpr size_t WS_MIX = 368 * MiB;
constexpr size_t WS_PC = 112 * MiB;
constexpr size_t WS_Q1 = 224 * MiB;
constexpr size_t WS_KV1 = 320 * MiB;
constexpr size_t WS_CQN = 448 * MiB;
constexpr size_t WS_CKVN = 464 * MiB;
constexpr size_t WS_KPE = 480 * MiB;
constexpr size_t WS_O1 = 48 * MiB;
constexpr size_t WS_END = 484 * MiB;

constexpr int LDS_BYTES = 147456;
constexpr int NTHR = 512, NWV = 8;

typedef unsigned short bf16_t;
#define LAS __attribute__((address_space(3)))

__device__ __forceinline__ float bf2f(bf16_t v) { return __uint_as_float(((unsigned)v) << 16); }
__device__ __forceinline__ bf16_t f2bf(float f) { unsigned u = __float_as_uint(f); return (bf16_t)((u + 0x7fffu + ((u >> 16) & 1u)) >> 16); }
__device__ __forceinline__ float wave_sum(float v) {
#pragma unroll
    for (int o = 1; o < 64; o <<= 1) v += __shfl_xor(v, o);
    return v;
}
__device__ __forceinline__ float wave_max(float v) {
#pragma unroll
    for (int o = 1; o < 64; o <<= 1) v = fmaxf(v, __shfl_xor(v, o));
    return v;
}
#define WSYNC() asm volatile("s_waitcnt lgkmcnt(0)" ::: "memory")
__device__ __forceinline__ float siluf(float x) { return x / (1.f + __expf(-x)); }
__device__ __forceinline__ float sigmoidf_(float x) { return 1.f / (1.f + __expf(-x)); }

#define XB_TMO      128
#define XB_XCNT(j)  (256  + 64 * (j))
#define XB_XSUB(j)  (1280 + 64 * (j))
#define XB_XGEN(j)  (2304 + 64 * (j))
#define XB_TOP      3328
#define XB_TOPGEN   3392
#define XCD_BAR_WORDS 3456
#define XB_SPIN_CAP (1u << 24)
__device__ __forceinline__ unsigned xb_ld(unsigned* p)              { return __hip_atomic_load(p, __ATOMIC_RELAXED, __HIP_MEMORY_SCOPE_AGENT); }
__device__ __forceinline__ unsigned xb_add(unsigned* p, unsigned v) { return __hip_atomic_fetch_add(p, v, __ATOMIC_RELAXED, __HIP_MEMORY_SCOPE_AGENT); }
__device__ __forceinline__ unsigned xb_xcc_id() { return (unsigned)__builtin_amdgcn_s_getreg((3 << 11) | 20) & 0xFu; }
#define XB_SPIN(cond, bar) do { unsigned _sp = 0; while (cond) { __builtin_amdgcn_s_sleep(1); \
    if ((++_sp & 255u) == 0u) { if (xb_ld(&(bar)[XB_TMO])) break; if (_sp > XB_SPIN_CAP) { atomicAdd(&(bar)[XB_TMO], 1u); break; } } } } while (0)
struct XcdBarrier { unsigned* bar; unsigned x; volatile LAS unsigned* st; };
__device__ __forceinline__ XcdBarrier xcd_barrier_post(unsigned* bar, volatile LAS unsigned* st) {
    XcdBarrier b; b.bar = bar; b.x = xb_xcc_id(); b.st = st;
    if (threadIdx.x == 0) (void)xb_add(&bar[XB_XCNT(b.x)], 1u);
    return b;
}
__device__ __forceinline__ void xcd_barrier_complete(unsigned* bar, unsigned x, unsigned& nloc, unsigned& nx) {
    const unsigned G = gridDim.x * gridDim.y * gridDim.z;
    unsigned sum, cnt, mine, sp = 0u;
    for (;;) {
        sum = 0u; cnt = 0u; mine = 0u;
#pragma unroll
        for (unsigned j = 0; j < 16; ++j) { const unsigned c = xb_ld(&bar[XB_XCNT(j)]); sum += c; cnt += (c > 0u) ? 1u : 0u; mine = (j == x) ? c : mine; }
        if (sum == G) break;
        __builtin_amdgcn_s_sleep(1);
        if ((++sp & 255u) == 0u) { if (xb_ld(&bar[XB_TMO])) break; if (sp > XB_SPIN_CAP) { atomicAdd(&bar[XB_TMO], 1u); break; } }
    }
    nloc = mine > 0u ? mine : 1u; nx = cnt > 0u ? cnt : 1u;
}
__device__ __forceinline__ void xcd_barrier(const XcdBarrier& b) {
    asm volatile("s_waitcnt vmcnt(0)" ::: "memory");
    __syncthreads();
    if (threadIdx.x == 0) {
        unsigned* bar = b.bar;
        __builtin_amdgcn_s_waitcnt(0);
        unsigned nloc = b.st[0], nx = b.st[1];
        if (nloc == 0u) { xcd_barrier_complete(bar, b.x, nloc, nx); b.st[0] = nloc; b.st[1] = nx; }
        const unsigned old = xb_add(&bar[XB_XSUB(b.x)], 1u);
        const unsigned gen = old / nloc;
        if (old + 1u == (gen + 1u) * nloc) {
            __builtin_amdgcn_fence(__ATOMIC_RELEASE, "agent");
            asm volatile("s_waitcnt vmcnt(0)" ::: "memory");
            const unsigned og = xb_add(&bar[XB_TOP], 1u);
            const unsigned tg = og / nx;
            if (og + 1u == (tg + 1u) * nx) xb_add(&bar[XB_TOPGEN], 1u);
            else XB_SPIN(xb_ld(&bar[XB_TOPGEN]) == tg, bar);
            __builtin_amdgcn_fence(__ATOMIC_ACQUIRE, "agent");
            xb_add(&bar[XB_XGEN(b.x)], 1u);
            asm volatile("s_waitcnt vmcnt(0)" ::: "memory");
        } else {
            XB_SPIN(xb_ld(&bar[XB_XGEN(b.x)]) == gen, bar);
            __builtin_amdgcn_fence(__ATOMIC_ACQUIRE, "agent");
            asm volatile("s_waitcnt vmcnt(0)" ::: "memory");
        }
    }
    __syncthreads();
}

struct Args { const void* in[20]; float* out; unsigned char* ws; int lo, hi; };
struct Ctx {
    const float* x; const int* pos; const float* a_norm; const float* a_w_in; const float* pe_k; const float* pe_v;
    const float* w_ck1; const float* w_ck2; const float* w_cv1; const float* w_cv2; const float* conv_w; const float* a_w_out;
    const float* c_norm; const float* c_w_in; const float* q_norm; const float* kv_norm; const float* w_uq; const float* w_ukv; const float* c_w_out; const float* final_norm;
    float* out; unsigned char* ws;
    float2* CS; bf16_t* KCMP; bf16_t* VCMP; bf16_t* XN; bf16_t* PA; bf16_t* MIX; bf16_t* PC; bf16_t* Q1; bf16_t* KV1; bf16_t* CQN; bf16_t* CKVN; bf16_t* KPE; bf16_t* O1;
};

__device__ __forceinline__ void sincos_acc(float angf, float& s, float& c) {
    const double x = (double)angf;
    const double k = rint(x * 0.6366197723675814);
    double r = fma(-k, 1.5707963267948966, x);
    r = fma(-k, 6.123233995736766e-17, r);
    const double r2 = r * r;
    double sp = -1.0 / 1307674368000.0;
    sp = fma(sp, r2, 1.0 / 6227020800.0);
    sp = fma(sp, r2, -1.0 / 39916800.0);
    sp = fma(sp, r2, 1.0 / 362880.0);
    sp = fma(sp, r2, -1.0 / 5040.0);
    sp = fma(sp, r2, 1.0 / 120.0);
    sp = fma(sp, r2, -1.0 / 6.0);
    const double sn = fma(sp * r2, r, r);
    double cp = 1.0 / 20922789888000.0;
    cp = fma(cp, r2, -1.0 / 87178291200.0);
    cp = fma(cp, r2, 1.0 / 479001600.0);
    cp = fma(cp, r2, -1.0 / 3628800.0);
    cp = fma(cp, r2, 1.0 / 40320.0);
    cp = fma(cp, r2, -1.0 / 720.0);
    cp = fma(cp, r2, 1.0 / 24.0);
    cp = fma(cp, r2, -0.5);
    const double cs = fma(cp, r2, 1.0);
    const int q = ((int)(long long)k) & 3;
    const double ss = (q == 0) ? sn : (q == 1) ? cs : (q == 2) ? -sn : -cs;
    const double cc = (q == 0) ? cs : (q == 1) ? -sn : (q == 2) ? -cs : sn;
    s = (float)ss; c = (float)cc;
}

__device__ __forceinline__ void rms_row_f32(const float* xr, const float* g, bf16_t* orow, int lane) {
    float4 v[4]; float s = 0.f;
#pragma unroll
    for (int j = 0; j < 4; ++j) { v[j] = *(const float4*)(xr + 4 * lane + 256 * j); s += (v[j].x * v[j].x + v[j].y * v[j].y) + (v[j].z * v[j].z + v[j].w * v[j].w); }
    const float rstd = 1.f / sqrtf(wave_sum(s) * (1.f / DM) + RMS_EPS);
#pragma unroll
    for (int j = 0; j < 4; ++j) {
        const float4 gg = *(const float4*)(g + 4 * lane + 256 * j);
        ushort4 o; o.x = f2bf(v[j].x * rstd * gg.x); o.y = f2bf(v[j].y * rstd * gg.y); o.z = f2bf(v[j].z * rstd * gg.z); o.w = f2bf(v[j].w * rstd * gg.w);
        *(ushort4*)(orow + 4 * lane + 256 * j) = o;
    }
}

namespace pg8 {
#define PG8_LAS __attribute__((address_space(3)))
typedef unsigned short bf16_t;
typedef short bf16x8 __attribute__((ext_vector_type(8)));
typedef float f32x4 __attribute__((ext_vector_type(4)));
typedef unsigned u32x4 __attribute__((ext_vector_type(4)));
constexpr int BM = 256, BK = 64, HALF = 128, HTB = HALF * BK * 2  , STAGE_BYTES = 8 * HTB, NXCD = 8, WGM = 8;

__host__ __device__ __forceinline__ int lds_byte(int r, int c) { const int st = (r >> 4) * 2 + (c >> 5), rr = r & 15, cc = c & 31, ob = rr * 64 + cc * 2; return st * 1024 + (ob ^ (((ob >> 9) & 1) << 5)); }
__host__ __device__ __forceinline__ void stage_rc(int b, int& R, int& C) { const int st = b / 1024, sb = b % 1024, swz = sb ^ (((sb >> 9) & 1) << 5); R = (st >> 1) * 16 + swz / 64; C = (st & 1) * 32 + (swz % 64) / 2; }
__host__ __device__ __forceinline__ int perm32(int rho) { const int n = rho >> 4, i = rho & 15; return 8 * (i >> 2) + 4 * n + (i & 3); }

struct Unit { int pm, pn; };
struct Gemm { const bf16_t* A; const bf16_t* Bt; int M, N, K; };

struct StaticOrder {
    int nM, nN, nwg, G, c;
    __host__ __device__ void init(int M, int N, int G_, int c_) { nM = M / BM; nN = N / BM; nwg = nM * nN; G = G_; c = c_; }
    __host__ __device__ bool next(int i, Unit& u) const {
        const long L = (long)i * G + c; if (L >= nwg) return false;
        int wgid = (int)L; { const int q = nwg / NXCD, r = nwg % NXCD, xcd = wgid % NXCD, off = wgid / NXCD; wgid = (xcd < r ? xcd * (q + 1) : r * (q + 1) + (xcd - r) * q) + off; }
        const int nig = WGM * nN, gid = wgid / nig, fm = gid * WGM, gsz = (nM - fm) < WGM ? (nM - fm) : WGM;
        u.pm = fm + ((wgid % nig) % gsz); u.pn = (wgid % nig) / gsz; return true;
    }
    __device__ __forceinline__ void a_ready(const Unit&) const {}
    __device__ __forceinline__ void done(const Unit&) const {}
};

__device__ __forceinline__ unsigned cvt_pk_bf16(float lo, float hi) { unsigned r; asm volatile("v_cvt_pk_bf16_f32 %0, %1, %2" : "=v"(r) : "v"(lo), "v"(hi)); return r; }

struct EpiPA {
    static constexpr bool PERM = true, AFTER_DRAIN = false;
    bf16_t* PA; const float2* CS;
    __device__ __forceinline__ void operator()(const f32x4 (&acc)[2][2][4][2], const Unit& u, int wr, int wc, int fr, int fq) const {
        const int row0 = u.pm * BM + wr * 64 + fr;
        if (u.pn < 3) {
            const int base = (u.pn == 0) ? 64 * wc : (u.pn == 1) ? 256 + 64 * wc : (wc < 2 ? 768 + 64 * wc : 1024 + 64 * (wc - 2));
            const float sc = u.pn < 2 ? QSCALE_A : 1.f;
#pragma unroll
            for (int ai = 0; ai < 2; ++ai)
#pragma unroll
                for (int m = 0; m < 4; ++m) {
                    const int row = row0 + ai * HALF + m * 16;
                    const f32x4* csp = (const f32x4*)(CS + (size_t)row * 32 + 8 * fq);
                    const f32x4 t0 = csp[0], t1 = csp[1], t2 = csp[2], t3 = csp[3];
                    const f32x4 a0 = acc[ai][0][m][0], a1 = acc[ai][0][m][1], b0 = acc[ai][1][m][0], b1 = acc[ai][1][m][1];
                    u32x4 w1, w2;
                    w1.x = cvt_pk_bf16((a0[0] * t0[0] - b0[0] * t0[1]) * sc, (a0[1] * t0[2] - b0[1] * t0[3]) * sc);
                    w1.y = cvt_pk_bf16((a0[2] * t1[0] - b0[2] * t1[1]) * sc, (a0[3] * t1[2] - b0[3] * t1[3]) * sc);
                    w1.z = cvt_pk_bf16((a1[0] * t2[0] - b1[0] * t2[1]) * sc, (a1[1] * t2[2] - b1[1] * t2[3]) * sc);
                    w1.w = cvt_pk_bf16((a1[2] * t3[0] - b1[2] * t3[1]) * sc, (a1[3] * t3[2] - b1[3] * t3[3]) * sc);
                    w2.x = cvt_pk_bf16((b0[0] * t0[0] + a0[0] * t0[1]) * sc, (b0[1] * t0[2] + a0[1] * t0[3]) * sc);
                    w2.y = cvt_pk_bf16((b0[2] * t1[0] + a0[2] * t1[1]) * sc, (b0[3] * t1[2] + a0[3] * t1[3]) * sc);
                    w2.z = cvt_pk_bf16((b1[0] * t2[0] + a1[0] * t2[1]) * sc, (b1[1] * t2[2] + a1[1] * t2[3]) * sc);
                    w2.w = cvt_pk_bf16((b1[2] * t3[0] + a1[2] * t3[1]) * sc, (b1[3] * t3[2] + a1[3] * t3[3]) * sc);
                    bf16_t* rp = PA + (size_t)row * PA_LD + base + 8 * fq;
                    *(u32x4*)rp = w1; *(u32x4*)(rp + 32) = w2;
                }
        } else {
            const int cb0 = (u.pn == 3) ? 512 : (u.pn == 4) ? 896 : 256 * u.pn;
            const int cb1 = (u.pn == 3) ? 640 : (u.pn == 4) ? 1152 : 256 * u.pn + 128;
#pragma unroll
            for (int ai = 0; ai < 2; ++ai)
#pragma unroll
                for (int m = 0; m < 4; ++m) {
                    bf16_t* rp = PA + (size_t)(row0 + ai * HALF + m * 16) * PA_LD + 32 * wc + 8 * fq;
#pragma unroll
                    for (int bj = 0; bj < 2; ++bj) { const f32x4 v0 = acc[ai][bj][m][0], v1 = acc[ai][bj][m][1];
                        u32x4 w; w.x = cvt_pk_bf16(v0[0], v0[1]); w.y = cvt_pk_bf16(v0[2], v0[3]); w.z = cvt_pk_bf16(v1[0], v1[1]); w.w = cvt_pk_bf16(v1[2], v1[3]);
                        *(u32x4*)(rp + (bj ? cb1 : cb0)) = w; }
                }
        }
    }
};
struct EpiPlain {
    static constexpr bool PERM = true, AFTER_DRAIN = false;
    bf16_t* O; int ldc;
    __device__ __forceinline__ void operator()(const f32x4 (&acc)[2][2][4][2], const Unit& u, int wr, int wc, int fr, int fq) const {
        const int row0 = u.pm * BM + wr * 64 + fr; const int col0 = u.pn * BM + wc * 32 + 8 * fq;
#pragma unroll
        for (int ai = 0; ai < 2; ++ai)
#pragma unroll
            for (int m = 0; m < 4; ++m) { bf16_t* rp = O + (size_t)(row0 + ai * HALF + m * 16) * ldc + col0;
#pragma unroll
                for (int bj = 0; bj < 2; ++bj) { const f32x4 v0 = acc[ai][bj][m][0], v1 = acc[ai][bj][m][1];
                    u32x4 w; w.x = cvt_pk_bf16(v0[0], v0[1]); w.y = cvt_pk_bf16(v0[2], v0[3]); w.z = cvt_pk_bf16(v1[0], v1[1]); w.w = cvt_pk_bf16(v1[2], v1[3]);
                    *(u32x4*)(rp + bj * HALF) = w; } }
    }
};
struct EpiRes {
    static constexpr bool PERM = false, AFTER_DRAIN = false;
    const float* base; float* out;
    __device__ __forceinline__ void operator()(const f32x4 (&acc)[2][2][4][2], const Unit& u, int wr, int wc, int fr, int fq) const {
        const int row0 = u.pm * BM + wr * 64 + fr; const int col0 = u.pn * BM + wc * 32 + 4 * fq;
#pragma unroll
        for (int ai = 0; ai < 2; ++ai)
#pragma unroll
            for (int m = 0; m < 4; ++m) { const size_t off = (size_t)(row0 + ai * HALF + m * 16) * 1024 + col0;
#pragma unroll
                for (int bj = 0; bj < 2; ++bj)
#pragma unroll
                    for (int n = 0; n < 2; ++n) { const f32x4 b = *(const f32x4*)(base + off + bj * HALF + n * 16); *(f32x4*)(out + off + bj * HALF + n * 16) = b + acc[ai][bj][m][n]; } }
    }
};
template <class Epi, class Sched, bool ALIGN_EPI = false, bool SP2 = false>
__device__ __forceinline__ void gemm_phase(PG8_LAS unsigned char* lds, const Gemm g, const Sched& S, const Epi& E) {
    const int tid = threadIdx.x, wid = __builtin_amdgcn_readfirstlane(tid >> 6), lane = tid & 63, wr = wid >> 2, wc = wid & 3, fr = lane & 15, fq = lane >> 4;
    const int K = g.K, nt = K / BK;
    unsigned voffA[2], voffB[2];
#pragma unroll
    for (int i = 0; i < 2; ++i) { int R, C; stage_rc(tid * 16 + i * 8192, R, C); const int Rb = Epi::PERM ? ((R & ~31) + perm32(R & 31)) : R;
        voffA[i] = (unsigned)(R * K + C) * 2u; voffB[i] = (unsigned)(Rb * K + C) * 2u; }
    const size_t kstep = (size_t)(BK * 2);
    const size_t hstep = (size_t)HALF * K * 2;
    const size_t tstep = 2 * hstep;
    const unsigned ldsw = (unsigned)wid * 1024u;
    const int aoff = lds_byte(wr * 64 + fr, fq * 8), boff = lds_byte(wc * 32 + fr, fq * 8);
#define PG8_SA(b, h) (((b) * 2 + (h)) * HTB)
#define PG8_SB(b, h) ((4 + (b) * 2 + (h)) * HTB)
#define PG8_STAGE(bufoff, gbase, voff) do { _Pragma("unroll") for (int _i = 0; _i < 2; ++_i) \
        __builtin_amdgcn_global_load_lds((const unsigned*)((const char*)(gbase) + (voff)[_i]), (PG8_LAS unsigned*)(lds + (bufoff) + ldsw + _i * 8192), 16, 0, 0); } while (0)
#define PG8_LDA(dst, b, h) do { _Pragma("unroll") for (int m = 0; m < 4; ++m) _Pragma("unroll") for (int k = 0; k < 2; ++k) dst[m][k] = *(const PG8_LAS bf16x8*)(lds + PG8_SA(b, h) + aoff + m * 2048 + k * 1024); } while (0)
#define PG8_LDB(dst, b, h) do { _Pragma("unroll") for (int n = 0; n < 2; ++n) _Pragma("unroll") for (int k = 0; k < 2; ++k) dst[n][k] = *(const PG8_LAS bf16x8*)(lds + PG8_SB(b, h) + boff + n * 2048 + k * 1024); } while (0)
#define PG8_MMA(ai, bj, At, Bt) do { __builtin_amdgcn_s_setprio(1); _Pragma("unroll") for (int m = 0; m < 4; ++m) _Pragma("unroll") for (int n = 0; n < 2; ++n) _Pragma("unroll") for (int k = 0; k < 2; ++k) \
        acc[ai][bj][m][n] = __builtin_amdgcn_mfma_f32_16x16x32_bf16(Bt[n][k], At[m][k], acc[ai][bj][m][n], 0, 0, 0); __builtin_amdgcn_s_setprio(0); } while (0)
#define PG8_WAIT_V(n) asm volatile("s_waitcnt vmcnt(" #n ")" ::: "memory")
#define PG8_WAIT_L(n) asm volatile("s_waitcnt lgkmcnt(" #n ")" ::: "memory")
#define PG8_BAR __builtin_amdgcn_s_barrier()
#define PG8_SCHED __builtin_amdgcn_sched_barrier(0)
    Unit cur, nxt; int ui = 0;
    if (!S.next(0, cur)) return;
    f32x4 acc[2][2][4][2];
#pragma unroll
    for (int a = 0; a < 2; ++a)
#pragma unroll
        for (int b = 0; b < 2; ++b)
#pragma unroll
            for (int m = 0; m < 4; ++m)
#pragma unroll
                for (int n = 0; n < 2; ++n) acc[a][b][m][n] = (f32x4){0.f, 0.f, 0.f, 0.f};
    bf16x8 At[4][2], B0[2][2], B1[2][2];
    const char* cA = (const char*)g.A + (size_t)cur.pm * tstep; const char* cB = (const char*)g.Bt + (size_t)cur.pn * tstep;
    S.a_ready(cur);
    if constexpr (SP2) {
        PG8_STAGE(PG8_SB(0, 0), cB, voffB); PG8_STAGE(PG8_SB(0, 1), cB + hstep, voffB); PG8_STAGE(PG8_SA(0, 0), cA, voffA); PG8_STAGE(PG8_SA(0, 1), cA + hstep, voffA);
        if (wr == 1) PG8_BAR;
        PG8_WAIT_V(2); PG8_BAR;
        PG8_STAGE(PG8_SB(1, 0), cB + kstep, voffB); PG8_STAGE(PG8_SA(1, 0), cA + kstep, voffA); PG8_STAGE(PG8_SB(1, 1), cB + hstep + kstep, voffB);
        PG8_WAIT_V(6); PG8_BAR;
    } else {
        PG8_STAGE(PG8_SB(0, 0), cB, voffB); PG8_STAGE(PG8_SA(0, 0), cA, voffA); PG8_STAGE(PG8_SB(0, 1), cB + hstep, voffB); PG8_STAGE(PG8_SA(0, 1), cA + hstep, voffA);
        if (wr == 1) PG8_BAR;
        PG8_WAIT_V(4); PG8_BAR;
        PG8_STAGE(PG8_SB(1, 0), cB + kstep, voffB); PG8_STAGE(PG8_SA(1, 0), cA + kstep, voffA); PG8_STAGE(PG8_SB(1, 1), cB + hstep + kstep, voffB);
        PG8_WAIT_V(6); PG8_BAR;
    }
    for (;;) {
        const bool has_next = S.next(ui + 1, nxt);
        const char* nA = has_next ? (const char*)g.A + (size_t)nxt.pm * tstep : cA; const char* nB = has_next ? (const char*)g.Bt + (size_t)nxt.pn * tstep : cB;
        for (int t = 0; t < nt; t += 2) {
            const bool last = (t == nt - 2);
            const char* a1 = cA + (size_t)(t + 1) * kstep;
            const char* a2 = last ? nA : cA + (size_t)(t + 2) * kstep; const char* b2 = last ? nB : cB + (size_t)(t + 2) * kstep;
            const char* a3 = a2 + kstep; const char* b3 = b2 + kstep;
            if (last && has_next) S.a_ready(nxt);
            if constexpr (SP2) {
            PG8_LDB(B0, 0, 0); PG8_LDB(B1, 0, 1); PG8_SCHED; PG8_LDA(At, 0, 0); PG8_STAGE(PG8_SA(1, 1), a1 + hstep, voffA);
            PG8_WAIT_V(8); PG8_WAIT_L(0); PG8_BAR; PG8_MMA(0, 0, At, B0); PG8_MMA(0, 1, At, B1); PG8_BAR; PG8_SCHED;
            PG8_LDA(At, 0, 1); PG8_STAGE(PG8_SB(0, 0), b2, voffB); PG8_STAGE(PG8_SB(0, 1), b2 + hstep, voffB); PG8_STAGE(PG8_SA(0, 0), a2, voffA);
            PG8_WAIT_V(8); PG8_WAIT_L(0); PG8_BAR; PG8_MMA(1, 0, At, B0); PG8_MMA(1, 1, At, B1); PG8_BAR; PG8_SCHED;
            PG8_LDB(B0, 1, 0); PG8_LDB(B1, 1, 1); PG8_SCHED; PG8_LDA(At, 1, 0); PG8_STAGE(PG8_SA(0, 1), a2 + hstep, voffA);
            PG8_WAIT_V(8); PG8_WAIT_L(0); PG8_BAR; PG8_MMA(0, 0, At, B0); PG8_MMA(0, 1, At, B1); PG8_BAR; PG8_SCHED;
            PG8_LDA(At, 1, 1); PG8_STAGE(PG8_SB(1, 0), b3, voffB); PG8_STAGE(PG8_SB(1, 1), b3 + hstep, voffB); PG8_STAGE(PG8_SA(1, 0), a3, voffA);
            PG8_WAIT_V(8); PG8_WAIT_L(0); PG8_BAR; PG8_MMA(1, 0, At, B0); PG8_MMA(1, 1, At, B1); PG8_BAR; PG8_SCHED;
            } else {
            PG8_LDB(B0, 0, 0); PG8_SCHED; PG8_LDA(At, 0, 0); PG8_STAGE(PG8_SA(1, 1), a1 + hstep, voffA);
            PG8_WAIT_L(8); PG8_BAR; PG8_WAIT_L(0); PG8_MMA(0, 0, At, B0); PG8_BAR; PG8_SCHED;
            PG8_LDB(B1, 0, 1); PG8_STAGE(PG8_SB(0, 0), b2, voffB);
            PG8_BAR; PG8_WAIT_L(0); PG8_MMA(0, 1, At, B1); PG8_BAR;
            PG8_LDA(At, 0, 1); PG8_STAGE(PG8_SA(0, 0), a2, voffA);
            PG8_BAR; PG8_WAIT_L(0); PG8_MMA(1, 0, At, B0); PG8_BAR; PG8_SCHED;
            PG8_STAGE(PG8_SB(0, 1), b2 + hstep, voffB);
            PG8_WAIT_V(6); PG8_BAR; PG8_MMA(1, 1, At, B1); PG8_BAR;
            PG8_LDB(B0, 1, 0); PG8_SCHED; PG8_LDA(At, 1, 0); PG8_STAGE(PG8_SA(0, 1), a2 + hstep, voffA);
            PG8_WAIT_L(8); PG8_BAR; PG8_WAIT_L(0); PG8_MMA(0, 0, At, B0); PG8_BAR; PG8_SCHED;
            PG8_LDB(B1, 1, 1); PG8_STAGE(PG8_SB(1, 0), b3, voffB);
            PG8_BAR; PG8_WAIT_L(0); PG8_MMA(0, 1, At, B1); PG8_BAR;
            PG8_LDA(At, 1, 1); PG8_STAGE(PG8_SA(1, 0), a3, voffA);
            PG8_BAR; PG8_WAIT_L(0); PG8_MMA(1, 0, At, B0); PG8_BAR; PG8_SCHED;
            PG8_STAGE(PG8_SB(1, 1), b3 + hstep, voffB);
            PG8_WAIT_V(6); PG8_BAR; PG8_MMA(1, 1, At, B1); PG8_BAR;
            }
        }
        if constexpr (ALIGN_EPI) { if (wr == 0) PG8_BAR; }
        if constexpr (!Epi::AFTER_DRAIN) { E(acc, cur, wr, wc, fr, fq); S.done(cur); }
        if (!has_next) break;
#pragma unroll
        for (int a = 0; a < 2; ++a)
#pragma unroll
            for (int b = 0; b < 2; ++b)
#pragma unroll
                for (int m = 0; m < 4; ++m)
#pragma unroll
                    for (int n = 0; n < 2; ++n) acc[a][b][m][n] = (f32x4){0.f, 0.f, 0.f, 0.f};
        cur = nxt; cA = nA; cB = nB; ++ui;
        if constexpr (ALIGN_EPI) { if (wr == 1) PG8_BAR; }
    }
    PG8_WAIT_V(0);
    if constexpr (!ALIGN_EPI) { if (wr == 0) PG8_BAR; }
    PG8_BAR;
    if constexpr (Epi::AFTER_DRAIN) { E.fused(acc, cur, wr, wc, fr, fq, lds, wid, lane); S.done(cur); }
#undef PG8_SA
#undef PG8_SB
#undef PG8_STAGE
#undef PG8_LDA
#undef PG8_LDB
#undef PG8_MMA
#undef PG8_WAIT_V
#undef PG8_WAIT_L
#undef PG8_BAR
#undef PG8_SCHED
}
}

template <class Epi>
__device__ __forceinline__ void gemm_naive(const bf16_t* A, int lda, const float* W, int K, int N, unsigned char* lds, Epi epi) {
    float (*As)[132] = (float (*)[132])lds;
    float (*Bs)[128] = (float (*)[128])(lds + 16 * 132 * 4);
    const int tid = threadIdx.x, tx = tid & 31, ty = tid >> 5;
    const int ntm = M / 128, ntn = (N + 127) / 128;
    for (int tile = blockIdx.x; tile < ntm * ntn; tile += gridDim.x) {
        const int tm = tile / ntn, tn = tile % ntn;
        float acc[8][4];
#pragma unroll
        for (int i = 0; i < 8; ++i)
#pragma unroll
            for (int j = 0; j < 4; ++j) acc[i][j] = 0.f;
        for (int k0 = 0; k0 < K; k0 += 16) {
            {   const int r = tid >> 2, kq = (tid & 3) * 4;
                const ushort4 v = *(const ushort4*)(A + (size_t)(tm * 128 + r) * lda + k0 + kq);
                As[kq + 0][r] = bf2f(v.x); As[kq + 1][r] = bf2f(v.y); As[kq + 2][r] = bf2f(v.z); As[kq + 3][r] = bf2f(v.w); }
            {   const int kk = tid >> 5, n4 = (tid & 31) * 4; const int n = tn * 128 + n4;
                const float* wp = W + (size_t)(k0 + kk) * N + n;
                float4 v;
                v.x = (n + 0 < N) ? wp[0] : 0.f; v.y = (n + 1 < N) ? wp[1] : 0.f; v.z = (n + 2 < N) ? wp[2] : 0.f; v.w = (n + 3 < N) ? wp[3] : 0.f;
                *(float4*)&Bs[kk][n4] = v; }
            __syncthreads();
#pragma unroll 2
            for (int kk = 0; kk < 16; ++kk) {
                const float4 a0 = *(const float4*)&As[kk][ty * 8], a1 = *(const float4*)&As[kk][ty * 8 + 4];
                const float4 b = *(const float4*)&Bs[kk][tx * 4];
                const float a[8] = {a0.x, a0.y, a0.z, a0.w, a1.x, a1.y, a1.z, a1.w};
                const float bb[4] = {b.x, b.y, b.z, b.w};
#pragma unroll
                for (int i = 0; i < 8; ++i)
#pragma unroll
                    for (int j = 0; j < 4; ++j) acc[i][j] = fmaf(a[i], bb[j], acc[i][j]);
            }
            __syncthreads();
        }
#pragma unroll
        for (int i = 0; i < 8; ++i)
#pragma unroll
            for (int j = 0; j < 4; ++j) { const int m = tm * 128 + ty * 8 + i, n = tn * 128 + tx * 4 + j; if (n < N) epi(m, n, acc[i][j]); }
    }
}

__device__ __forceinline__ int natA(int p) {
    if (p < 768) { const int T = p >> 8, q = p & 255, half = q >> 7, hh = (q & 127) >> 5, i = q & 31;
        const int base = (T == 0) ? 64 * hh : (T == 1) ? 256 + 64 * hh : (hh < 2 ? 768 + 64 * hh : 1024 + 64 * (hh - 2));
        return base + 32 * half + i; }
    if (p < 1024) return 512 + (p - 768);
    if (p < 1152) return 896 + (p - 1024);
    if (p < 1280) return p;
    if (p < 3840) return p + 24;
    if (p < 3864) return 1280 + (p - 3840);
    return -1;
}
__device__ __forceinline__ int natC(int p) { return p < 512 ? p : (p < 1536 ? p + 64 : (p < 1600 ? 512 + (p - 1536) : -1)); }
__device__ __forceinline__ unsigned pk2(float lo, float hi) { return (unsigned)f2bf(lo) | ((unsigned)f2bf(hi) << 16); }
template <int MAP>
__device__ __forceinline__ void transpose_item(const float* W, int K, int Nsrc, int Ndst, bf16_t* WT, float* scr, int item, int lane) {
    const int nblk = Ndst / 32, kb = item / nblk, nb = item % nblk, k0 = 64 * kb, p0 = 32 * nb;
    const int p = p0 + (lane & 31);
    const int sc = (MAP == 0) ? natA(p) : (MAP == 1) ? natC(p) : p;
#pragma unroll 8
    for (int i = 0; i < 32; ++i) { const int kk = 2 * i + (lane >> 5); scr[kk * 33 + (lane & 31)] = (sc >= 0) ? W[(size_t)(k0 + kk) * Nsrc + sc] : 0.f; }
    WSYNC();
    const int c = lane & 7;
#pragma unroll
    for (int j = 0; j < 4; ++j) { const int n = (lane >> 3) + 8 * j; const float* sp = scr + (8 * c) * 33 + n;
        uint4 o; o.x = pk2(sp[0 * 33], sp[1 * 33]); o.y = pk2(sp[2 * 33], sp[3 * 33]); o.z = pk2(sp[4 * 33], sp[5 * 33]); o.w = pk2(sp[6 * 33], sp[7 * 33]);
        *(uint4*)(WT + (size_t)(p0 + n) * K + k0 + 8 * c) = o; }
    WSYNC();
}
__device__ __forceinline__ void ph0_weights(const Ctx& c, unsigned char* lds) {
    const int lane = threadIdx.x & 63, wave = threadIdx.x >> 6;
    float* scr = (float*)(lds + wave * 16384);
    const int gw = blockIdx.x * NWV + wave, NGW = gridDim.x * NWV;
    constexpr int I_A = 16 * 128, I_OA = 16 * 32, I_C = 16 * 56, I_UQ = 4 * 48, I_UKV = 4 * 64, I_OC = 16 * 32;
    constexpr int NITEMS = I_A + I_OA + I_C + I_UQ + I_UKV + I_OC;
    for (int it = gw; it < NITEMS; it += NGW) {
        int r = it;
        if (r < I_A) { transpose_item<0>(c.a_w_in, 1024, NIN_A, 4096, (bf16_t*)(c.ws + WS_WTA), scr, r, lane); continue; } r -= I_A;
        if (r < I_OA) { transpose_item<2>(c.a_w_out, 1024, 1024, 1024, (bf16_t*)(c.ws + WS_WTOA), scr, r, lane); continue; } r -= I_OA;
        if (r < I_C) { transpose_item<1>(c.c_w_in, 1024, NIN_C, 1792, (bf16_t*)(c.ws + WS_WTC), scr, r, lane); continue; } r -= I_C;
        if (r < I_UQ) { transpose_item<2>(c.w_uq, 256, 1536, 1536, (bf16_t*)(c.ws + WS_WTUQ), scr, r, lane); continue; } r -= I_UQ;
        if (r < I_UKV) { transpose_item<2>(c.w_ukv, 256, 2048, 2048, (bf16_t*)(c.ws + WS_WTUKV), scr, r, lane); continue; } r -= I_UKV;
        transpose_item<2>(c.c_w_out, 1024, 1024, 1024, (bf16_t*)(c.ws + WS_WTOC), scr, r, lane);
    }
}

__device__ __forceinline__ void ph0_prologue(const Ctx& c) {
    for (int idx = blockIdx.x * NTHR + threadIdx.x; idx < M * 32; idx += gridDim.x * NTHR) {
        const int m = idx >> 5, i = idx & 31;
        const float invf = (float)exp2(-(double)i * (13.287712379549449 / 32.0));
        const float ang = (float)c.pos[m] * invf;
        float s, co; sincos_acc(ang, s, co);
        c.CS[idx] = make_float2(co, s);
    }
    const int lane = threadIdx.x & 63, gw = blockIdx.x * NWV + (threadIdx.x >> 6), NGW = gridDim.x * NWV;
    for (int m = gw; m < M; m += NGW) rms_row_f32(c.x + (size_t)m * DM, c.a_norm, c.XN + (size_t)m * DM, lane);
}
__device__ __forceinline__ int pa_col(int n) { return n < 1280 ? n : (n < 1304 ? PA_GL + (n - 1280) : n - 24); }
__device__ __forceinline__ int pc_col(int n) { return n < 512 ? n : (n < 576 ? PC_KR + (n - 512) : n - 64); }

__device__ __forceinline__ void ph2_rope_a(const Ctx& c) {
    for (size_t idx = (size_t)blockIdx.x * NTHR + threadIdx.x; idx < (size_t)M * 12 * 32; idx += (size_t)gridDim.x * NTHR) {
        const int i = (int)(idx & 31); const size_t r = idx >> 5; const int slot = (int)(r % 12); const int m = (int)(r / 12);
        const int base = slot < 8 ? PA_Q + slot * 64 : (slot < 10 ? PA_KS + (slot - 8) * 64 : PA_KW + (slot - 10) * 64);
        const float sc = slot < 8 ? QSCALE_A : 1.f;
        bf16_t* p = c.PA + (size_t)m * PA_LD + base + i;
        const float x1 = bf2f(p[0]), x2 = bf2f(p[32]);
        const float2 cs = c.CS[(size_t)m * 32 + i];
        p[0] = f2bf((x1 * cs.x - x2 * cs.y) * sc); p[32] = f2bf((x2 * cs.x + x1 * cs.y) * sc);
    }
}

__device__ __forceinline__ void ph3_compress(const Ctx& c, unsigned char* lds) {
    float* blk = (float*)lds;
    float* part = blk + 8 * 2048;
    float* hid = part + 4 * 8 * 128;
    float* outp = hid + 8 * 128;
    float* outs = outp + 8 * 8 * 64;
    const int tid = threadIdx.x;
    for (int item = blockIdx.x; item < 2 * BATCH * 2 * 32; item += gridDim.x) {
        const int ct = item & 31, g = (item >> 5) & 1, b = (item >> 6) & 7, kv = item >> 9;
        const float* pe = kv ? c.pe_v : c.pe_k; const float* w1 = kv ? c.w_cv1 : c.w_ck1; const float* w2 = kv ? c.w_cv2 : c.w_ck2;
        const int col0 = (kv ? PA_VC : PA_KC) + g * 64;
        __syncthreads();
        for (int e = tid; e < 8 * 2048; e += NTHR) {
            const int ci = e >> 11, k = e & 2047, l = k >> 6, d = k & 63; const int cidx = ct * 8 + ci;
            float v = 0.f;
            if (cidx < 255) v = bf2f(c.PA[(size_t)(b * SEQ + 16 * cidx + l) * PA_LD + col0 + d]) + pe[l * 64 + d];
            blk[e] = v;
        }
        __syncthreads();
        {   const int j = tid & 127, pt = tid >> 7;
            float acc[8];
#pragma unroll
            for (int ci = 0; ci < 8; ++ci) acc[ci] = 0.f;
            for (int k = pt * 512; k < pt * 512 + 512; ++k) {
                const float w = w1[(size_t)k * 128 + j];
#pragma unroll
                for (int ci = 0; ci < 8; ++ci) acc[ci] = fmaf(blk[ci * 2048 + k], w, acc[ci]);
            }
#pragma unroll
            for (int ci = 0; ci < 8; ++ci) part[(pt * 8 + ci) * 128 + j] = acc[ci];
        }
        __syncthreads();
        for (int e = tid; e < 8 * 128; e += NTHR) { const int ci = e >> 7, j = e & 127; const float s = (part[(0 * 8 + ci) * 128 + j] + part[(1 * 8 + ci) * 128 + j]) + (part[(2 * 8 + ci) * 128 + j] + part[(3 * 8 + ci) * 128 + j]); hid[e] = siluf(s); }
        __syncthreads();
        {   const int d = tid & 63, pt = tid >> 6;
            float acc[8];
#pragma unroll
            for (int ci = 0; ci < 8; ++ci) acc[ci] = 0.f;
            for (int j = pt * 16; j < pt * 16 + 16; ++j) {
                const float w = w2[j * 64 + d];
#pragma unroll
                for (int ci = 0; ci < 8; ++ci) acc[ci] = fmaf(hid[ci * 128 + j], w, acc[ci]);
            }
#pragma unroll
            for (int ci = 0; ci < 8; ++ci) outp[(pt * 8 + ci) * 64 + d] = acc[ci];
        }
        __syncthreads();
        {   const int ci = tid >> 6, d = tid & 63; float s = 0.f;
#pragma unroll
            for (int pt = 0; pt < 8; ++pt) s += outp[(pt * 8 + ci) * 64 + d];
            outs[ci * 64 + d] = s; }
        __syncthreads();
        {   const int ci = tid >> 6, d = tid & 63; const int cidx = ct * 8 + ci;
            float v = outs[ci * 64 + d];
            if (kv == 0 && cidx < 255) {
                const int i = d & 31; const float2 cs = c.CS[(size_t)(b * SEQ + 16 * cidx + 31) * 32 + i];
                const float x1 = outs[ci * 64 + i], x2 = outs[ci * 64 + i + 32];
                v = (d < 32) ? (x1 * cs.x - x2 * cs.y) : (x2 * cs.x + x1 * cs.y);
            }
            if (cidx >= 255) v = 0.f;
            bf16_t* dst = (kv ? c.VCMP : c.KCMP) + ((size_t)(b * 2 + g) * 256 + cidx) * 64 + d;
            *dst = f2bf(v);
        }
    }
    __syncthreads();
}

__device__ __forceinline__ float dot64(const bf16_t* krow, const float* q) {
    float s = 0.f;
#pragma unroll
    for (int ch = 0; ch < 8; ++ch) {
        const uint4 v = *(const uint4*)(krow + ch * 8);
        const unsigned w[4] = {v.x, v.y, v.z, v.w};
#pragma unroll
        for (int e = 0; e < 4; ++e) { s = fmaf(__uint_as_float(w[e] << 16), q[ch * 8 + 2 * e], s); s = fmaf(__uint_as_float(w[e] & 0xffff0000u), q[ch * 8 + 2 * e + 1], s); }
    }
    return s;
}

__device__ __forceinline__ void ph4_nsa(const Ctx& c, unsigned char* lds) {
    const int lane = threadIdx.x & 63, wave = threadIdx.x >> 6;
    float* wq = (float*)(lds + wave * 12288);
    float* wp = wq + 64;
    float* wpc = wp + 1024;
    float* wres = wpc + 1024;
    const int gw = blockIdx.x * NWV + wave, NGW = gridDim.x * NWV;
    for (int item = gw; item < M * 2; item += NGW) {
        const int g = item & 1, m = item >> 1; const int b = m / SEQ, t = m % SEQ;
        const bf16_t* parow = c.PA + (size_t)m * PA_LD;
        const bf16_t* pab = c.PA + (size_t)b * SEQ * PA_LD;
        const bf16_t* kc = c.KCMP + (size_t)(b * 2 + g) * 256 * 64; const bf16_t* vc = c.VCMP + (size_t)(b * 2 + g) * 256 * 64;
        const int nvalid = t >= 31 ? min((t - 31) / 16 + 1, 255) : 0;
        for (int hh = 0; hh < 4; ++hh) {
            const int head = g * 4 + hh;
            WSYNC(); wq[lane] = bf2f(parow[PA_Q + head * 64 + lane]); WSYNC();
            float s[4]; float mx = -INFINITY;
#pragma unroll
            for (int jj = 0; jj < 4; ++jj) { const int ci = lane + 64 * jj; s[jj] = (ci < nvalid) ? dot64(kc + (size_t)ci * 64, wq) : -INFINITY; mx = fmaxf(mx, s[jj]); }
            mx = wave_max(mx);
            float sum = 0.f;
#pragma unroll
            for (int jj = 0; jj < 4; ++jj) { s[jj] = (nvalid > 0) ? exp2f(s[jj] - mx) : 0.f; sum += s[jj]; }
            sum = wave_sum(sum);
            const float inv = nvalid > 0 ? 1.f / sum : 0.f;
#pragma unroll
            for (int jj = 0; jj < 4; ++jj) wpc[hh * 256 + lane + 64 * jj] = s[jj] * inv;
            WSYNC();
            float o = 0.f;
            for (int ci = 0; ci < nvalid; ++ci) o = fmaf(wpc[hh * 256 + ci], bf2f(vc[(size_t)ci * 64 + lane]), o);
            wres[(hh * 3 + 0) * 64 + lane] = o;
        }
        unsigned long long selmask;
        {   const int n = lane; float imp = 0.f;
            const int c_lo = max(4 * n - 1, 0), c_hi = min(4 * n + 3, 254);
            for (int hh = 0; hh < 4; ++hh) for (int ci = c_lo; ci <= c_hi; ++ci) imp += wpc[hh * 256 + ci];
            const bool bv = (64 * n <= t); const int cur = t >> 6;
            const bool forced = (n == 0) || (n == cur) || (n == cur - 1);
            const float sc = bv ? (forced ? 1e4f : imp) : -1.f;
            int rank = 0;
            for (int mm = 0; mm < 64; ++mm) { const float o = __shfl(sc, mm); rank += (o > sc || (o == sc && mm < n)) ? 1 : 0; }
            selmask = __ballot(rank < 16 && bv);
        }
        for (int hh = 0; hh < 4; ++hh) {
            const int head = g * 4 + hh;
            WSYNC(); wq[lane] = bf2f(parow[PA_Q + head * 64 + lane]); WSYNC();
            {   unsigned long long sm = selmask; int slot = 0; float mx = -INFINITY;
                while (sm) { const int n = __builtin_ctzll(sm); sm &= sm - 1; const int tok = n * 64 + lane;
                    const float s = (tok <= t) ? dot64(pab + (size_t)tok * PA_LD + PA_KS + g * 64, wq) : -INFINITY;
                    wp[slot * 64 + lane] = s; mx = fmaxf(mx, s); ++slot; }
                mx = wave_max(mx);
                float sum = 0.f;
                for (int sl = 0; sl < slot; ++sl) { const float p = exp2f(wp[sl * 64 + lane] - mx); wp[sl * 64 + lane] = p; sum += p; }
                sum = wave_sum(sum); WSYNC();
                float o = 0.f; sm = selmask; slot = 0;
                while (sm) { const int n = __builtin_ctzll(sm); sm &= sm - 1;
                    const int kmax = min(63, t - n * 64);
                    for (int kk = 0; kk <= kmax; ++kk) o = fmaf(wp[slot * 64 + kk], bf2f(pab[(size_t)(n * 64 + kk) * PA_LD + PA_VS + g * 64 + lane]), o);
                    ++slot; }
                wres[(hh * 3 + 1) * 64 + lane] = o / sum; }
            WSYNC();
            {   float mx = -INFINITY;
                for (int j = 0; j < 8; ++j) { const int kp = t - 511 + 64 * j + lane;
                    const float s = (kp >= 0) ? dot64(pab + (size_t)kp * PA_LD + PA_KW + g * 64, wq) : -INFINITY;
                    wp[j * 64 + lane] = s; mx = fmaxf(mx, s); }
                mx = wave_max(mx);
                float sum = 0.f;
                for (int j = 0; j < 8; ++j) { const float p = exp2f(wp[j * 64 + lane] - mx); wp[j * 64 + lane] = p; sum += p; }
                sum = wave_sum(sum); WSYNC();
                float o = 0.f;
                const int k_lo = max(0, 511 - t);
                for (int kk = k_lo; kk < 512; ++kk) o = fmaf(wp[kk], bf2f(pab[(size_t)(t - 511 + kk) * PA_LD + PA_VW + g * 64 + lane]), o);
                wres[(hh * 3 + 2) * 64 + lane] = o / sum; }
        }
        for (int hh = 0; hh < 4; ++hh) {
            const int head = g * 4 + hh;
            const float g0 = sigmoidf_(bf2f(parow[PA_GL + head * 3 + 0])), g1 = sigmoidf_(bf2f(parow[PA_GL + head * 3 + 1])), g2 = sigmoidf_(bf2f(parow[PA_GL + head * 3 + 2]));
            const float o = g0 * wres[(hh * 3 + 0) * 64 + lane] + g1 * wres[(hh * 3 + 1) * 64 + lane] + g2 * wres[(hh * 3 + 2) * 64 + lane];
            const float ga = bf2f(parow[PA_GA + head * 64 + lane]);
            c.MIX[(size_t)m * DM + head * 64 + lane] = f2bf(siluf(ga) * o);
        }
    }
}

__device__ __forceinline__ void ph5_conv(const Ctx& c) {
    for (size_t idx = (size_t)blockIdx.x * NTHR + threadIdx.x; idx < (size_t)M * 512; idx += (size_t)gridDim.x * NTHR) {
        const int ch = (int)(idx & 511); const int m = (int)(idx >> 9); const int t = m % SEQ;
        const bf16_t* r0 = c.PA + (size_t)m * PA_LD;
        float y = c.conv_w[2 * 512 + ch] * bf2f(r0[PA_CC + ch]) * bf2f(r0[PA_CH + ch]);
        if (t >= 1) { const bf16_t* r1 = r0 - PA_LD; y += c.conv_w[1 * 512 + ch] * bf2f(r1[PA_CC + ch]) * bf2f(r1[PA_CH + ch]); }
        if (t >= 2) { const bf16_t* r2 = r0 - 2 * PA_LD; y += c.conv_w[0 * 512 + ch] * bf2f(r2[PA_CC + ch]) * bf2f(r2[PA_CH + ch]); }
        c.MIX[(size_t)m * DM + 512 + ch] = f2bf(siluf(bf2f(r0[PA_GB + ch])) * bf2f(r0[PA_CB + ch]) * y);
    }
}

__device__ __forceinline__ void ph7_norm1(const Ctx& c) {
    const int lane = threadIdx.x & 63, gw = blockIdx.x * NWV + (threadIdx.x >> 6), NGW = gridDim.x * NWV;
    for (int m = gw; m < M; m += NGW) rms_row_f32(c.out + (size_t)m * DM, c.c_norm, c.XN + (size_t)m * DM, lane);
}
__device__ __forceinline__ void ph_final(const Ctx& c) {
    const int lane = threadIdx.x & 63, gw = blockIdx.x * NWV + (threadIdx.x >> 6), NGW = gridDim.x * NWV;
    for (int m = gw; m < M; m += NGW) {
        float* xr = c.out + (size_t)m * DM;
        float4 v[4]; float s = 0.f;
#pragma unroll
        for (int j = 0; j < 4; ++j) { v[j] = *(const float4*)(xr + 4 * lane + 256 * j); s += (v[j].x * v[j].x + v[j].y * v[j].y) + (v[j].z * v[j].z + v[j].w * v[j].w); }
        const float rstd = 1.f / sqrtf(wave_sum(s) * (1.f / DM) + RMS_EPS);
#pragma unroll
        for (int j = 0; j < 4; ++j) { const float4 gg = *(const float4*)(c.final_norm + 4 * lane + 256 * j);
            float4 o; o.x = v[j].x * rstd * gg.x; o.y = v[j].y * rstd * gg.y; o.z = v[j].z * rstd * gg.z; o.w = v[j].w * rstd * gg.w;
            *(float4*)(xr + 4 * lane + 256 * j) = o; }
    }
}

__device__ __forceinline__ void ph9_lat_norm(const Ctx& c) {
    const int lane = threadIdx.x & 63, gw = blockIdx.x * NWV + (threadIdx.x >> 6), NGW = gridDim.x * NWV;
    for (int m = gw; m < M; m += NGW) {
        const bf16_t* r = c.PC + (size_t)m * PC_LD;
#pragma unroll
        for (int w = 0; w < 2; ++w) {
            const ushort4 v = *(const ushort4*)(r + (w ? PC_CKV : PC_CQ) + 4 * lane);
            const float a0 = bf2f(v.x), a1 = bf2f(v.y), a2 = bf2f(v.z), a3 = bf2f(v.w);
            const float rstd = 1.f / sqrtf(wave_sum(a0 * a0 + a1 * a1 + a2 * a2 + a3 * a3) * (1.f / 256.f) + RMS_EPS);
            const float4 gg = *(const float4*)((w ? c.kv_norm : c.q_norm) + 4 * lane);
            ushort4 o; o.x = f2bf(a0 * rstd * gg.x); o.y = f2bf(a1 * rstd * gg.y); o.z = f2bf(a2 * rstd * gg.z); o.w = f2bf(a3 * rstd * gg.w);
            *(ushort4*)((w ? c.CKVN : c.CQN) + (size_t)m * 256 + 4 * lane) = o;
        }
        if (lane < 32) {
            const float x1 = bf2f(r[PC_KR + lane]), x2 = bf2f(r[PC_KR + lane + 32]); const float2 cs = c.CS[(size_t)m * 32 + lane];
            c.KPE[(size_t)m * 64 + lane] = f2bf(x1 * cs.x - x2 * cs.y); c.KPE[(size_t)m * 64 + lane + 32] = f2bf(x2 * cs.x + x1 * cs.y);
        }
    }
}
__device__ __forceinline__ void ph11_rope_q1(const Ctx& c) {
    for (size_t idx = (size_t)blockIdx.x * NTHR + threadIdx.x; idx < (size_t)M * 8 * 96; idx += (size_t)gridDim.x * NTHR) {
        const int e = (int)(idx % 96); const size_t r = idx / 96; const int h = (int)(r & 7); const int m = (int)(r >> 3);
        bf16_t* q = c.Q1 + (size_t)m * 1536 + h * 192;
        if (e < 64) { q[e] = f2bf(bf2f(q[e]) * QSCALE_C); q[e + 64] = f2bf(bf2f(q[e + 64]) * QSCALE_C); }
        else { const int i = e - 64; const float2 cs = c.CS[(size_t)m * 32 + i];
            const float x1 = bf2f(q[128 + i]), x2 = bf2f(q[160 + i]);
            q[128 + i] = f2bf((x1 * cs.x - x2 * cs.y) * QSCALE_C); q[160 + i] = f2bf((x2 * cs.x + x1 * cs.y) * QSCALE_C); }
    }
}
__device__ __forceinline__ void ph12_mla(const Ctx& c, unsigned char* lds) {
    const int lane = threadIdx.x & 63, wave = threadIdx.x >> 6;
    float* wq = (float*)(lds + wave * 2048);
    float* wp = wq + 192;
    const int gw = blockIdx.x * NWV + wave, NGW = gridDim.x * NWV;
    for (int item = gw; item < M * 8; item += NGW) {
        const int h = item & 7, m = item >> 3; const int b = m / SEQ, t = m % SEQ;
        WSYNC();
        const bf16_t* qrow = c.Q1 + (size_t)m * 1536 + h * 192;
        wq[lane] = bf2f(qrow[lane]); wq[64 + lane] = bf2f(qrow[64 + lane]); wq[128 + lane] = bf2f(qrow[128 + lane]);
        WSYNC();
        float mrun = -1e30f, l = 0.f, o0 = 0.f, o1 = 0.f;
        const bf16_t* kvb = c.KV1 + (size_t)b * SEQ * 2048 + h * 256; const bf16_t* kpb = c.KPE + (size_t)b * SEQ * 64;
        for (int k0 = 0; k0 <= t; k0 += 64) {
            const int key = k0 + lane;
            float s = -INFINITY;
            if (key <= t) { const bf16_t* kr = kvb + (size_t)key * 2048; s = dot64(kr, wq) + dot64(kr + 64, wq + 64) + dot64(kpb + (size_t)key * 64, wq + 128); }
            const float cm = wave_max(s);
            const float mn = fmaxf(mrun, cm); const float alpha = exp2f(mrun - mn); mrun = mn;
            const float p = exp2f(s - mn);
            l = l * alpha + wave_sum(p); o0 *= alpha; o1 *= alpha;
            WSYNC(); wp[lane] = p; WSYNC();
            const int kmax = min(63, t - k0);
            for (int kk = 0; kk <= kmax; ++kk) { const bf16_t* vr = kvb + (size_t)(k0 + kk) * 2048 + 128; const float pp = wp[kk]; o0 = fmaf(pp, bf2f(vr[lane]), o0); o1 = fmaf(pp, bf2f(vr[64 + lane]), o1); }
        }
        const float inv = 1.f / l;
        const bf16_t* gr = c.PC + (size_t)m * PC_LD + PC_G + h * 128;
        c.O1[(size_t)m * DM + h * 128 + lane] = f2bf(siluf(bf2f(gr[lane])) * o0 * inv);
        c.O1[(size_t)m * DM + h * 128 + 64 + lane] = f2bf(siluf(bf2f(gr[64 + lane])) * o1 * inv);
    }
}

constexpr int NPHASE = 15;
__global__ void __launch_bounds__(NTHR, 2) mk_fwd(Args a) {
    extern __shared__ __attribute__((aligned(16))) unsigned char lds[];
    Ctx c;
    c.x = (const float*)a.in[0]; c.pos = (const int*)a.in[1]; c.a_norm = (const float*)a.in[2]; c.a_w_in = (const float*)a.in[3]; c.pe_k = (const float*)a.in[4]; c.pe_v = (const float*)a.in[5];
    c.w_ck1 = (const float*)a.in[6]; c.w_ck2 = (const float*)a.in[7]; c.w_cv1 = (const float*)a.in[8]; c.w_cv2 = (const float*)a.in[9]; c.conv_w = (const float*)a.in[10]; c.a_w_out = (const float*)a.in[11];
    c.c_norm = (const float*)a.in[12]; c.c_w_in = (const float*)a.in[13]; c.q_norm = (const float*)a.in[14]; c.kv_norm = (const float*)a.in[15]; c.w_uq = (const float*)a.in[16]; c.w_ukv = (const float*)a.in[17];
    c.c_w_out = (const float*)a.in[18]; c.final_norm = (const float*)a.in[19];
    c.out = a.out; c.ws = a.ws;
    c.CS = (float2*)(a.ws + WS_CS); c.KCMP = (bf16_t*)(a.ws + WS_KCMP); c.VCMP = (bf16_t*)(a.ws + WS_VCMP); c.XN = (bf16_t*)(a.ws + WS_XN); c.PA = (bf16_t*)(a.ws + WS_PA);
    c.MIX = (bf16_t*)(a.ws + WS_MIX); c.PC = (bf16_t*)(a.ws + WS_PC); c.Q1 = (bf16_t*)(a.ws + WS_Q1); c.KV1 = (bf16_t*)(a.ws + WS_KV1); c.CQN = (bf16_t*)(a.ws + WS_CQN);
    c.CKVN = (bf16_t*)(a.ws + WS_CKVN); c.KPE = (bf16_t*)(a.ws + WS_KPE); c.O1 = (bf16_t*)(a.ws + WS_O1);

    volatile LAS unsigned* misc = (volatile LAS unsigned*)((LAS unsigned char*)lds + (LDS_BYTES - 64));
    if (threadIdx.x < 16) misc[threadIdx.x] = 0u;
    __syncthreads();
    XcdBarrier bar; bar.bar = (unsigned*)(a.ws + WS_CTL) + 4096; bar.x = 0; bar.st = misc;
    const bool multi = (a.hi - a.lo) > 1;
    if (multi) bar = xcd_barrier_post((unsigned*)(a.ws + WS_CTL) + 4096, misc);

#define PHASE(k, ...) if (a.lo <= (k) && (k) < a.hi) { __VA_ARGS__; if ((k) + 1 < a.hi) xcd_barrier(bar); }
    LAS unsigned char* ldsl = (LAS unsigned char*)lds;
    PHASE(0, { ph0_weights(c, lds); ph0_prologue(c); })
    PHASE(1, { pg8::Gemm g{c.XN, (const bf16_t*)(c.ws + WS_WTA), M, 4096, 1024}; pg8::StaticOrder S; S.init(M, 4096, gridDim.x, blockIdx.x);
               pg8::EpiPA E{c.PA, c.CS}; pg8::gemm_phase<pg8::EpiPA, pg8::StaticOrder, true, true>(ldsl, g, S, E); })
    PHASE(3, ph3_compress(c, lds))
    PHASE(4, ph4_nsa(c, lds))
    PHASE(5, ph5_conv(c))
    PHASE(6, { pg8::Gemm g{c.MIX, (const bf16_t*)(c.ws + WS_WTOA), M, 1024, 1024}; pg8::StaticOrder S; S.init(M, 1024, gridDim.x, blockIdx.x);
               pg8::EpiRes E{c.x, c.out}; pg8::gemm_phase<pg8::EpiRes, pg8::StaticOrder, true, true>(ldsl, g, S, E); })
    PHASE(7, ph7_norm1(c))
    PHASE(8, { pg8::Gemm g{c.XN, (const bf16_t*)(c.ws + WS_WTC), M, 1792, 1024}; pg8::StaticOrder S; S.init(M, 1792, gridDim.x, blockIdx.x);
               pg8::EpiPlain E{c.PC, PC_LD}; pg8::gemm_phase<pg8::EpiPlain, pg8::StaticOrder, true, true>(ldsl, g, S, E); })
    PHASE(9, ph9_lat_norm(c))
    PHASE(10, { for (int gi = 0; gi < 2; ++gi) {
                pg8::Gemm g{gi ? c.CKVN : c.CQN, (const bf16_t*)(c.ws + (gi ? WS_WTUKV : WS_WTUQ)), M, gi ? 2048 : 1536, 256}; pg8::StaticOrder S; S.init(M, gi ? 2048 : 1536, gridDim.x, blockIdx.x);
                pg8::EpiPlain E{gi ? c.KV1 : c.Q1, gi ? 2048 : 1536}; pg8::gemm_phase<pg8::EpiPlain, pg8::StaticOrder, true, true>(ldsl, g, S, E); __syncthreads(); } })
    PHASE(11, ph11_rope_q1(c))
    PHASE(12, ph12_mla(c, lds))
    PHASE(13, { pg8::Gemm g{c.O1, (const bf16_t*)(c.ws + WS_WTOC), M, 1024, 1024}; pg8::StaticOrder S; S.init(M, 1024, gridDim.x, blockIdx.x);
               pg8::EpiRes E{c.out, c.out}; pg8::gemm_phase<pg8::EpiRes, pg8::StaticOrder, true, true>(ldsl, g, S, E); })
    PHASE(14, ph_final(c))
#undef PHASE
}

extern "C" void kernel_launch(void* const* d_in, const int* in_sizes, int n_in, void* d_out, int out_size, void* d_ws, size_t ws_size, hipStream_t stream) {
    static int grid = 0;
    if (grid == 0) {
        if (n_in != 20 || in_sizes[0] != M * DM || out_size != M * DM || ws_size < WS_END) {
            fprintf(stderr, "kernel_launch: unexpected shapes (n_in %d, in0 %d, out %d, ws %zu)\n", n_in, n_in > 0 ? in_sizes[0] : -1, out_size, ws_size); grid = -1; return; }
        int dev = 0, cus = 0;
        if (hipGetDevice(&dev) != hipSuccess || hipDeviceGetAttribute(&cus, hipDeviceAttributeMultiprocessorCount, dev) != hipSuccess || cus <= 0) { grid = -1; return; }
        if (hipFuncSetAttribute((const void*)mk_fwd, hipFuncAttributeMaxDynamicSharedMemorySize, LDS_BYTES) != hipSuccess) { fprintf(stderr, "kernel_launch: hipFuncSetAttribute failed\n"); grid = -1; return; }
        (void)hipGetLastError();
        grid = cus;
    }
    if (grid < 0) return;
    (void)hipMemsetAsync((char*)d_ws + WS_CTL, 0, CTL_BYTES, stream);
    Args a{};
    for (int i = 0; i < 20; ++i) a.in[i] = d_in[i];
    a.out = (float*)d_out; a.ws = (unsigned char*)d_ws;
#if MK_ONE_LAUNCH
    a.lo = 0; a.hi = NPHASE;
    hipLaunchKernelGGL(mk_fwd, dim3(grid), dim3(NTHR), LDS_BYTES, stream, a);
#else
    for (int ph = 0; ph < NPHASE; ++ph) { a.lo = ph; a.hi = ph + 1; hipLaunchKernelGGL(mk_fwd, dim3(grid), dim3(NTHR), LDS_BYTES, stream, a); }
#endif
}
```

```cpp
#include <hip/hip_runtime.h>
#include <cstdio>
#include <cstdint>
#include <cmath>

#ifndef MK_ONE_LAUNCH
#define MK_ONE_LAUNCH 1
#endif

constexpr int BATCH = 8, SEQ = 4096, DM = 1024, M = BATCH * SEQ;
constexpr int NIN_A = 3864, NIN_C = 1600;
constexpr int PA_LD = 4096;
constexpr int PC_LD = 1792;
constexpr int PA_Q = 0, PA_KC = 512, PA_VC = 640, PA_KS = 768, PA_VS = 896, PA_KW = 1024, PA_VW = 1152,
              PA_GA = 1280, PA_CB = 1792, PA_CC = 2304, PA_CH = 2816, PA_GB = 3328, PA_GL = 3840;
constexpr int PC_CQ = 0, PC_CKV = 256, PC_G = 512, PC_KR = 1536;
constexpr float LOG2E = 1.4426950408889634f;
constexpr float QSCALE_A = 0.125f * LOG2E;
constexpr float QSCALE_C = 0.07216878364870323f * LOG2E;
constexpr float RMS_EPS = 1e-6f;

constexpr size_t MiB = 1u << 20;
constexpr size_t WS_CTL = 0, CTL_BYTES = 1 * MiB;
constexpr size_t WS_CS = 1 * MiB;
constexpr size_t WS_KCMP = 9 * MiB;
constexpr size_t WS_VCMP = 9 * MiB + 512 * 1024;
constexpr size_t WS_WTA = 16 * MiB;
constexpr size_t WS_WTOA = 24 * MiB;
constexpr size_t WS_WTC = 26 * MiB;
constexpr size_t WS_WTUQ = 30 * MiB;
constexpr size_t WS_WTUKV = 31 * MiB;
constexpr size_t WS_WTOC = 32 * MiB;
constexpr size_t WS_XN = 48 * MiB;
constexpr size_t WS_PA = 112 * MiB;
constexpr size_t WS_MIX = 368 * MiB;
constexpr size_t WS_PC = 112 * MiB;
constexpr size_t WS_Q1 = 224 * MiB;
constexpr size_t WS_KV1 = 320 * MiB;
constexpr size_t WS_CQN = 448 * MiB;
constexpr size_t WS_CKVN = 464 * MiB;
constexpr size_t WS_KPE = 480 * MiB;
constexpr size_t WS_O1 = 48 * MiB;
constexpr size_t WS_END = 484 * MiB;

constexpr int LDS_BYTES = 147456;
constexpr int NTHR = 512, NWV = 8;

typedef unsigned short bf16_t;
#define LAS __attribute__((address_space(3)))

__device__ __forceinline__ float bf2f(bf16_t v) { return __uint_as_float(((unsigned)v) << 16); }
__device__ __forceinline__ bf16_t f2bf(float f) { unsigned u = __float_as_uint(f); return (bf16_t)((u + 0x7fffu + ((u >> 16) & 1u)) >> 16); }
__device__ __forceinline__ float wave_sum(float v) {
#pragma unroll
    for (int o = 1; o < 64; o <<= 1) v += __shfl_xor(v, o);
    return v;
}
__device__ __forceinline__ float wave_max(float v) {
#pragma unroll
    for (int o = 1; o < 64; o <<= 1) v = fmaxf(v, __shfl_xor(v, o));
    return v;
}
#define WSYNC() asm volatile("s_waitcnt lgkmcnt(0)" ::: "memory")
__device__ __forceinline__ float siluf(float x) { return x / (1.f + __expf(-x)); }
__device__ __forceinline__ float sigmoidf_(float x) { return 1.f / (1.f + __expf(-x)); }

#define XB_TMO      128
#define XB_XCNT(j)  (256  + 64 * (j))
#define XB_XSUB(j)  (1280 + 64 * (j))
#define XB_XGEN(j)  (2304 + 64 * (j))
#define XB_TOP      3328
#define XB_TOPGEN   3392
#define XCD_BAR_WORDS 3456
#define XB_SPIN_CAP (1u << 24)
__device__ __forceinline__ unsigned xb_ld(unsigned* p)              { return __hip_atomic_load(p, __ATOMIC_RELAXED, __HIP_MEMORY_SCOPE_AGENT); }
__device__ __forceinline__ unsigned xb_add(unsigned* p, unsigned v) { return __hip_atomic_fetch_add(p, v, __ATOMIC_RELAXED, __HIP_MEMORY_SCOPE_AGENT); }
__device__ __forceinline__ unsigned xb_xcc_id() { return (unsigned)__builtin_amdgcn_s_getreg((3 << 11) | 20) & 0xFu; }
#define XB_SPIN(cond, bar) do { unsigned _sp = 0; while (cond) { __builtin_amdgcn_s_sleep(1); \
    if ((++_sp & 255u) == 0u) { if (xb_ld(&(bar)[XB_TMO])) break; if (_sp > XB_SPIN_CAP) { atomicAdd(&(bar)[XB_TMO], 1u); break; } } } } while (0)
struct XcdBarrier { unsigned* bar; unsigned x; volatile LAS unsigned* st; };
__device__ __forceinline__ XcdBarrier xcd_barrier_post(unsigned* bar, volatile LAS unsigned* st) {
    XcdBarrier b; b.bar = bar; b.x = xb_xcc_id(); b.st = st;
    if (threadIdx.x == 0) (void)xb_add(&bar[XB_XCNT(b.x)], 1u);
    return b;
}
__device__ __forceinline__ void xcd_barrier_complete(unsigned* bar, unsigned x, unsigned& nloc, unsigned& nx) {
    const unsigned G = gridDim.x * gridDim.y * gridDim.z;
    unsigned sum, cnt, mine, sp = 0u;
    for (;;) {
        sum = 0u; cnt = 0u; mine = 0u;
#pragma unroll
        for (unsigned j = 0; j < 16; ++j) { const unsigned c = xb_ld(&bar[XB_XCNT(j)]); sum += c; cnt += (c > 0u) ? 1u : 0u; mine = (j == x) ? c : mine; }
        if (sum == G) break;
        __builtin_amdgcn_s_sleep(1);
        if ((++sp & 255u) == 0u) { if (xb_ld(&bar[XB_TMO])) break; if (sp > XB_SPIN_CAP) { atomicAdd(&bar[XB_TMO], 1u); break; } }
    }
    nloc = mine > 0u ? mine : 1u; nx = cnt > 0u ? cnt : 1u;
}
__device__ __forceinline__ void xcd_barrier(const XcdBarrier& b) {
    asm volatile("s_waitcnt vmcnt(0)" ::: "memory");
    __syncthreads();
    if (threadIdx.x == 0) {
        unsigned* bar = b.bar;
        __builtin_amdgcn_s_waitcnt(0);
        unsigned nloc = b.st[0], nx = b.st[1];
        if (nloc == 0u) { xcd_barrier_complete(bar, b.x, nloc, nx); b.st[0] = nloc; b.st[1] = nx; }
        const unsigned old = xb_add(&bar[XB_XSUB(b.x)], 1u);
        const unsigned gen = old / nloc;
        if (old + 1u == (gen + 1u) * nloc) {
            __builtin_amdgcn_fence(__ATOMIC_RELEASE, "agent");
            asm volatile("s_waitcnt vmcnt(0)" ::: "memory");
            const unsigned og = xb_add(&bar[XB_TOP], 1u);
            const unsigned tg = og / nx;
            if (og + 1u == (tg + 1u) * nx) xb_add(&bar[XB_TOPGEN], 1u);
            else XB_SPIN(xb_ld(&bar[XB_TOPGEN]) == tg, bar);
            __builtin_amdgcn_fence(__ATOMIC_ACQUIRE, "agent");
            xb_add(&bar[XB_XGEN(b.x)], 1u);
            asm volatile("s_waitcnt vmcnt(0)" ::: "memory");
        } else {
            XB_SPIN(xb_ld(&bar[XB_XGEN(b.x)]) == gen, bar);
            __builtin_amdgcn_fence(__ATOMIC_ACQUIRE, "agent");
            asm volatile("s_waitcnt vmcnt(0)" ::: "memory");
        }
    }
    __syncthreads();
}

struct Args { const void* in[20]; float* out; unsigned char* ws; int lo, hi; };
struct Ctx {
    const float* x; const int* pos; const float* a_norm; const float* a_w_in; const float* pe_k; const float* pe_v;
    const float* w_ck1; const float* w_ck2; const float* w_cv1; const float* w_cv2; const float* conv_w; const float* a_w_out;
    const float* c_norm; const float* c_w_in; const float* q_norm; const float* kv_norm; const float* w_uq; const float* w_ukv; const float* c_w_out; const float* final_norm;
    float* out; unsigned char* ws;
    float2* CS; bf16_t* KCMP; bf16_t* VCMP; bf16_t* XN; bf16_t* PA; bf16_t* MIX; bf16_t* PC; bf16_t* Q1; bf16_t* KV1; bf16_t* CQN; bf16_t* CKVN; bf16_t* KPE; bf16_t* O1;
};

__device__ __forceinline__ void sincos_acc(float angf, float& s, float& c) {
    const double x = (double)angf;
    const double k = rint(x * 0.6366197723675814);
    double r = fma(-k, 1.5707963267948966, x);
    r = fma(-k, 6.123233995736766e-17, r);
    const double r2 = r * r;
    double sp = -1.0 / 1307674368000.0;
    sp = fma(sp, r2, 1.0 / 6227020800.0);
    sp = fma(sp, r2, -1.0 / 39916800.0);
    sp = fma(sp, r2, 1.0 / 362880.0);
    sp = fma(sp, r2, -1.0 / 5040.0);
    sp = fma(sp, r2, 1.0 / 120.0);
    sp = fma(sp, r2, -1.0 / 6.0);
    const double sn = fma(sp * r2, r, r);
    double cp = 1.0 / 20922789888000.0;
    cp = fma(cp, r2, -1.0 / 87178291200.0);
    cp = fma(cp, r2, 1.0 / 479001600.0);
    cp = fma(cp, r2, -1.0 / 3628800.0);
    cp = fma(cp, r2, 1.0 / 40320.0);
    cp = fma(cp, r2, -1.0 / 720.0);
    cp = fma(cp, r2, 1.0 / 24.0);
    cp = fma(cp, r2, -0.5);
    const double cs = fma(cp, r2, 1.0);
    const int q = ((int)(long long)k) & 3;
    const double ss = (q == 0) ? sn : (q == 1) ? cs : (q == 2) ? -sn : -cs;
    const double cc = (q == 0) ? cs : (q == 1) ? -sn : (q == 2) ? -cs : sn;
    s = (float)ss; c = (float)cc;
}

__device__ __forceinline__ void rms_row_f32(const float* xr, const float* g, bf16_t* orow, int lane) {
    float4 v[4]; float s = 0.f;
#pragma unroll
    for (int j = 0; j < 4; ++j) { v[j] = *(const float4*)(xr + 4 * lane + 256 * j); s += (v[j].x * v[j].x + v[j].y * v[j].y) + (v[j].z * v[j].z + v[j].w * v[j].w); }
    const float rstd = 1.f / sqrtf(wave_sum(s) * (1.f / DM) + RMS_EPS);
#pragma unroll
    for (int j = 0; j < 4; ++j) {
        const float4 gg = *(const float4*)(g + 4 * lane + 256 * j);
        ushort4 o; o.x = f2bf(v[j].x * rstd * gg.x); o.y = f2bf(v[j].y * rstd * gg.y); o.z = f2bf(v[j].z * rstd * gg.z); o.w = f2bf(v[j].w * rstd * gg.w);
        *(ushort4*)(orow + 4 * lane + 256 * j) = o;
    }
}

namespace pg8 {
#define PG8_LAS __attribute__((address_space(3)))
typedef unsigned short bf16_t;
typedef short bf16x8 __attribute__((ext_vector_type(8)));
typedef float f32x4 __attribute__((ext_vector_type(4)));
typedef unsigned u32x4 __attribute__((ext_vector_type(4)));
constexpr int BM = 256, BK = 64, HALF = 128, HTB = HALF * BK * 2  , STAGE_BYTES = 8 * HTB, NXCD = 8, WGM = 8;

__host__ __device__ __forceinline__ int lds_byte(int r, int c) { const int st = (r >> 4) * 2 + (c >> 5), rr = r & 15, cc = c & 31, ob = rr * 64 + cc * 2; return st * 1024 + (ob ^ (((ob >> 9) & 1) << 5)); }
__host__ __device__ __forceinline__ void stage_rc(int b, int& R, int& C) { const int st = b / 1024, sb = b % 1024, swz = sb ^ (((sb >> 9) & 1) << 5); R = (st >> 1) * 16 + swz / 64; C = (st & 1) * 32 + (swz % 64) / 2; }
__host__ __device__ __forceinline__ int perm32(int rho) { const int n = rho >> 4, i = rho & 15; return 8 * (i >> 2) + 4 * n + (i & 3); }

struct Unit { int pm, pn; };
struct Gemm { const bf16_t* A; const bf16_t* Bt; int M, N, K; };

struct StaticOrder {
    int nM, nN, nwg, G, c;
    __host__ __device__ void init(int M, int N, int G_, int c_) { nM = M / BM; nN = N / BM; nwg = nM * nN; G = G_; c = c_; }
    __host__ __device__ bool next(int i, Unit& u) const {
        const long L = (long)i * G + c; if (L >= nwg) return false;
        int wgid = (int)L; { const int q = nwg / NXCD, r = nwg % NXCD, xcd = wgid % NXCD, off = wgid / NXCD; wgid = (xcd < r ? xcd * (q + 1) : r * (q + 1) + (xcd - r) * q) + off; }
        const int nig = WGM * nN, gid = wgid / nig, fm = gid * WGM, gsz = (nM - fm) < WGM ? (nM - fm) : WGM;
        u.pm = fm + ((wgid % nig) % gsz); u.pn = (wgid % nig) / gsz; return true;
    }
    __device__ __forceinline__ void a_ready(const Unit&) const {}
    __device__ __forceinline__ void done(const Unit&) const {}
};

__device__ __forceinline__ unsigned cvt_pk_bf16(float lo, float hi) { unsigned r; asm volatile("v_cvt_pk_bf16_f32 %0, %1, %2" : "=v"(r) : "v"(lo), "v"(hi)); return r; }

struct EpiPA {
    static constexpr bool PERM = true, AFTER_DRAIN = false;
    bf16_t* PA; const float2* CS;
    __device__ __forceinline__ void operator()(const f32x4 (&acc)[2][2][4][2], const Unit& u, int wr, int wc, int fr, int fq) const {
        const int row0 = u.pm * BM + wr * 64 + fr;
        if (u.pn < 3) {
            const int base = (u.pn == 0) ? 64 * wc : (u.pn == 1) ? 256 + 64 * wc : (wc < 2 ? 768 + 64 * wc : 1024 + 64 * (wc - 2));
            const float sc = u.pn < 2 ? QSCALE_A : 1.f;
#pragma unroll
            for (int ai = 0; ai < 2; ++ai)
#pragma unroll
                for (int m = 0; m < 4; ++m) {
                    const int row = row0 + ai * HALF + m * 16;
                    const f32x4* csp = (const f32x4*)(CS + (size_t)row * 32 + 8 * fq);
                    const f32x4 t0 = csp[0], t1 = csp[1], t2 = csp[2], t3 = csp[3];
                    const f32x4 a0 = acc[ai][0][m][0], a1 = acc[ai][0][m][1], b0 = acc[ai][1][m][0], b1 = acc[ai][1][m][1];
                    u32x4 w1, w2;
                    w1.x = cvt_pk_bf16((a0[0] * t0[0] - b0[0] * t0[1]) * sc, (a0[1] * t0[2] - b0[1] * t0[3]) * sc);
                    w1.y = cvt_pk_bf16((a0[2] * t1[0] - b0[2] * t1[1]) * sc, (a0[3] * t1[2] - b0[3] * t1[3]) * sc);
                    w1.z = cvt_pk_bf16((a1[0] * t2[0] - b1[0] * t2[1]) * sc, (a1[1] * t2[2] - b1[1] * t2[3]) * sc);
                    w1.w = cvt_pk_bf16((a1[2] * t3[0] - b1[2] * t3[1]) * sc, (a1[3] * t3[2] - b1[3] * t3[3]) * sc);
                    w2.x = cvt_pk_bf16((b0[0] * t0[0] + a0[0] * t0[1]) * sc, (b0[1] * t0[2] + a0[1] * t0[3]) * sc);
                    w2.y = cvt_pk_bf16((b0[2] * t1[0] + a0[2] * t1[1]) * sc, (b0[3] * t1[2] + a0[3] * t1[3]) * sc);
                    w2.z = cvt_pk_bf16((b1[0] * t2[0] + a1[0] * t2[1]) * sc, (b1[1] * t2[2] + a1[1] * t2[3]) * sc);
                    w2.w = cvt_pk_bf16((b1[2] * t3[0] + a1[2] * t3[1]) * sc, (b1[3] * t3[2] + a1[3] * t3[3]) * sc);
                    bf16_t* rp = PA + (size_t)row * PA_LD + base + 8 * fq;
                    *(u32x4*)rp = w1; *(u32x4*)(rp + 32) = w2;
                }
        } else {
            const int cb0 = (u.pn == 3) ? 512 : (u.pn == 4) ? 896 : 256 * u.pn;
            const int cb1 = (u.pn == 3) ? 640 : (u.pn == 4) ? 1152 : 256 * u.pn + 128;
#pragma unroll
            for (int ai = 0; ai < 2; ++ai)
#pragma unroll
                for (int m = 0; m < 4; ++m) {
                    bf16_t* rp = PA + (size_t)(row0 + ai * HALF + m * 16) * PA_LD + 32 * wc + 8 * fq;
#pragma unroll
                    for (int bj = 0; bj < 2; ++bj) { const f32x4 v0 = acc[ai][bj][m][0], v1 = acc[ai][bj][m][1];
                        u32x4 w; w.x = cvt_pk_bf16(v0[0], v0[1]); w.y = cvt_pk_bf16(v0[2], v0[3]); w.z = cvt_pk_bf16(v1[0], v1[1]); w.w = cvt_pk_bf16(v1[2], v1[3]);
                        *(u32x4*)(rp + (bj ? cb1 : cb0)) = w; }
                }
        }
    }
};
struct EpiPlain {
    static constexpr bool PERM = true, AFTER_DRAIN = false;
    bf16_t* O; int ldc;
    __device__ __forceinline__ void operator()(const f32x4 (&acc)[2][2][4][2], const Unit& u, int wr, int wc, int fr, int fq) const {
        const int row0 = u.pm * BM + wr * 64 + fr; const int col0 = u.pn * BM + wc * 32 + 8 * fq;
#pragma unroll
        for (int ai = 0; ai < 2; ++ai)
#pragma unroll
            for (int m = 0; m < 4; ++m) { bf16_t* rp = O + (size_t)(row0 + ai * HALF + m * 16) * ldc + col0;
#pragma unroll
                for (int bj = 0; bj < 2; ++bj) { const f32x4 v0 = acc[ai][bj][m][0], v1 = acc[ai][bj][m][1];
                    u32x4 w; w.x = cvt_pk_bf16(v0[0], v0[1]); w.y = cvt_pk_bf16(v0[2], v0[3]); w.z = cvt_pk_bf16(v1[0], v1[1]); w.w = cvt_pk_bf16(v1[2], v1[3]);
                    *(u32x4*)(rp + bj * HALF) = w; } }
    }
};
struct EpiRes {
    static constexpr bool PERM = false, AFTER_DRAIN = false;
    const float* base; float* out;
    __device__ __forceinline__ void operator()(const f32x4 (&acc)[2][2][4][2], const Unit& u, int wr, int wc, int fr, int fq) const {
        const int row0 = u.pm * BM + wr * 64 + fr; const int col0 = u.pn * BM + wc * 32 + 4 * fq;
#pragma unroll
        for (int ai = 0; ai < 2; ++ai)
#pragma unroll
            for (int m = 0; m < 4; ++m) { const size_t off = (size_t)(row0 + ai * HALF + m * 16) * 1024 + col0;
#pragma unroll
                for (int bj = 0; bj < 2; ++bj)
#pragma unroll
                    for (int n = 0; n < 2; ++n) { const f32x4 b = *(const f32x4*)(base + off + bj * HALF + n * 16); *(f32x4*)(out + off + bj * HALF + n * 16) = b + acc[ai][bj][m][n]; } }
    }
};
template <class Epi, class Sched, bool ALIGN_EPI = false, bool SP2 = false>
__device__ __forceinline__ void gemm_phase(PG8_LAS unsigned char* lds, const Gemm g, const Sched& S, const Epi& E) {
    const int tid = threadIdx.x, wid = __builtin_amdgcn_readfirstlane(tid >> 6), lane = tid & 63, wr = wid >> 2, wc = wid & 3, fr = lane & 15, fq = lane >> 4;
    const int K = g.K, nt = K / BK;
    unsigned voffA[2], voffB[2];
#pragma unroll
    for (int i = 0; i < 2; ++i) { int R, C; stage_rc(tid * 16 + i * 8192, R, C); const int Rb = Epi::PERM ? ((R & ~31) + perm32(R & 31)) : R;
        voffA[i] = (unsigned)(R * K + C) * 2u; voffB[i] = (unsigned)(Rb * K + C) * 2u; }
    const size_t kstep = (size_t)(BK * 2);
    const size_t hstep = (size_t)HALF * K * 2;
    const size_t tstep = 2 * hstep;
    const unsigned ldsw = (unsigned)wid * 1024u;
    const int aoff = lds_byte(wr * 64 + fr, fq * 8), boff = lds_byte(wc * 32 + fr, fq * 8);
#define PG8_SA(b, h) (((b) * 2 + (h)) * HTB)
#define PG8_SB(b, h) ((4 + (b) * 2 + (h)) * HTB)
#define PG8_STAGE(bufoff, gbase, voff) do { _Pragma("unroll") for (int _i = 0; _i < 2; ++_i) \
        __builtin_amdgcn_global_load_lds((const unsigned*)((const char*)(gbase) + (voff)[_i]), (PG8_LAS unsigned*)(lds + (bufoff) + ldsw + _i * 8192), 16, 0, 0); } while (0)
#define PG8_LDA(dst, b, h) do { _Pragma("unroll") for (int m = 0; m < 4; ++m) _Pragma("unroll") for (int k = 0; k < 2; ++k) dst[m][k] = *(const PG8_LAS bf16x8*)(lds + PG8_SA(b, h) + aoff + m * 2048 + k * 1024); } while (0)
#define PG8_LDB(dst, b, h) do { _Pragma("unroll") for (int n = 0; n < 2; ++n) _Pragma("unroll") for (int k = 0; k < 2; ++k) dst[n][k] = *(const PG8_LAS bf16x8*)(lds + PG8_SB(b, h) + boff + n * 2048 + k * 1024); } while (0)
#define PG8_MMA(ai, bj, At, Bt) do { __builtin_amdgcn_s_setprio(1); _Pragma("unroll") for (int m = 0; m < 4; ++m) _Pragma("unroll") for (int n = 0; n < 2; ++n) _Pragma("unroll") for (int k = 0; k < 2; ++k) \
        acc[ai][bj][m][n] = __builtin_amdgcn_mfma_f32_16x16x32_bf16(Bt[n][k], At[m][k], acc[ai][bj][m][n], 0, 0, 0); __builtin_amdgcn_s_setprio(0); } while (0)
#define PG8_WAIT_V(n) asm volatile("s_waitcnt vmcnt(" #n ")" ::: "memory")
#define PG8_WAIT_L(n) asm volatile("s_waitcnt lgkmcnt(" #n ")" ::: "memory")
#define PG8_BAR __builtin_amdgcn_s_barrier()
#define PG8_SCHED __builtin_amdgcn_sched_barrier(0)
    Unit cur, nxt; int ui = 0;
    if (!S.next(0, cur)) return;
    f32x4 acc[2][2][4][2];
#pragma unroll
    for (int a = 0; a < 2; ++a)
#pragma unroll
        for (int b = 0; b < 2; ++b)
#pragma unroll
            for (int m = 0; m < 4; ++m)
#pragma unroll
                for (int n = 0; n < 2; ++n) acc[a][b][m][n] = (f32x4){0.f, 0.f, 0.f, 0.f};
    bf16x8 At[4][2], B0[2][2], B1[2][2];
    const char* cA = (const char*)g.A + (size_t)cur.pm * tstep; const char* cB = (const char*)g.Bt + (size_t)cur.pn * tstep;
    S.a_ready(cur);
    if constexpr (SP2) {
        PG8_STAGE(PG8_SB(0, 0), cB, voffB); PG8_STAGE(PG8_SB(0, 1), cB + hstep, voffB); PG8_STAGE(PG8_SA(0, 0), cA, voffA); PG8_STAGE(PG8_SA(0, 1), cA + hstep, voffA);
        if (wr == 1) PG8_BAR;
        PG8_WAIT_V(2); PG8_BAR;
        PG8_STAGE(PG8_SB(1, 0), cB + kstep, voffB); PG8_STAGE(PG8_SA(1, 0), cA + kstep, voffA); PG8_STAGE(PG8_SB(1, 1), cB + hstep + kstep, voffB);
        PG8_WAIT_V(6); PG8_BAR;
    } else {
        PG8_STAGE(PG8_SB(0, 0), cB, voffB); PG8_STAGE(PG8_SA(0, 0), cA, voffA); PG8_STAGE(PG8_SB(0, 1), cB + hstep, voffB); PG8_STAGE(PG8_SA(0, 1), cA + hstep, voffA);
        if (wr == 1) PG8_BAR;
        PG8_WAIT_V(4); PG8_BAR;
        PG8_STAGE(PG8_SB(1, 0), cB + kstep, voffB); PG8_STAGE(PG8_SA(1, 0), cA + kstep, voffA); PG8_STAGE(PG8_SB(1, 1), cB + hstep + kstep, voffB);
        PG8_WAIT_V(6); PG8_BAR;
    }
    for (;;) {
        const bool has_next = S.next(ui + 1, nxt);
        const char* nA = has_next ? (const char*)g.A + (size_t)nxt.pm * tstep : cA; const char* nB = has_next ? (const char*)g.Bt + (size_t)nxt.pn * tstep : cB;
        for (int t = 0; t < nt; t += 2) {
            const bool last = (t == nt - 2);
            const char* a1 = cA + (size_t)(t + 1) * kstep;
            const char* a2 = last ? nA : cA + (size_t)(t + 2) * kstep; const char* b2 = last ? nB : cB + (size_t)(t + 2) * kstep;
            const char* a3 = a2 + kstep; const char* b3 = b2 + kstep;
            if (last && has_next) S.a_ready(nxt);
            if constexpr (SP2) {
            PG8_LDB(B0, 0, 0); PG8_LDB(B1, 0, 1); PG8_SCHED; PG8_LDA(At, 0, 0); PG8_STAGE(PG8_SA(1, 1), a1 + hstep, voffA);
            PG8_WAIT_V(8); PG8_WAIT_L(0); PG8_BAR; PG8_MMA(0, 0, At, B0); PG8_MMA(0, 1, At, B1); PG8_BAR; PG8_SCHED;
            PG8_LDA(At, 0, 1); PG8_STAGE(PG8_SB(0, 0), b2, voffB); PG8_STAGE(PG8_SB(0, 1), b2 + hstep, voffB); PG8_STAGE(PG8_SA(0, 0), a2, voffA);
            PG8_WAIT_V(8); PG8_WAIT_L(0); PG8_BAR; PG8_MMA(1, 0, At, B0); PG8_MMA(1, 1, At, B1); PG8_BAR; PG8_SCHED;
            PG8_LDB(B0, 1, 0); PG8_LDB(B1, 1, 1); PG8_SCHED; PG8_LDA(At, 1, 0); PG8_STAGE(PG8_SA(0, 1), a2 + hstep, voffA);
            PG8_WAIT_V(8); PG8_WAIT_L(0); PG8_BAR; PG8_MMA(0, 0, At, B0); PG8_MMA(0, 1, At, B1); PG8_BAR; PG8_SCHED;
            PG8_LDA(At, 1, 1); PG8_STAGE(PG8_SB(1, 0), b3, voffB); PG8_STAGE(PG8_SB(1, 1), b3 + hstep, voffB); PG8_STAGE(PG8_SA(1, 0), a3, voffA);
            PG8_WAIT_V(8); PG8_WAIT_L(0); PG8_BAR; PG8_MMA(1, 0, At, B0); PG8_MMA(1, 1, At, B1); PG8_BAR; PG8_SCHED;
            } else {
            PG8_LDB(B0, 0, 0); PG8_SCHED; PG8_LDA(At, 0, 0); PG8_STAGE(PG8_SA(1, 1), a1 + hstep, voffA);
            PG8_WAIT_L(8); PG8_BAR; PG8_WAIT_L(0); PG8_MMA(0, 0, At, B0); PG8_BAR; PG8_SCHED;
            PG8_LDB(B1, 0, 1); PG8_STAGE(PG8_SB(0, 0), b2, voffB);
            PG8_BAR; PG8_WAIT_L(0); PG8_MMA(0, 1, At, B1); PG8_BAR;
            PG8_LDA(At, 0, 1); PG8_STAGE(PG8_SA(0, 0), a2, voffA);
            PG8_BAR; PG8_WAIT_L(0); PG8_MMA(1, 0, At, B0); PG8_BAR; PG8_SCHED;
            PG8_STAGE(PG8_SB(0, 1), b2 + hstep, voffB);
            PG8_WAIT_V(6); PG8_BAR; PG8_MMA(1, 1, At, B1); PG8_BAR;
            PG8_LDB(B0, 1, 0); PG8_SCHED; PG8_LDA(At, 1, 0); PG8_STAGE(PG8_SA(0, 1), a2 + hstep, voffA);
            PG8_WAIT_L(8); PG8_BAR; PG8_WAIT_L(0); PG8_MMA(0, 0, At, B0); PG8_BAR; PG8_SCHED;
            PG8_LDB(B1, 1, 1); PG8_STAGE(PG8_SB(1, 0), b3, voffB);
            PG8_BAR; PG8_WAIT_L(0); PG8_MMA(0, 1, At, B1); PG8_BAR;
            PG8_LDA(At, 1, 1); PG8_STAGE(PG8_SA(1, 0), a3, voffA);
            PG8_BAR; PG8_WAIT_L(0); PG8_MMA(1, 0, At, B0); PG8_BAR; PG8_SCHED;
            PG8_STAGE(PG8_SB(1, 1), b3 + hstep, voffB);
            PG8_WAIT_V(6); PG8_BAR; PG8_MMA(1, 1, At, B1); PG8_BAR;
            }
        }
        if constexpr (ALIGN_EPI) { if (wr == 0) PG8_BAR; }
        if constexpr (!Epi::AFTER_DRAIN) { E(acc, cur, wr, wc, fr, fq); S.done(cur); }
        if (!has_next) break;
#pragma unroll
        for (int a = 0; a < 2; ++a)
#pragma unroll
            for (int b = 0; b < 2; ++b)
#pragma unroll
                for (int m = 0; m < 4; ++m)
#pragma unroll
                    for (int n = 0; n < 2; ++n) acc[a][b][m][n] = (f32x4){0.f, 0.f, 0.f, 0.f};
        cur = nxt; cA = nA; cB = nB; ++ui;
        if constexpr (ALIGN_EPI) { if (wr == 1) PG8_BAR; }
    }
    PG8_WAIT_V(0);
    if constexpr (!ALIGN_EPI) { if (wr == 0) PG8_BAR; }
    PG8_BAR;
    if constexpr (Epi::AFTER_DRAIN) { E.fused(acc, cur, wr, wc, fr, fq, lds, wid, lane); S.done(cur); }
#undef PG8_SA
#undef PG8_SB
#undef PG8_STAGE
#undef PG8_LDA
#undef PG8_LDB
#undef PG8_MMA
#undef PG8_WAIT_V
#undef PG8_WAIT_L
#undef PG8_BAR
#undef PG8_SCHED
}
}

template <class Epi>
__device__ __forceinline__ void gemm_naive(const bf16_t* A, int lda, const float* W, int K, int N, unsigned char* lds, Epi epi) {
    float (*As)[132] = (float (*)[132])lds;
    float (*Bs)[128] = (float (*)[128])(lds + 16 * 132 * 4);
    const int tid = threadIdx.x, tx = tid & 31, ty = tid >> 5;
    const int ntm = M / 128, ntn = (N + 127) / 128;
    for (int tile = blockIdx.x; tile < ntm * ntn; tile += gridDim.x) {
        const int tm = tile / ntn, tn = tile % ntn;
        float acc[8][4];
#pragma unroll
        for (int i = 0; i < 8; ++i)
#pragma unroll
            for (int j = 0; j < 4; ++j) acc[i][j] = 0.f;
        for (int k0 = 0; k0 < K; k0 += 16) {
            {   const int r = tid >> 2, kq = (tid & 3) * 4;
                const ushort4 v = *(const ushort4*)(A + (size_t)(tm * 128 + r) * lda + k0 + kq);
                As[kq + 0][r] = bf2f(v.x); As[kq + 1][r] = bf2f(v.y); As[kq + 2][r] = bf2f(v.z); As[kq + 3][r] = bf2f(v.w); }
            {   const int kk = tid >> 5, n4 = (tid & 31) * 4; const int n = tn * 128 + n4;
                const float* wp = W + (size_t)(k0 + kk) * N + n;
                float4 v;
                v.x = (n + 0 < N) ? wp[0] : 0.f; v.y = (n + 1 < N) ? wp[1] : 0.f; v.z = (n + 2 < N) ? wp[2] : 0.f; v.w = (n + 3 < N) ? wp[3] : 0.f;
                *(float4*)&Bs[kk][n4] = v; }
            __syncthreads();
#pragma unroll 2
            for (int kk = 0; kk < 16; ++kk) {
                const float4 a0 = *(const float4*)&As[kk][ty * 8], a1 = *(const float4*)&As[kk][ty * 8 + 4];
                const float4 b = *(const float4*)&Bs[kk][tx * 4];
                const float a[8] = {a0.x, a0.y, a0.z, a0.w, a1.x, a1.y, a1.z, a1.w};
                const float bb[4] = {b.x, b.y, b.z, b.w};
#pragma unroll
                for (int i = 0; i < 8; ++i)
#pragma unroll
                    for (int j = 0; j < 4; ++j) acc[i][j] = fmaf(a[i], bb[j], acc[i][j]);
            }
            __syncthreads();
        }
#pragma unroll
        for (int i = 0; i < 8; ++i)
#pragma unroll
            for (int j = 0; j < 4; ++j) { const int m = tm * 128 + ty * 8 + i, n = tn * 128 + tx * 4 + j; if (n < N) epi(m, n, acc[i][j]); }
    }
}

namespace fa {
typedef short bf16x8 __attribute__((ext_vector_type(8)));
typedef short s16x4 __attribute__((ext_vector_type(4)));
typedef float f32x16 __attribute__((ext_vector_type(16)));
typedef unsigned u32x4 __attribute__((ext_vector_type(4)));
#define FA_SBAR() __builtin_amdgcn_sched_barrier(0)
__device__ __forceinline__ int crow(int r, int hi) { return (r & 3) + 8 * (r >> 2) + 4 * hi; }
__device__ __forceinline__ unsigned cvtpk(float lo, float hi) { unsigned r; asm volatile("v_cvt_pk_bf16_f32 %0, %1, %2" : "=v"(r) : "v"(lo), "v"(hi)); return r; }
template <int NCB> __device__ __forceinline__ int v_st(int k, int c) { const int kk = (k & ~0xC) | ((k & 4) << 1) | ((k & 8) >> 1); return ((kk >> 3) * NCB + (c >> 5)) * 512 + ((kk & 7) * 32 + (c & 31)) * 2; }
__device__ __forceinline__ int v_rd_base(int lane) { return ((lane & 3) << 3) | (((lane >> 2) & 3) << 6) | (((lane >> 4) & 1) << 5) | (((lane >> 5) & 1) << 8); }
__device__ __forceinline__ void mask_tile(f32x16& p0, f32x16& p1, int dq, unsigned W) {
    const float NEG = -__builtin_inff();
#pragma unroll
    for (int r = 0; r < 16; ++r) { const int cc = (r & 3) + 8 * (r >> 2);
        if ((unsigned)(dq - cc) >= W) p0[r] = NEG;
        if ((unsigned)(dq - cc - 32) >= W) p1[r] = NEG; }
}
__device__ __forceinline__ void softmax_tile(f32x16& p0, f32x16& p1, float& m_reg, float& l_reg, float& alpha, bf16x8& pa0, bf16x8& pa1, bf16x8& pa2, bf16x8& pa3) {
    float pmax = p0[0];
#pragma unroll
    for (int r = 1; r < 16; ++r) pmax = fmaxf(pmax, p0[r]);
#pragma unroll
    for (int r = 0; r < 16; ++r) pmax = fmaxf(pmax, p1[r]);
    { auto rr = __builtin_amdgcn_permlane32_swap(__float_as_uint(pmax), __float_as_uint(pmax), false, false); pmax = fmaxf(__uint_as_float(rr[0]), __uint_as_float(rr[1])); }
    const float mn = fmaxf(m_reg, pmax);
    alpha = __builtin_amdgcn_exp2f(m_reg - mn); m_reg = mn;
#pragma unroll
    for (int r = 0; r < 16; ++r) { p0[r] = __builtin_amdgcn_exp2f(p0[r] - mn); p1[r] = __builtin_amdgcn_exp2f(p1[r] - mn); }
    float ps = 0.f;
#pragma unroll
    for (int r = 0; r < 16; ++r) ps += p0[r];
#pragma unroll
    for (int r = 0; r < 16; ++r) ps += p1[r];
    { auto rr = __builtin_amdgcn_permlane32_swap(__float_as_uint(ps), __float_as_uint(ps), false, false); ps = __uint_as_float(rr[0]) + __uint_as_float(rr[1]); }
    l_reg = l_reg * alpha + ps;
#define FA_PK4(P, B_, OUT) do { unsigned a0 = cvtpk(P[B_+0], P[B_+1]), a1 = cvtpk(P[B_+2], P[B_+3]); unsigned b0 = cvtpk(P[B_+4], P[B_+5]), b1 = cvtpk(P[B_+6], P[B_+7]); \
        auto r0 = __builtin_amdgcn_permlane32_swap(a0, b0, false, false); auto r1 = __builtin_amdgcn_permlane32_swap(a1, b1, false, false); \
        u32x4 w = {r0[0], r1[0], r0[1], r1[1]}; OUT = __builtin_bit_cast(bf16x8, w); } while (0)
    FA_PK4(p0, 0, pa0); FA_PK4(p0, 8, pa1); FA_PK4(p1, 0, pa2); FA_PK4(p1, 8, pa3);
#undef FA_PK4
}
template <int ND0, int KROW>
__device__ __forceinline__ void qkt(f32x16& p0, f32x16& p1, const LAS unsigned char* kp, const bf16x8* qr) {
    p0 = f32x16{}; p1 = f32x16{};
#pragma unroll
    for (int d0 = 0; d0 < ND0; ++d0) {
        const bf16x8 b0 = *(const LAS bf16x8*)(kp + d0 * 32);
        const bf16x8 b1 = *(const LAS bf16x8*)(kp + 32 * KROW + d0 * 32);
        p0 = __builtin_amdgcn_mfma_f32_32x32x16_bf16(b0, qr[d0], p0, 0, 0, 0);
        p1 = __builtin_amdgcn_mfma_f32_32x32x16_bf16(b1, qr[d0], p1, 0, 0, 0);
    }
}
#define FA_TRRD(dst, off) asm volatile("ds_read_b64_tr_b16 %0, %1 offset:%2" : "=&v"(dst) : "v"(vb), "i"(off) : "memory")
template <int NCB, int D0>
__device__ __forceinline__ void pv_d0(f32x16* o, int vb, bf16x8 pa0, bf16x8 pa1, bf16x8 pa2, bf16x8 pa3) {
    s16x4 l0, l1, l2, l3, h0, h1, h2, h3; constexpr int b_ = D0 * 512, HS = NCB * 512, KS = 2 * NCB * 512;
    FA_TRRD(l0, b_); FA_TRRD(h0, b_ + HS); FA_TRRD(l1, b_ + KS); FA_TRRD(h1, b_ + KS + HS); FA_TRRD(l2, b_ + 2 * KS); FA_TRRD(h2, b_ + 2 * KS + HS); FA_TRRD(l3, b_ + 3 * KS); FA_TRRD(h3, b_ + 3 * KS + HS);
    asm volatile("s_waitcnt lgkmcnt(0)" ::: "memory"); FA_SBAR();
    o[D0] = __builtin_amdgcn_mfma_f32_32x32x16_bf16(pa0, (bf16x8){l0[0], l0[1], l0[2], l0[3], h0[0], h0[1], h0[2], h0[3]}, o[D0], 0, 0, 0);
    o[D0] = __builtin_amdgcn_mfma_f32_32x32x16_bf16(pa1, (bf16x8){l1[0], l1[1], l1[2], l1[3], h1[0], h1[1], h1[2], h1[3]}, o[D0], 0, 0, 0);
    o[D0] = __builtin_amdgcn_mfma_f32_32x32x16_bf16(pa2, (bf16x8){l2[0], l2[1], l2[2], l2[3], h2[0], h2[1], h2[2], h2[3]}, o[D0], 0, 0, 0);
    o[D0] = __builtin_amdgcn_mfma_f32_32x32x16_bf16(pa3, (bf16x8){l3[0], l3[1], l3[2], l3[3], h3[0], h3[1], h3[2], h3[3]}, o[D0], 0, 0, 0);
}
template <int NCB>
__device__ __forceinline__ void rescale_o(f32x16* o, float alpha, LAS float* al, int r32, int hi) {
    if (__any(alpha < 1.f)) {
        if (hi == 0) al[r32] = alpha;
        asm volatile("s_waitcnt lgkmcnt(0)" ::: "memory");
        float f[16]; const LAS float* alh = al + 4 * hi;
#pragma unroll
        for (int r = 0; r < 16; ++r) f[r] = alh[(r & 3) + 8 * (r >> 2)];
#pragma unroll
        for (int d = 0; d < NCB; ++d)
#pragma unroll
            for (int r = 0; r < 16; ++r) o[d][r] *= f[r];
    }
}
}

namespace mla {
constexpr int KROW = 400, KBUF = 64 * KROW, VBUF = 64 * 128 * 2;
constexpr int L_K = 0, L_V = 2 * KBUF, L_AL = L_V + 2 * VBUF, L_END = L_AL + 8 * 64 * 4;
using namespace fa;
__device__ __forceinline__ void unit(const Ctx& c, unsigned char* lds, int b, int h, int qb) {
    const int tid = threadIdx.x, lane = tid & 63, r32 = lane & 31, hi = lane >> 5; const int wid = __builtin_amdgcn_readfirstlane(tid >> 6);
    LAS unsigned char* L = (LAS unsigned char*)lds;
    const size_t rowbase = (size_t)b * SEQ; const int q0 = qb * 256;
    bf16x8 qr[12];
    { const bf16_t* qrow = c.Q1 + (rowbase + q0 + wid * 32 + r32) * 1536 + h * 192 + hi * 8;
#pragma unroll
      for (int d0 = 0; d0 < 12; ++d0) qr[d0] = *(const bf16x8*)(qrow + d0 * 16); }
    const bf16_t* kvb = c.KV1 + rowbase * 2048 + h * 256; const bf16_t* kpb = c.KPE + rowbase * 64;
    const unsigned koff = (unsigned)((tid >> 4) * 2048 + (tid & 15) * 8), kpoff = (unsigned)((tid >> 3) * 64 + (tid & 7) * 8);
    const int kw0 = (tid >> 4) * KROW + (tid & 15) * 16, kpw = (tid >> 3) * KROW + 256 + (tid & 7) * 16;
    const int vw0 = v_st<4>(tid >> 4, (tid & 15) * 8), vw1 = v_st<4>(32 + (tid >> 4), (tid & 15) * 8);
    u32x4 sk0, sk1, skp, sv0, sv1;
#define MLA_LOAD(j) do { const bf16_t* kn_ = kvb + (size_t)(j) * 64 * 2048; sk0 = *(const u32x4*)(kn_ + koff); sk1 = *(const u32x4*)(kn_ + koff + 32 * 2048); sv0 = *(const u32x4*)(kn_ + koff + 128); sv1 = *(const u32x4*)(kn_ + koff + 32 * 2048 + 128); \
        skp = *(const u32x4*)(kpb + (size_t)(j) * 64 * 64 + kpoff); } while (0)
#define MLA_WRITE(B) do { *(LAS u32x4*)(L + L_K + (B) * KBUF + kw0) = sk0; *(LAS u32x4*)(L + L_K + (B) * KBUF + kw0 + 32 * KROW) = sk1; *(LAS u32x4*)(L + L_K + (B) * KBUF + kpw) = skp; \
        *(LAS u32x4*)(L + L_V + (B) * VBUF + vw0) = sv0; *(LAS u32x4*)(L + L_V + (B) * VBUF + vw1) = sv1; } while (0)
    const LAS unsigned char* kp0 = L + L_K + r32 * KROW + hi * 16;
    const int vb0 = (int)(uintptr_t)lds + L_V + v_rd_base(lane);
    LAS float* al = (LAS float*)(L + L_AL) + wid * 64;
    const int NT = 4 * qb + 4;
    const int qm = q0 + wid * 32 + r32 - 4 * hi;
    float m_reg = -1e30f, l_reg = 0.f; f32x16 o[4] = {};
    MLA_LOAD(0); MLA_WRITE(0); __syncthreads();
#define MLA_STEP(t, B) do { \
        if ((t) + 1 < NT) MLA_LOAD((t) + 1); \
        f32x16 p0, p1; qkt<12, KROW>(p0, p1, kp0 + (B) * KBUF, qr); \
        if ((t) >= NT - 4) mask_tile(p0, p1, qm - 64 * (t), 0x7fffffffu); \
        float alpha; bf16x8 pa0, pa1, pa2, pa3; softmax_tile(p0, p1, m_reg, l_reg, alpha, pa0, pa1, pa2, pa3); \
        rescale_o<4>(o, alpha, al, r32, hi); \
        { const int vb = vb0 + (B) * VBUF; pv_d0<4, 0>(o, vb, pa0, pa1, pa2, pa3); pv_d0<4, 1>(o, vb, pa0, pa1, pa2, pa3); pv_d0<4, 2>(o, vb, pa0, pa1, pa2, pa3); pv_d0<4, 3>(o, vb, pa0, pa1, pa2, pa3); } \
        if ((t) + 1 < NT) MLA_WRITE((B) ^ 1); \
        __syncthreads(); } while (0)
    for (int t = 0; t < NT; t += 2) { MLA_STEP(t, 0); MLA_STEP(t + 1, 1); }
#undef MLA_STEP
#undef MLA_LOAD
#undef MLA_WRITE
    if (hi == 0) al[r32] = l_reg;
    asm volatile("s_waitcnt lgkmcnt(0)" ::: "memory");
    const size_t orow0 = rowbase + q0 + wid * 32;
    const LAS float* alh = al + 4 * hi;
    const bf16_t* gp0 = c.PC + (orow0 + 4 * hi) * PC_LD + PC_G + h * 128 + r32; bf16_t* op0 = c.O1 + (orow0 + 4 * hi) * DM + h * 128 + r32;
#pragma unroll
    for (int r = 0; r < 16; ++r) { const int rc = (r & 3) + 8 * (r >> 2); const float rl = 1.f / alh[rc];
        const bf16_t* gp = gp0 + rc * PC_LD; bf16_t* op = op0 + rc * DM;
#pragma unroll
        for (int d0 = 0; d0 < 4; ++d0) { const float v = o[d0][r] * rl * siluf(bf2f(gp[d0 * 32])); const float vn = __shfl_xor(v, 1);
            if ((r32 & 1) == 0) *(unsigned*)(op + d0 * 32) = cvtpk(v, vn); } }
    __syncthreads();
}
__device__ __forceinline__ void phase(const Ctx& c, unsigned char* lds) {
    const int G = gridDim.x, bx = blockIdx.x; const int vcu = (G % 8 == 0) ? (bx % 8) * (G / 8) + bx / 8 : bx;
    for (int item = vcu; item < 256; item += G) {
        const int bh = item >> 2, s_ = item & 3;
#pragma unroll 1
        for (int i = 0; i < 4; ++i) { const int qb = (i == 0) ? s_ : (i == 1) ? 7 - s_ : (i == 2) ? 8 + s_ : 15 - s_; unit(c, lds, bh >> 3, bh & 7, qb); }
    }
}
}

__device__ __forceinline__ int natA(int p) {
    if (p < 768) { const int T = p >> 8, q = p & 255, half = q >> 7, hh = (q & 127) >> 5, i = q & 31;
        const int base = (T == 0) ? 64 * hh : (T == 1) ? 256 + 64 * hh : (hh < 2 ? 768 + 64 * hh : 1024 + 64 * (hh - 2));
        return base + 32 * half + i; }
    if (p < 1024) return 512 + (p - 768);
    if (p < 1152) return 896 + (p - 1024);
    if (p < 1280) return p;
    if (p < 3840) return p + 24;
    if (p < 3864) return 1280 + (p - 3840);
    return -1;
}
__device__ __forceinline__ int natC(int p) { return p < 512 ? p : (p < 1536 ? p + 64 : (p < 1600 ? 512 + (p - 1536) : -1)); }
__device__ __forceinline__ unsigned pk2(float lo, float hi) { return (unsigned)f2bf(lo) | ((unsigned)f2bf(hi) << 16); }
template <int MAP>
__device__ __forceinline__ void transpose_item(const float* W, int K, int Nsrc, int Ndst, bf16_t* WT, float* scr, int item, int lane) {
    const int nblk = Ndst / 32, kb = item / nblk, nb = item % nblk, k0 = 64 * kb, p0 = 32 * nb;
    const int p = p0 + (lane & 31);
    const int sc = (MAP == 0) ? natA(p) : (MAP == 1) ? natC(p) : p;
#pragma unroll 8
    for (int i = 0; i < 32; ++i) { const int kk = 2 * i + (lane >> 5); scr[kk * 33 + (lane & 31)] = (sc >= 0) ? W[(size_t)(k0 + kk) * Nsrc + sc] : 0.f; }
    WSYNC();
    const int c = lane & 7;
#pragma unroll
    for (int j = 0; j < 4; ++j) { const int n = (lane >> 3) + 8 * j; const float* sp = scr + (8 * c) * 33 + n;
        uint4 o; o.x = pk2(sp[0 * 33], sp[1 * 33]); o.y = pk2(sp[2 * 33], sp[3 * 33]); o.z = pk2(sp[4 * 33], sp[5 * 33]); o.w = pk2(sp[6 * 33], sp[7 * 33]);
        *(uint4*)(WT + (size_t)(p0 + n) * K + k0 + 8 * c) = o; }
    WSYNC();
}
__device__ __forceinline__ void ph0_weights(const Ctx& c, unsigned char* lds) {
    const int lane = threadIdx.x & 63, wave = threadIdx.x >> 6;
    float* scr = (float*)(lds + wave * 16384);
    const int gw = blockIdx.x * NWV + wave, NGW = gridDim.x * NWV;
    constexpr int I_A = 16 * 128, I_OA = 16 * 32, I_C = 16 * 56, I_UQ = 4 * 48, I_UKV = 4 * 64, I_OC = 16 * 32;
    constexpr int NITEMS = I_A + I_OA + I_C + I_UQ + I_UKV + I_OC;
    for (int it = gw; it < NITEMS; it += NGW) {
        int r = it;
        if (r < I_A) { transpose_item<0>(c.a_w_in, 1024, NIN_A, 4096, (bf16_t*)(c.ws + WS_WTA), scr, r, lane); continue; } r -= I_A;
        if (r < I_OA) { transpose_item<2>(c.a_w_out, 1024, 1024, 1024, (bf16_t*)(c.ws + WS_WTOA), scr, r, lane); continue; } r -= I_OA;
        if (r < I_C) { transpose_item<1>(c.c_w_in, 1024, NIN_C, 1792, (bf16_t*)(c.ws + WS_WTC), scr, r, lane); continue; } r -= I_C;
        if (r < I_UQ) { transpose_item<2>(c.w_uq, 256, 1536, 1536, (bf16_t*)(c.ws + WS_WTUQ), scr, r, lane); continue; } r -= I_UQ;
        if (r < I_UKV) { transpose_item<2>(c.w_ukv, 256, 2048, 2048, (bf16_t*)(c.ws + WS_WTUKV), scr, r, lane); continue; } r -= I_UKV;
        transpose_item<2>(c.c_w_out, 1024, 1024, 1024, (bf16_t*)(c.ws + WS_WTOC), scr, r, lane);
    }
}

__device__ __forceinline__ void ph0_prologue(const Ctx& c) {
    for (int idx = blockIdx.x * NTHR + threadIdx.x; idx < M * 32; idx += gridDim.x * NTHR) {
        const int m = idx >> 5, i = idx & 31;
        const float invf = (float)exp2(-(double)i * (13.287712379549449 / 32.0));
        const float ang = (float)c.pos[m] * invf;
        float s, co; sincos_acc(ang, s, co);
        c.CS[idx] = make_float2(co, s);
    }
    const int lane = threadIdx.x & 63, gw = blockIdx.x * NWV + (threadIdx.x >> 6), NGW = gridDim.x * NWV;
    for (int m = gw; m < M; m += NGW) rms_row_f32(c.x + (size_t)m * DM, c.a_norm, c.XN + (size_t)m * DM, lane);
}
__device__ __forceinline__ int pa_col(int n) { return n < 1280 ? n : (n < 1304 ? PA_GL + (n - 1280) : n - 24); }
__device__ __forceinline__ int pc_col(int n) { return n < 512 ? n : (n < 576 ? PC_KR + (n - 512) : n - 64); }

__device__ __forceinline__ void ph2_rope_a(const Ctx& c) {
    for (size_t idx = (size_t)blockIdx.x * NTHR + threadIdx.x; idx < (size_t)M * 12 * 32; idx += (size_t)gridDim.x * NTHR) {
        const int i = (int)(idx & 31); const size_t r = idx >> 5; const int slot = (int)(r % 12); const int m = (int)(r / 12);
        const int base = slot < 8 ? PA_Q + slot * 64 : (slot < 10 ? PA_KS + (slot - 8) * 64 : PA_KW + (slot - 10) * 64);
        const float sc = slot < 8 ? QSCALE_A : 1.f;
        bf16_t* p = c.PA + (size_t)m * PA_LD + base + i;
        const float x1 = bf2f(p[0]), x2 = bf2f(p[32]);
        const float2 cs = c.CS[(size_t)m * 32 + i];
        p[0] = f2bf((x1 * cs.x - x2 * cs.y) * sc); p[32] = f2bf((x2 * cs.x + x1 * cs.y) * sc);
    }
}

__device__ __forceinline__ void ph3_compress(const Ctx& c, unsigned char* lds) {
    float* blk = (float*)lds;
    float* part = blk + 8 * 2048;
    float* hid = part + 4 * 8 * 128;
    float* outp = hid + 8 * 128;
    float* outs = outp + 8 * 8 * 64;
    const int tid = threadIdx.x;
    for (int item = blockIdx.x; item < 2 * BATCH * 2 * 32; item += gridDim.x) {
        const int ct = item & 31, g = (item >> 5) & 1, b = (item >> 6) & 7, kv = item >> 9;
        const float* pe = kv ? c.pe_v : c.pe_k; const float* w1 = kv ? c.w_cv1 : c.w_ck1; const float* w2 = kv ? c.w_cv2 : c.w_ck2;
        const int col0 = (kv ? PA_VC : PA_KC) + g * 64;
        __syncthreads();
        for (int e = tid; e < 8 * 2048; e += NTHR) {
            const int ci = e >> 11, k = e & 2047, l = k >> 6, d = k & 63; const int cidx = ct * 8 + ci;
            float v = 0.f;
            if (cidx < 255) v = bf2f(c.PA[(size_t)(b * SEQ + 16 * cidx + l) * PA_LD + col0 + d]) + pe[l * 64 + d];
            blk[e] = v;
        }
        __syncthreads();
        {   const int j = tid & 127, pt = tid >> 7;
            float acc[8];
#pragma unroll
            for (int ci = 0; ci < 8; ++ci) acc[ci] = 0.f;
            for (int k = pt * 512; k < pt * 512 + 512; ++k) {
                const float w = w1[(size_t)k * 128 + j];
#pragma unroll
                for (int ci = 0; ci < 8; ++ci) acc[ci] = fmaf(blk[ci * 2048 + k], w, acc[ci]);
            }
#pragma unroll
            for (int ci = 0; ci < 8; ++ci) part[(pt * 8 + ci) * 128 + j] = acc[ci];
        }
        __syncthreads();
        for (int e = tid; e < 8 * 128; e += NTHR) { const int ci = e >> 7, j = e & 127; const float s = (part[(0 * 8 + ci) * 128 + j] + part[(1 * 8 + ci) * 128 + j]) + (part[(2 * 8 + ci) * 128 + j] + part[(3 * 8 + ci) * 128 + j]); hid[e] = siluf(s); }
        __syncthreads();
        {   const int d = tid & 63, pt = tid >> 6;
            float acc[8];
#pragma unroll
            for (int ci = 0; ci < 8; ++ci) acc[ci] = 0.f;
            for (int j = pt * 16; j < pt * 16 + 16; ++j) {
                const float w = w2[j * 64 + d];
#pragma unroll
                for (int ci = 0; ci < 8; ++ci) acc[ci] = fmaf(hid[ci * 128 + j], w, acc[ci]);
            }
#pragma unroll
            for (int ci = 0; ci < 8; ++ci) outp[(pt * 8 + ci) * 64 + d] = acc[ci];
        }
        __syncthreads();
        {   const int ci = tid >> 6, d = tid & 63; float s = 0.f;
#pragma unroll
            for (int pt = 0; pt < 8; ++pt) s += outp[(pt * 8 + ci) * 64 + d];
            outs[ci * 64 + d] = s; }
        __syncthreads();
        {   const int ci = tid >> 6, d = tid & 63; const int cidx = ct * 8 + ci;
            float v = outs[ci * 64 + d];
            if (kv == 0 && cidx < 255) {
                const int i = d & 31; const float2 cs = c.CS[(size_t)(b * SEQ + 16 * cidx + 31) * 32 + i];
                const float x1 = outs[ci * 64 + i], x2 = outs[ci * 64 + i + 32];
                v = (d < 32) ? (x1 * cs.x - x2 * cs.y) : (x2 * cs.x + x1 * cs.y);
            }
            if (cidx >= 255) v = 0.f;
            bf16_t* dst = (kv ? c.VCMP : c.KCMP) + ((size_t)(b * 2 + g) * 256 + cidx) * 64 + d;
            *dst = f2bf(v);
        }
    }
    __syncthreads();
}

__device__ __forceinline__ float dot64(const bf16_t* krow, const float* q) {
    float s = 0.f;
#pragma unroll
    for (int ch = 0; ch < 8; ++ch) {
        const uint4 v = *(const uint4*)(krow + ch * 8);
        const unsigned w[4] = {v.x, v.y, v.z, v.w};
#pragma unroll
        for (int e = 0; e < 4; ++e) { s = fmaf(__uint_as_float(w[e] << 16), q[ch * 8 + 2 * e], s); s = fmaf(__uint_as_float(w[e] & 0xffff0000u), q[ch * 8 + 2 * e + 1], s); }
    }
    return s;
}

__device__ __forceinline__ void ph4_nsa(const Ctx& c, unsigned char* lds) {
    const int lane = threadIdx.x & 63, wave = threadIdx.x >> 6;
    float* wq = (float*)(lds + wave * 12288);
    float* wp = wq + 64;
    float* wpc = wp + 1024;
    float* wres = wpc + 1024;
    const int gw = blockIdx.x * NWV + wave, NGW = gridDim.x * NWV;
    for (int item = gw; item < M * 2; item += NGW) {
        const int g = item & 1, m = item >> 1; const int b = m / SEQ, t = m % SEQ;
        const bf16_t* parow = c.PA + (size_t)m * PA_LD;
        const bf16_t* pab = c.PA + (size_t)b * SEQ * PA_LD;
        const bf16_t* kc = c.KCMP + (size_t)(b * 2 + g) * 256 * 64; const bf16_t* vc = c.VCMP + (size_t)(b * 2 + g) * 256 * 64;
        const int nvalid = t >= 31 ? min((t - 31) / 16 + 1, 255) : 0;
        for (int hh = 0; hh < 4; ++hh) {
            const int head = g * 4 + hh;
            WSYNC(); wq[lane] = bf2f(parow[PA_Q + head * 64 + lane]); WSYNC();
            float s[4]; float mx = -INFINITY;
#pragma unroll
            for (int jj = 0; jj < 4; ++jj) { const int ci = lane + 64 * jj; s[jj] = (ci < nvalid) ? dot64(kc + (size_t)ci * 64, wq) : -INFINITY; mx = fmaxf(mx, s[jj]); }
            mx = wave_max(mx);
            float sum = 0.f;
#pragma unroll
            for (int jj = 0; jj < 4; ++jj) { s[jj] = (nvalid > 0) ? exp2f(s[jj] - mx) : 0.f; sum += s[jj]; }
            sum = wave_sum(sum);
            const float inv = nvalid > 0 ? 1.f / sum : 0.f;
#pragma unroll
            for (int jj = 0; jj < 4; ++jj) wpc[hh * 256 + lane + 64 * jj] = s[jj] * inv;
            WSYNC();
            float o = 0.f;
            for (int ci = 0; ci < nvalid; ++ci) o = fmaf(wpc[hh * 256 + ci], bf2f(vc[(size_t)ci * 64 + lane]), o);
            wres[(hh * 3 + 0) * 64 + lane] = o;
        }
        unsigned long long selmask;
        {   const int n = lane; float imp = 0.f;
            const int c_lo = max(4 * n - 1, 0), c_hi = min(4 * n + 3, 254);
            for (int hh = 0; hh < 4; ++hh) for (int ci = c_lo; ci <= c_hi; ++ci) imp += wpc[hh * 256 + ci];
            const bool bv = (64 * n <= t); const int cur = t >> 6;
            const bool forced = (n == 0) || (n == cur) || (n == cur - 1);
            const float sc = bv ? (forced ? 1e4f : imp) : -1.f;
            int rank = 0;
            for (int mm = 0; mm < 64; ++mm) { const float o = __shfl(sc, mm); rank += (o > sc || (o == sc && mm < n)) ? 1 : 0; }
            selmask = __ballot(rank < 16 && bv);
        }
        for (int hh = 0; hh < 4; ++hh) {
            const int head = g * 4 + hh;
            WSYNC(); wq[lane] = bf2f(parow[PA_Q + head * 64 + lane]); WSYNC();
            {   unsigned long long sm = selmask; int slot = 0; float mx = -INFINITY;
                while (sm) { const int n = __builtin_ctzll(sm); sm &= sm - 1; const int tok = n * 64 + lane;
                    const float s = (tok <= t) ? dot64(pab + (size_t)tok * PA_LD + PA_KS + g * 64, wq) : -INFINITY;
                    wp[slot * 64 + lane] = s; mx = fmaxf(mx, s); ++slot; }
                mx = wave_max(mx);
                float sum = 0.f;
                for (int sl = 0; sl < slot; ++sl) { const float p = exp2f(wp[sl * 64 + lane] - mx); wp[sl * 64 + lane] = p; sum += p; }
                sum = wave_sum(sum); WSYNC();
                float o = 0.f; sm = selmask; slot = 0;
                while (sm) { const int n = __builtin_ctzll(sm); sm &= sm - 1;
                    const int kmax = min(63, t - n * 64);
                    for (int kk = 0; kk <= kmax; ++kk) o = fmaf(wp[slot * 64 + kk], bf2f(pab[(size_t)(n * 64 + kk) * PA_LD + PA_VS + g * 64 + lane]), o);
                    ++slot; }
                wres[(hh * 3 + 1) * 64 + lane] = o / sum; }
            WSYNC();
            {   float mx = -INFINITY;
                for (int j = 0; j < 8; ++j) { const int kp = t - 511 + 64 * j + lane;
                    const float s = (kp >= 0) ? dot64(pab + (size_t)kp * PA_LD + PA_KW + g * 64, wq) : -INFINITY;
                    wp[j * 64 + lane] = s; mx = fmaxf(mx, s); }
                mx = wave_max(mx);
                float sum = 0.f;
                for (int j = 0; j < 8; ++j) { const float p = exp2f(wp[j * 64 + lane] - mx); wp[j * 64 + lane] = p; sum += p; }
                sum = wave_sum(sum); WSYNC();
                float o = 0.f;
                const int k_lo = max(0, 511 - t);
                for (int kk = k_lo; kk < 512; ++kk) o = fmaf(wp[kk], bf2f(pab[(size_t)(t - 511 + kk) * PA_LD + PA_VW + g * 64 + lane]), o);
                wres[(hh * 3 + 2) * 64 + lane] = o / sum; }
        }
        for (int hh = 0; hh < 4; ++hh) {
            const int head = g * 4 + hh;
            const float g0 = sigmoidf_(bf2f(parow[PA_GL + head * 3 + 0])), g1 = sigmoidf_(bf2f(parow[PA_GL + head * 3 + 1])), g2 = sigmoidf_(bf2f(parow[PA_GL + head * 3 + 2]));
            const float o = g0 * wres[(hh * 3 + 0) * 64 + lane] + g1 * wres[(hh * 3 + 1) * 64 + lane] + g2 * wres[(hh * 3 + 2) * 64 + lane];
            const float ga = bf2f(parow[PA_GA + head * 64 + lane]);
            c.MIX[(size_t)m * DM + head * 64 + lane] = f2bf(siluf(ga) * o);
        }
    }
}

__device__ __forceinline__ void ph5_conv(const Ctx& c) {
    for (size_t idx = (size_t)blockIdx.x * NTHR + threadIdx.x; idx < (size_t)M * 512; idx += (size_t)gridDim.x * NTHR) {
        const int ch = (int)(idx & 511); const int m = (int)(idx >> 9); const int t = m % SEQ;
        const bf16_t* r0 = c.PA + (size_t)m * PA_LD;
        float y = c.conv_w[2 * 512 + ch] * bf2f(r0[PA_CC + ch]) * bf2f(r0[PA_CH + ch]);
        if (t >= 1) { const bf16_t* r1 = r0 - PA_LD; y += c.conv_w[1 * 512 + ch] * bf2f(r1[PA_CC + ch]) * bf2f(r1[PA_CH + ch]); }
        if (t >= 2) { const bf16_t* r2 = r0 - 2 * PA_LD; y += c.conv_w[0 * 512 + ch] * bf2f(r2[PA_CC + ch]) * bf2f(r2[PA_CH + ch]); }
        c.MIX[(size_t)m * DM + 512 + ch] = f2bf(siluf(bf2f(r0[PA_GB + ch])) * bf2f(r0[PA_CB + ch]) * y);
    }
}

__device__ __forceinline__ void ph7_norm1(const Ctx& c) {
    const int lane = threadIdx.x & 63, gw = blockIdx.x * NWV + (threadIdx.x >> 6), NGW = gridDim.x * NWV;
    for (int m = gw; m < M; m += NGW) rms_row_f32(c.out + (size_t)m * DM, c.c_norm, c.XN + (size_t)m * DM, lane);
}
__device__ __forceinline__ void ph_final(const Ctx& c) {
    const int lane = threadIdx.x & 63, gw = blockIdx.x * NWV + (threadIdx.x >> 6), NGW = gridDim.x * NWV;
    for (int m = gw; m < M; m += NGW) {
        float* xr = c.out + (size_t)m * DM;
        float4 v[4]; float s = 0.f;
#pragma unroll
        for (int j = 0; j < 4; ++j) { v[j] = *(const float4*)(xr + 4 * lane + 256 * j); s += (v[j].x * v[j].x + v[j].y * v[j].y) + (v[j].z * v[j].z + v[j].w * v[j].w); }
        const float rstd = 1.f / sqrtf(wave_sum(s) * (1.f / DM) + RMS_EPS);
#pragma unroll
        for (int j = 0; j < 4; ++j) { const float4 gg = *(const float4*)(c.final_norm + 4 * lane + 256 * j);
            float4 o; o.x = v[j].x * rstd * gg.x; o.y = v[j].y * rstd * gg.y; o.z = v[j].z * rstd * gg.z; o.w = v[j].w * rstd * gg.w;
            *(float4*)(xr + 4 * lane + 256 * j) = o; }
    }
}

__device__ __forceinline__ void ph9_lat_norm(const Ctx& c) {
    const int lane = threadIdx.x & 63, gw = blockIdx.x * NWV + (threadIdx.x >> 6), NGW = gridDim.x * NWV;
    for (int m = gw; m < M; m += NGW) {
        const bf16_t* r = c.PC + (size_t)m * PC_LD;
#pragma unroll
        for (int w = 0; w < 2; ++w) {
            const ushort4 v = *(const ushort4*)(r + (w ? PC_CKV : PC_CQ) + 4 * lane);
            const float a0 = bf2f(v.x), a1 = bf2f(v.y), a2 = bf2f(v.z), a3 = bf2f(v.w);
            const float rstd = 1.f / sqrtf(wave_sum(a0 * a0 + a1 * a1 + a2 * a2 + a3 * a3) * (1.f / 256.f) + RMS_EPS);
            const float4 gg = *(const float4*)((w ? c.kv_norm : c.q_norm) + 4 * lane);
            ushort4 o; o.x = f2bf(a0 * rstd * gg.x); o.y = f2bf(a1 * rstd * gg.y); o.z = f2bf(a2 * rstd * gg.z); o.w = f2bf(a3 * rstd * gg.w);
            *(ushort4*)((w ? c.CKVN : c.CQN) + (size_t)m * 256 + 4 * lane) = o;
        }
        if (lane < 32) {
            const float x1 = bf2f(r[PC_KR + lane]), x2 = bf2f(r[PC_KR + lane + 32]); const float2 cs = c.CS[(size_t)m * 32 + lane];
            c.KPE[(size_t)m * 64 + lane] = f2bf(x1 * cs.x - x2 * cs.y); c.KPE[(size_t)m * 64 + lane + 32] = f2bf(x2 * cs.x + x1 * cs.y);
        }
    }
}
__device__ __forceinline__ void ph11_rope_q1(const Ctx& c) {
    for (size_t idx = (size_t)blockIdx.x * NTHR + threadIdx.x; idx < (size_t)M * 8 * 96; idx += (size_t)gridDim.x * NTHR) {
        const int e = (int)(idx % 96); const size_t r = idx / 96; const int h = (int)(r & 7); const int m = (int)(r >> 3);
        bf16_t* q = c.Q1 + (size_t)m * 1536 + h * 192;
        if (e < 64) { q[e] = f2bf(bf2f(q[e]) * QSCALE_C); q[e + 64] = f2bf(bf2f(q[e + 64]) * QSCALE_C); }
        else { const int i = e - 64; const float2 cs = c.CS[(size_t)m * 32 + i];
            const float x1 = bf2f(q[128 + i]), x2 = bf2f(q[160 + i]);
            q[128 + i] = f2bf((x1 * cs.x - x2 * cs.y) * QSCALE_C); q[160 + i] = f2bf((x2 * cs.x + x1 * cs.y) * QSCALE_C); }
    }
}
__device__ __forceinline__ void ph12_mla(const Ctx& c, unsigned char* lds) {
    const int lane = threadIdx.x & 63, wave = threadIdx.x >> 6;
    float* wq = (float*)(lds + wave * 2048);
    float* wp = wq + 192;
    const int gw = blockIdx.x * NWV + wave, NGW = gridDim.x * NWV;
    for (int item = gw; item < M * 8; item += NGW) {
        const int h = item & 7, m = item >> 3; const int b = m / SEQ, t = m % SEQ;
        WSYNC();
        const bf16_t* qrow = c.Q1 + (size_t)m * 1536 + h * 192;
        wq[lane] = bf2f(qrow[lane]); wq[64 + lane] = bf2f(qrow[64 + lane]); wq[128 + lane] = bf2f(qrow[128 + lane]);
        WSYNC();
        float mrun = -1e30f, l = 0.f, o0 = 0.f, o1 = 0.f;
        const bf16_t* kvb = c.KV1 + (size_t)b * SEQ * 2048 + h * 256; const bf16_t* kpb = c.KPE + (size_t)b * SEQ * 64;
        for (int k0 = 0; k0 <= t; k0 += 64) {
            const int key = k0 + lane;
            float s = -INFINITY;
            if (key <= t) { const bf16_t* kr = kvb + (size_t)key * 2048; s = dot64(kr, wq) + dot64(kr + 64, wq + 64) + dot64(kpb + (size_t)key * 64, wq + 128); }
            const float cm = wave_max(s);
            const float mn = fmaxf(mrun, cm); const float alpha = exp2f(mrun - mn); mrun = mn;
            const float p = exp2f(s - mn);
            l = l * alpha + wave_sum(p); o0 *= alpha; o1 *= alpha;
            WSYNC(); wp[lane] = p; WSYNC();
            const int kmax = min(63, t - k0);
            for (int kk = 0; kk <= kmax; ++kk) { const bf16_t* vr = kvb + (size_t)(k0 + kk) * 2048 + 128; const float pp = wp[kk]; o0 = fmaf(pp, bf2f(vr[lane]), o0); o1 = fmaf(pp, bf2f(vr[64 + lane]), o1); }
        }
        const float inv = 1.f / l;
        const bf16_t* gr = c.PC + (size_t)m * PC_LD + PC_G + h * 128;
        c.O1[(size_t)m * DM + h * 128 + lane] = f2bf(siluf(bf2f(gr[lane])) * o0 * inv);
        c.O1[(size_t)m * DM + h * 128 + 64 + lane] = f2bf(siluf(bf2f(gr[64 + lane])) * o1 * inv);
    }
}

constexpr int NPHASE = 15;
__global__ void __launch_bounds__(NTHR, 2) mk_fwd(Args a) {
    extern __shared__ __attribute__((aligned(16))) unsigned char lds[];
    Ctx c;
    c.x = (const float*)a.in[0]; c.pos = (const int*)a.in[1]; c.a_norm = (const float*)a.in[2]; c.a_w_in = (const float*)a.in[3]; c.pe_k = (const float*)a.in[4]; c.pe_v = (const float*)a.in[5];
    c.w_ck1 = (const float*)a.in[6]; c.w_ck2 = (const float*)a.in[7]; c.w_cv1 = (const float*)a.in[8]; c.w_cv2 = (const float*)a.in[9]; c.conv_w = (const float*)a.in[10]; c.a_w_out = (const float*)a.in[11];
    c.c_norm = (const float*)a.in[12]; c.c_w_in = (const float*)a.in[13]; c.q_norm = (const float*)a.in[14]; c.kv_norm = (const float*)a.in[15]; c.w_uq = (const float*)a.in[16]; c.w_ukv = (const float*)a.in[17];
    c.c_w_out = (const float*)a.in[18]; c.final_norm = (const float*)a.in[19];
    c.out = a.out; c.ws = a.ws;
    c.CS = (float2*)(a.ws + WS_CS); c.KCMP = (bf16_t*)(a.ws + WS_KCMP); c.VCMP = (bf16_t*)(a.ws + WS_VCMP); c.XN = (bf16_t*)(a.ws + WS_XN); c.PA = (bf16_t*)(a.ws + WS_PA);
    c.MIX = (bf16_t*)(a.ws + WS_MIX); c.PC = (bf16_t*)(a.ws + WS_PC); c.Q1 = (bf16_t*)(a.ws + WS_Q1); c.KV1 = (bf16_t*)(a.ws + WS_KV1); c.CQN = (bf16_t*)(a.ws + WS_CQN);
    c.CKVN = (bf16_t*)(a.ws + WS_CKVN); c.KPE = (bf16_t*)(a.ws + WS_KPE); c.O1 = (bf16_t*)(a.ws + WS_O1);

    volatile LAS unsigned* misc = (volatile LAS unsigned*)((LAS unsigned char*)lds + (LDS_BYTES - 64));
    if (threadIdx.x < 16) misc[threadIdx.x] = 0u;
    __syncthreads();
    XcdBarrier bar; bar.bar = (unsigned*)(a.ws + WS_CTL) + 4096; bar.x = 0; bar.st = misc;
    const bool multi = (a.hi - a.lo) > 1;
    if (multi) bar = xcd_barrier_post((unsigned*)(a.ws + WS_CTL) + 4096, misc);

#define PHASE(k, ...) if (a.lo <= (k) && (k) < a.hi) { __VA_ARGS__; if ((k) + 1 < a.hi) xcd_barrier(bar); }
    LAS unsigned char* ldsl = (LAS unsigned char*)lds;
    PHASE(0, { ph0_weights(c, lds); ph0_prologue(c); })
    PHASE(1, { pg8::Gemm g{c.XN, (const bf16_t*)(c.ws + WS_WTA), M, 4096, 1024}; pg8::StaticOrder S; S.init(M, 4096, gridDim.x, blockIdx.x);
               pg8::EpiPA E{c.PA, c.CS}; pg8::gemm_phase<pg8::EpiPA, pg8::StaticOrder, true, true>(ldsl, g, S, E); })
    PHASE(3, ph3_compress(c, lds))
    PHASE(4, ph4_nsa(c, lds))
    PHASE(5, ph5_conv(c))
    PHASE(6, { pg8::Gemm g{c.MIX, (const bf16_t*)(c.ws + WS_WTOA), M, 1024, 1024}; pg8::StaticOrder S; S.init(M, 1024, gridDim.x, blockIdx.x);
               pg8::EpiRes E{c.x, c.out}; pg8::gemm_phase<pg8::EpiRes, pg8::StaticOrder, true, true>(ldsl, g, S, E); })
    PHASE(7, ph7_norm1(c))
    PHASE(8, { pg8::Gemm g{c.XN, (const bf16_t*)(c.ws + WS_WTC), M, 1792, 1024}; pg8::StaticOrder S; S.init(M, 1792, gridDim.x, blockIdx.x);
               pg8::EpiPlain E{c.PC, PC_LD}; pg8::gemm_phase<pg8::EpiPlain, pg8::StaticOrder, true, true>(ldsl, g, S, E); })
    PHASE(9, ph9_lat_norm(c))
    PHASE(10, { for (int gi = 0; gi < 2; ++gi) {
                pg8::Gemm g{gi ? c.CKVN : c.CQN, (const bf16_t*)(c.ws + (gi ? WS_WTUKV : WS_WTUQ)), M, gi ? 2048 : 1536, 256}; pg8::StaticOrder S; S.init(M, gi ? 2048 : 1536, gridDim.x, blockIdx.x);
                pg8::EpiPlain E{gi ? c.KV1 : c.Q1, gi ? 2048 : 1536}; pg8::gemm_phase<pg8::EpiPlain, pg8::StaticOrder, true, true>(ldsl, g, S, E); __syncthreads(); } })
    PHASE(11, ph11_rope_q1(c))
    PHASE(12, mla::phase(c, lds))
    PHASE(13, { pg8::Gemm g{c.O1, (const bf16_t*)(c.ws + WS_WTOC), M, 1024, 1024}; pg8::StaticOrder S; S.init(M, 1024, gridDim.x, blockIdx.x);
               pg8::EpiRes E{c.out, c.out}; pg8::gemm_phase<pg8::EpiRes, pg8::StaticOrder, true, true>(ldsl, g, S, E); })
    PHASE(14, ph_final(c))
#undef PHASE
}

extern "C" void kernel_launch(void* const* d_in, const int* in_sizes, int n_in, void* d_out, int out_size, void* d_ws, size_t ws_size, hipStream_t stream) {
    static int grid = 0;
    if (grid == 0) {
        if (n_in != 20 || in_sizes[0] != M * DM || out_size != M * DM || ws_size < WS_END) {
            fprintf(stderr, "kernel_launch: unexpected shapes (n_in %d, in0 %d, out %d, ws %zu)\n", n_in, n_in > 0 ? in_sizes[0] : -1, out_size, ws_size); grid = -1; return; }
        int dev = 0, cus = 0;
        if (hipGetDevice(&dev) != hipSuccess || hipDeviceGetAttribute(&cus, hipDeviceAttributeMultiprocessorCount, dev) != hipSuccess || cus <= 0) { grid = -1; return; }
        if (hipFuncSetAttribute((const void*)mk_fwd, hipFuncAttributeMaxDynamicSharedMemorySize, LDS_BYTES) != hipSuccess) { fprintf(stderr, "kernel_launch: hipFuncSetAttribute failed\n"); grid = -1; return; }
        (void)hipGetLastError();
        grid = cus;
    }
    if (grid < 0) return;
    (void)hipMemsetAsync((char*)d_ws + WS_CTL, 0, CTL_BYTES, stream);
    Args a{};
    for (int i = 0; i < 20; ++i) a.in[i] = d_in[i];
    a.out = (float*)d_out; a.ws = (unsigned char*)d_ws;
#if MK_ONE_LAUNCH
    a.lo = 0; a.hi = NPHASE;
    hipLaunchKernelGGL(mk_fwd, dim3(grid), dim3(NTHR), LDS_BYTES, stream, a);
#else
    for (int ph = 0; ph < NPHASE; ++ph) { a.lo = ph; a.hi = ph + 1; hipLaunchKernelGGL(mk_fwd, dim3(grid), dim3(NTHR), LDS_BYTES, stream, a); }
#endif
}
```

```cpp
#include <hip/hip_runtime.h>
#include <cstdio>
#include <cstdint>
#include <cmath>

#ifndef MK_ONE_LAUNCH
#define MK_ONE_LAUNCH 1
#endif

constexpr int BATCH = 8, SEQ = 4096, DM = 1024, M = BATCH * SEQ;
constexpr int NIN_A = 3864, NIN_C = 1600;
constexpr int PA_LD = 4096;
constexpr int PC_LD = 1792;
constexpr int PA_Q = 0, PA_KC = 512, PA_VC = 640, PA_KS = 768, PA_VS = 896, PA_KW = 1024, PA_VW = 1152,
              PA_GA = 1280, PA_CB = 1792, PA_CC = 2304, PA_CH = 2816, PA_GB = 3328, PA_GL = 3840;
constexpr int PC_CQ = 0, PC_CKV = 256, PC_G = 512, PC_KR = 1536;
constexpr float LOG2E = 1.4426950408889634f;
constexpr float QSCALE_A = 0.125f * LOG2E;
constexpr float QSCALE_C = 0.07216878364870323f * LOG2E;
constexpr float RMS_EPS = 1e-6f;

constexpr size_t MiB = 1u << 20;
constexpr size_t WS_CTL = 0, CTL_BYTES = 1 * MiB;
constexpr size_t WS_CS = 1 * MiB;
constexpr size_t WS_KCMP = 9 * MiB;
constexpr size_t WS_VCMP = 9 * MiB + 512 * 1024;
constexpr size_t WS_WTA = 16 * MiB;
constexpr size_t WS_WTOA = 24 * MiB;
constexpr size_t WS_WTC = 26 * MiB;
constexpr size_t WS_WTUQ = 30 * MiB;
constexpr size_t WS_WTUKV = 31 * MiB;
constexpr size_t WS_WTOC = 32 * MiB;
constexpr size_t WS_XN = 48 * MiB;
constexpr size_t WS_PA = 112 * MiB;
constexpr size_t WS_MIX = 368 * MiB;
constexpr size_t WS_PC = 112 * MiB;
constexpr size_t WS_Q1 = 224 * MiB;
constexpr size_t WS_KV1 = 320 * MiB;
constexpr size_t WS_CQN = 448 * MiB;
constexpr size_t WS_CKVN = 464 * MiB;
constexpr size_t WS_KPE = 480 * MiB;
constexpr size_t WS_O1 = 48 * MiB;
constexpr size_t WS_END = 484 * MiB;

constexpr int LDS_BYTES = 147456;
constexpr int NTHR = 512, NWV = 8;

typedef unsigned short bf16_t;
#define LAS __attribute__((address_space(3)))

__device__ __forceinline__ float bf2f(bf16_t v) { return __uint_as_float(((unsigned)v) << 16); }
__device__ __forceinline__ bf16_t f2bf(float f) { unsigned u = __float_as_uint(f); return (bf16_t)((u + 0x7fffu + ((u >> 16) & 1u)) >> 16); }
__device__ __forceinline__ float wave_sum(float v) {
#pragma unroll
    for (int o = 1; o < 64; o <<= 1) v += __shfl_xor(v, o);
    return v;
}
__device__ __forceinline__ float wave_max(float v) {
#pragma unroll
    for (int o = 1; o < 64; o <<= 1) v = fmaxf(v, __shfl_xor(v, o));
    return v;
}
#define WSYNC() asm volatile("s_waitcnt lgkmcnt(0)" ::: "memory")
__device__ __forceinline__ float siluf(float x) { return x / (1.f + __expf(-x)); }
__device__ __forceinline__ float sigmoidf_(float x) { return 1.f / (1.f + __expf(-x)); }

#define XB_TMO      128
#define XB_XCNT(j)  (256  + 64 * (j))
#define XB_XSUB(j)  (1280 + 64 * (j))
#define XB_XGEN(j)  (2304 + 64 * (j))
#define XB_TOP      3328
#define XB_TOPGEN   3392
#define XCD_BAR_WORDS 3456
#define XB_SPIN_CAP (1u << 24)
__device__ __forceinline__ unsigned xb_ld(unsigned* p)              { return __hip_atomic_load(p, __ATOMIC_RELAXED, __HIP_MEMORY_SCOPE_AGENT); }
__device__ __forceinline__ unsigned xb_add(unsigned* p, unsigned v) { return __hip_atomic_fetch_add(p, v, __ATOMIC_RELAXED, __HIP_MEMORY_SCOPE_AGENT); }
__device__ __forceinline__ unsigned xb_xcc_id() { return (unsigned)__builtin_amdgcn_s_getreg((3 << 11) | 20) & 0xFu; }
#define XB_SPIN(cond, bar) do { unsigned _sp = 0; while (cond) { __builtin_amdgcn_s_sleep(1); \
    if ((++_sp & 255u) == 0u) { if (xb_ld(&(bar)[XB_TMO])) break; if (_sp > XB_SPIN_CAP) { atomicAdd(&(bar)[XB_TMO], 1u); break; } } } } while (0)
struct XcdBarrier { unsigned* bar; unsigned x; volatile LAS unsigned* st; };
__device__ __forceinline__ XcdBarrier xcd_barrier_post(unsigned* bar, volatile LAS unsigned* st) {
    XcdBarrier b; b.bar = bar; b.x = xb_xcc_id(); b.st = st;
    if (threadIdx.x == 0) (void)xb_add(&bar[XB_XCNT(b.x)], 1u);
    return b;
}
__device__ __forceinline__ void xcd_barrier_complete(unsigned* bar, unsigned x, unsigned& nloc, unsigned& nx) {
    const unsigned G = gridDim.x * gridDim.y * gridDim.z;
    unsigned sum, cnt, mine, sp = 0u;
    for (;;) {
        sum = 0u; cnt = 0u; mine = 0u;
#pragma unroll
        for (unsigned j = 0; j < 16; ++j) { const unsigned c = xb_ld(&bar[XB_XCNT(j)]); sum += c; cnt += (c > 0u) ? 1u : 0u; mine = (j == x) ? c : mine; }
        if (sum == G) break;
        __builtin_amdgcn_s_sleep(1);
        if ((++sp & 255u) == 0u) { if (xb_ld(&bar[XB_TMO])) break; if (sp > XB_SPIN_CAP) { atomicAdd(&bar[XB_TMO], 1u); break; } }
    }
    nloc = mine > 0u ? mine : 1u; nx = cnt > 0u ? cnt : 1u;
}
__device__ __forceinline__ void xcd_barrier(const XcdBarrier& b) {
    asm volatile("s_waitcnt vmcnt(0)" ::: "memory");
    __syncthreads();
    if (threadIdx.x == 0) {
        unsigned* bar = b.bar;
        __builtin_amdgcn_s_waitcnt(0);
        unsigned nloc = b.st[0], nx = b.st[1];
        if (nloc == 0u) { xcd_barrier_complete(bar, b.x, nloc, nx); b.st[0] = nloc; b.st[1] = nx; }
        const unsigned old = xb_add(&bar[XB_XSUB(b.x)], 1u);
        const unsigned gen = old / nloc;
        if (old + 1u == (gen + 1u) * nloc) {
            __builtin_amdgcn_fence(__ATOMIC_RELEASE, "agent");
            asm volatile("s_waitcnt vmcnt(0)" ::: "memory");
            const unsigned og = xb_add(&bar[XB_TOP], 1u);
            const unsigned tg = og / nx;
            if (og + 1u == (tg + 1u) * nx) xb_add(&bar[XB_TOPGEN], 1u);
            else XB_SPIN(xb_ld(&bar[XB_TOPGEN]) == tg, bar);
            __builtin_amdgcn_fence(__ATOMIC_ACQUIRE, "agent");
            xb_add(&bar[XB_XGEN(b.x)], 1u);
            asm volatile("s_waitcnt vmcnt(0)" ::: "memory");
        } else {
            XB_SPIN(xb_ld(&bar[XB_XGEN(b.x)]) == gen, bar);
            __builtin_amdgcn_fence(__ATOMIC_ACQUIRE, "agent");
            asm volatile("s_waitcnt vmcnt(0)" ::: "memory");
        }
    }
    __syncthreads();
}

struct Args { const void* in[20]; float* out; unsigned char* ws; int lo, hi; };
struct Ctx {
    const float* x; const int* pos; const float* a_norm; const float* a_w_in; const float* pe_k; const float* pe_v;
    const float* w_ck1; const float* w_ck2; const float* w_cv1; const float* w_cv2; const float* conv_w; const float* a_w_out;
    const float* c_norm; const float* c_w_in; const float* q_norm; const float* kv_norm; const float* w_uq; const float* w_ukv; const float* c_w_out; const float* final_norm;
    float* out; unsigned char* ws;
    float2* CS; bf16_t* KCMP; bf16_t* VCMP; bf16_t* XN; bf16_t* PA; bf16_t* MIX; bf16_t* PC; bf16_t* Q1; bf16_t* KV1; bf16_t* CQN; bf16_t* CKVN; bf16_t* KPE; bf16_t* O1;
};

__device__ __forceinline__ void sincos_acc(float angf, float& s, float& c) {
    const double x = (double)angf;
    const double k = rint(x * 0.6366197723675814);
    double r = fma(-k, 1.5707963267948966, x);
    r = fma(-k, 6.123233995736766e-17, r);
    const double r2 = r * r;
    double sp = -1.0 / 1307674368000.0;
    sp = fma(sp, r2, 1.0 / 6227020800.0);
    sp = fma(sp, r2, -1.0 / 39916800.0);
    sp = fma(sp, r2, 1.0 / 362880.0);
    sp = fma(sp, r2, -1.0 / 5040.0);
    sp = fma(sp, r2, 1.0 / 120.0);
    sp = fma(sp, r2, -1.0 / 6.0);
    const double sn = fma(sp * r2, r, r);
    double cp = 1.0 / 20922789888000.0;
    cp = fma(cp, r2, -1.0 / 87178291200.0);
    cp = fma(cp, r2, 1.0 / 479001600.0);
    cp = fma(cp, r2, -1.0 / 3628800.0);
    cp = fma(cp, r2, 1.0 / 40320.0);
    cp = fma(cp, r2, -1.0 / 720.0);
    cp = fma(cp, r2, 1.0 / 24.0);
    cp = fma(cp, r2, -0.5);
    const double cs = fma(cp, r2, 1.0);
    const int q = ((int)(long long)k) & 3;
    const double ss = (q == 0) ? sn : (q == 1) ? cs : (q == 2) ? -sn : -cs;
    const double cc = (q == 0) ? cs : (q == 1) ? -sn : (q == 2) ? -cs : sn;
    s = (float)ss; c = (float)cc;
}

__device__ __forceinline__ void rms_row_f32(const float* xr, const float* g, bf16_t* orow, int lane) {
    float4 v[4]; float s = 0.f;
#pragma unroll
    for (int j = 0; j < 4; ++j) { v[j] = *(const float4*)(xr + 4 * lane + 256 * j); s += (v[j].x * v[j].x + v[j].y * v[j].y) + (v[j].z * v[j].z + v[j].w * v[j].w); }
    const float rstd = 1.f / sqrtf(wave_sum(s) * (1.f / DM) + RMS_EPS);
#pragma unroll
    for (int j = 0; j < 4; ++j) {
        const float4 gg = *(const float4*)(g + 4 * lane + 256 * j);
        ushort4 o; o.x = f2bf(v[j].x * rstd * gg.x); o.y = f2bf(v[j].y * rstd * gg.y); o.z = f2bf(v[j].z * rstd * gg.z); o.w = f2bf(v[j].w * rstd * gg.w);
        *(ushort4*)(orow + 4 * lane + 256 * j) = o;
    }
}

namespace pg8 {
#define PG8_LAS __attribute__((address_space(3)))
typedef unsigned short bf16_t;
typedef short bf16x8 __attribute__((ext_vector_type(8)));
typedef float f32x4 __attribute__((ext_vector_type(4)));
typedef unsigned u32x4 __attribute__((ext_vector_type(4)));
constexpr int BM = 256, BK = 64, HALF = 128, HTB = HALF * BK * 2  , STAGE_BYTES = 8 * HTB, NXCD = 8, WGM = 8;

__host__ __device__ __forceinline__ int lds_byte(int r, int c) { const int st = (r >> 4) * 2 + (c >> 5), rr = r & 15, cc = c & 31, ob = rr * 64 + cc * 2; return st * 1024 + (ob ^ (((ob >> 9) & 1) << 5)); }
__host__ __device__ __forceinline__ void stage_rc(int b, int& R, int& C) { const int st = b / 1024, sb = b % 1024, swz = sb ^ (((sb >> 9) & 1) << 5); R = (st >> 1) * 16 + swz / 64; C = (st & 1) * 32 + (swz % 64) / 2; }
__host__ __device__ __forceinline__ int perm32(int rho) { const int n = rho >> 4, i = rho & 15; return 8 * (i >> 2) + 4 * n + (i & 3); }

struct Unit { int pm, pn; };
struct Gemm { const bf16_t* A; const bf16_t* Bt; int M, N, K; };

struct StaticOrder {
    int nM, nN, nwg, G, c;
    __host__ __device__ void init(int M, int N, int G_, int c_) { nM = M / BM; nN = N / BM; nwg = nM * nN; G = G_; c = c_; }
    __host__ __device__ bool next(int i, Unit& u) const {
        const long L = (long)i * G + c; if (L >= nwg) return false;
        int wgid = (int)L; { const int q = nwg / NXCD, r = nwg % NXCD, xcd = wgid % NXCD, off = wgid / NXCD; wgid = (xcd < r ? xcd * (q + 1) : r * (q + 1) + (xcd - r) * q) + off; }
        const int nig = WGM * nN, gid = wgid / nig, fm = gid * WGM, gsz = (nM - fm) < WGM ? (nM - fm) : WGM;
        u.pm = fm + ((wgid % nig) % gsz); u.pn = (wgid % nig) / gsz; return true;
    }
    __device__ __forceinline__ void a_ready(const Unit&) const {}
    __device__ __forceinline__ void done(const Unit&) const {}
};

__device__ __forceinline__ unsigned cvt_pk_bf16(float lo, float hi) { unsigned r; asm volatile("v_cvt_pk_bf16_f32 %0, %1, %2" : "=v"(r) : "v"(lo), "v"(hi)); return r; }

struct EpiPA {
    static constexpr bool PERM = true, AFTER_DRAIN = false;
    bf16_t* PA; const float2* CS;
    __device__ __forceinline__ void operator()(const f32x4 (&acc)[2][2][4][2], const Unit& u, int wr, int wc, int fr, int fq) const {
        const int row0 = u.pm * BM + wr * 64 + fr;
        if (u.pn < 3) {
            const int base = (u.pn == 0) ? 64 * wc : (u.pn == 1) ? 256 + 64 * wc : (wc < 2 ? 768 + 64 * wc : 1024 + 64 * (wc - 2));
            const float sc = u.pn < 2 ? QSCALE_A : 1.f;
#pragma unroll
            for (int ai = 0; ai < 2; ++ai)
#pragma unroll
                for (int m = 0; m < 4; ++m) {
                    const int row = row0 + ai * HALF + m * 16;
                    const f32x4* csp = (const f32x4*)(CS + (size_t)row * 32 + 8 * fq);
                    const f32x4 t0 = csp[0], t1 = csp[1], t2 = csp[2], t3 = csp[3];
                    const f32x4 a0 = acc[ai][0][m][0], a1 = acc[ai][0][m][1], b0 = acc[ai][1][m][0], b1 = acc[ai][1][m][1];
                    u32x4 w1, w2;
                    w1.x = cvt_pk_bf16((a0[0] * t0[0] - b0[0] * t0[1]) * sc, (a0[1] * t0[2] - b0[1] * t0[3]) * sc);
                    w1.y = cvt_pk_bf16((a0[2] * t1[0] - b0[2] * t1[1]) * sc, (a0[3] * t1[2] - b0[3] * t1[3]) * sc);
                    w1.z = cvt_pk_bf16((a1[0] * t2[0] - b1[0] * t2[1]) * sc, (a1[1] * t2[2] - b1[1] * t2[3]) * sc);
                    w1.w = cvt_pk_bf16((a1[2] * t3[0] - b1[2] * t3[1]) * sc, (a1[3] * t3[2] - b1[3] * t3[3]) * sc);
                    w2.x = cvt_pk_bf16((b0[0] * t0[0] + a0[0] * t0[1]) * sc, (b0[1] * t0[2] + a0[1] * t0[3]) * sc);
                    w2.y = cvt_pk_bf16((b0[2] * t1[0] + a0[2] * t1[1]) * sc, (b0[3] * t1[2] + a0[3] * t1[3]) * sc);
                    w2.z = cvt_pk_bf16((b1[0] * t2[0] + a1[0] * t2[1]) * sc, (b1[1] * t2[2] + a1[1] * t2[3]) * sc);
                    w2.w = cvt_pk_bf16((b1[2] * t3[0] + a1[2] * t3[1]) * sc, (b1[3] * t3[2] + a1[3] * t3[3]) * sc);
                    bf16_t* rp = PA + (size_t)row * PA_LD + base + 8 * fq;
                    *(u32x4*)rp = w1; *(u32x4*)(rp + 32) = w2;
                }
        } else {
            const int cb0 = (u.pn == 3) ? 512 : (u.pn == 4) ? 896 : 256 * u.pn;
            const int cb1 = (u.pn == 3) ? 640 : (u.pn == 4) ? 1152 : 256 * u.pn + 128;
#pragma unroll
            for (int ai = 0; ai < 2; ++ai)
#pragma unroll
                for (int m = 0; m < 4; ++m) {
                    bf16_t* rp = PA + (size_t)(row0 + ai * HALF + m * 16) * PA_LD + 32 * wc + 8 * fq;
#pragma unroll
                    for (int bj = 0; bj < 2; ++bj) { const f32x4 v0 = acc[ai][bj][m][0], v1 = acc[ai][bj][m][1];
                        u32x4 w; w.x = cvt_pk_bf16(v0[0], v0[1]); w.y = cvt_pk_bf16(v0[2], v0[3]); w.z = cvt_pk_bf16(v1[0], v1[1]); w.w = cvt_pk_bf16(v1[2], v1[3]);
                        *(u32x4*)(rp + (bj ? cb1 : cb0)) = w; }
                }
        }
    }
};
struct EpiPlain {
    static constexpr bool PERM = true, AFTER_DRAIN = false;
    bf16_t* O; int ldc;
    __device__ __forceinline__ void operator()(const f32x4 (&acc)[2][2][4][2], const Unit& u, int wr, int wc, int fr, int fq) const {
        const int row0 = u.pm * BM + wr * 64 + fr; const int col0 = u.pn * BM + wc * 32 + 8 * fq;
#pragma unroll
        for (int ai = 0; ai < 2; ++ai)
#pragma unroll
            for (int m = 0; m < 4; ++m) { bf16_t* rp = O + (size_t)(row0 + ai * HALF + m * 16) * ldc + col0;
#pragma unroll
                for (int bj = 0; bj < 2; ++bj) { const f32x4 v0 = acc[ai][bj][m][0], v1 = acc[ai][bj][m][1];
                    u32x4 w; w.x = cvt_pk_bf16(v0[0], v0[1]); w.y = cvt_pk_bf16(v0[2], v0[3]); w.z = cvt_pk_bf16(v1[0], v1[1]); w.w = cvt_pk_bf16(v1[2], v1[3]);
                    *(u32x4*)(rp + bj * HALF) = w; } }
    }
};
struct EpiRes {
    static constexpr bool PERM = false, AFTER_DRAIN = false;
    const float* base; float* out;
    __device__ __forceinline__ void operator()(const f32x4 (&acc)[2][2][4][2], const Unit& u, int wr, int wc, int fr, int fq) const {
        const int row0 = u.pm * BM + wr * 64 + fr; const int col0 = u.pn * BM + wc * 32 + 4 * fq;
#pragma unroll
        for (int ai = 0; ai < 2; ++ai)
#pragma unroll
            for (int m = 0; m < 4; ++m) { const size_t off = (size_t)(row0 + ai * HALF + m * 16) * 1024 + col0;
#pragma unroll
                for (int bj = 0; bj < 2; ++bj)
#pragma unroll
                    for (int n = 0; n < 2; ++n) { const f32x4 b = *(const f32x4*)(base + off + bj * HALF + n * 16); *(f32x4*)(out + off + bj * HALF + n * 16) = b + acc[ai][bj][m][n]; } }
    }
};
template <class Epi, class Sched, bool ALIGN_EPI = false, bool SP2 = false>
__device__ __forceinline__ void gemm_phase(PG8_LAS unsigned char* lds, const Gemm g, const Sched& S, const Epi& E) {
    const int tid = threadIdx.x, wid = __builtin_amdgcn_readfirstlane(tid >> 6), lane = tid & 63, wr = wid >> 2, wc = wid & 3, fr = lane & 15, fq = lane >> 4;
    const int K = g.K, nt = K / BK;
    unsigned voffA[2], voffB[2];
#pragma unroll
    for (int i = 0; i < 2; ++i) { int R, C; stage_rc(tid * 16 + i * 8192, R, C); const int Rb = Epi::PERM ? ((R & ~31) + perm32(R & 31)) : R;
        voffA[i] = (unsigned)(R * K + C) * 2u; voffB[i] = (unsigned)(Rb * K + C) * 2u; }
    const size_t kstep = (size_t)(BK * 2);
    const size_t hstep = (size_t)HALF * K * 2;
    const size_t tstep = 2 * hstep;
    const unsigned ldsw = (unsigned)wid * 1024u;
    const int aoff = lds_byte(wr * 64 + fr, fq * 8), boff = lds_byte(wc * 32 + fr, fq * 8);
#define PG8_SA(b, h) (((b) * 2 + (h)) * HTB)
#define PG8_SB(b, h) ((4 + (b) * 2 + (h)) * HTB)
#define PG8_STAGE(bufoff, gbase, voff) do { _Pragma("unroll") for (int _i = 0; _i < 2; ++_i) \
        __builtin_amdgcn_global_load_lds((const unsigned*)((const char*)(gbase) + (voff)[_i]), (PG8_LAS unsigned*)(lds + (bufoff) + ldsw + _i * 8192), 16, 0, 0); } while (0)
#define PG8_LDA(dst, b, h) do { _Pragma("unroll") for (int m = 0; m < 4; ++m) _Pragma("unroll") for (int k = 0; k < 2; ++k) dst[m][k] = *(const PG8_LAS bf16x8*)(lds + PG8_SA(b, h) + aoff + m * 2048 + k * 1024); } while (0)
#define PG8_LDB(dst, b, h) do { _Pragma("unroll") for (int n = 0; n < 2; ++n) _Pragma("unroll") for (int k = 0; k < 2; ++k) dst[n][k] = *(const PG8_LAS bf16x8*)(lds + PG8_SB(b, h) + boff + n * 2048 + k * 1024); } while (0)
#define PG8_MMA(ai, bj, At, Bt) do { __builtin_amdgcn_s_setprio(1); _Pragma("unroll") for (int m = 0; m < 4; ++m) _Pragma("unroll") for (int n = 0; n < 2; ++n) _Pragma("unroll") for (int k = 0; k < 2; ++k) \
        acc[ai][bj][m][n] = __builtin_amdgcn_mfma_f32_16x16x32_bf16(Bt[n][k], At[m][k], acc[ai][bj][m][n], 0, 0, 0); __builtin_amdgcn_s_setprio(0); } while (0)
#define PG8_WAIT_V(n) asm volatile("s_waitcnt vmcnt(" #n ")" ::: "memory")
#define PG8_WAIT_L(n) asm volatile("s_waitcnt lgkmcnt(" #n ")" ::: "memory")
#define PG8_BAR __builtin_amdgcn_s_barrier()
#define PG8_SCHED __builtin_amdgcn_sched_barrier(0)
    Unit cur, nxt; int ui = 0;
    if (!S.next(0, cur)) return;
    f32x4 acc[2][2][4][2];
#pragma unroll
    for (int a = 0; a < 2; ++a)
#pragma unroll
        for (int b = 0; b < 2; ++b)
#pragma unroll
            for (int m = 0; m < 4; ++m)
#pragma unroll
                for (int n = 0; n < 2; ++n) acc[a][b][m][n] = (f32x4){0.f, 0.f, 0.f, 0.f};
    bf16x8 At[4][2], B0[2][2], B1[2][2];
    const char* cA = (const char*)g.A + (size_t)cur.pm * tstep; const char* cB = (const char*)g.Bt + (size_t)cur.pn * tstep;
    S.a_ready(cur);
    if constexpr (SP2) {
        PG8_STAGE(PG8_SB(0, 0), cB, voffB); PG8_STAGE(PG8_SB(0, 1), cB + hstep, voffB); PG8_STAGE(PG8_SA(0, 0), cA, voffA); PG8_STAGE(PG8_SA(0, 1), cA + hstep, voffA);
        if (wr == 1) PG8_BAR;
        PG8_WAIT_V(2); PG8_BAR;
        PG8_STAGE(PG8_SB(1, 0), cB + kstep, voffB); PG8_STAGE(PG8_SA(1, 0), cA + kstep, voffA); PG8_STAGE(PG8_SB(1, 1), cB + hstep + kstep, voffB);
        PG8_WAIT_V(6); PG8_BAR;
    } else {
        PG8_STAGE(PG8_SB(0, 0), cB, voffB); PG8_STAGE(PG8_SA(0, 0), cA, voffA); PG8_STAGE(PG8_SB(0, 1), cB + hstep, voffB); PG8_STAGE(PG8_SA(0, 1), cA + hstep, voffA);
        if (wr == 1) PG8_BAR;
        PG8_WAIT_V(4); PG8_BAR;
        PG8_STAGE(PG8_SB(1, 0), cB + kstep, voffB); PG8_STAGE(PG8_SA(1, 0), cA + kstep, voffA); PG8_STAGE(PG8_SB(1, 1), cB + hstep + kstep, voffB);
        PG8_WAIT_V(6); PG8_BAR;
    }
    for (;;) {
        const bool has_next = S.next(ui + 1, nxt);
        const char* nA = has_next ? (const char*)g.A + (size_t)nxt.pm * tstep : cA; const char* nB = has_next ? (const char*)g.Bt + (size_t)nxt.pn * tstep : cB;
        for (int t = 0; t < nt; t += 2) {
            const bool last = (t == nt - 2);
            const char* a1 = cA + (size_t)(t + 1) * kstep;
            const char* a2 = last ? nA : cA + (size_t)(t + 2) * kstep; const char* b2 = last ? nB : cB + (size_t)(t + 2) * kstep;
            const char* a3 = a2 + kstep; const char* b3 = b2 + kstep;
            if (last && has_next) S.a_ready(nxt);
            if constexpr (SP2) {
            PG8_LDB(B0, 0, 0); PG8_LDB(B1, 0, 1); PG8_SCHED; PG8_LDA(At, 0, 0); PG8_STAGE(PG8_SA(1, 1), a1 + hstep, voffA);
            PG8_WAIT_V(8); PG8_WAIT_L(0); PG8_BAR; PG8_MMA(0, 0, At, B0); PG8_MMA(0, 1, At, B1); PG8_BAR; PG8_SCHED;
            PG8_LDA(At, 0, 1); PG8_STAGE(PG8_SB(0, 0), b2, voffB); PG8_STAGE(PG8_SB(0, 1), b2 + hstep, voffB); PG8_STAGE(PG8_SA(0, 0), a2, voffA);
            PG8_WAIT_V(8); PG8_WAIT_L(0); PG8_BAR; PG8_MMA(1, 0, At, B0); PG8_MMA(1, 1, At, B1); PG8_BAR; PG8_SCHED;
            PG8_LDB(B0, 1, 0); PG8_LDB(B1, 1, 1); PG8_SCHED; PG8_LDA(At, 1, 0); PG8_STAGE(PG8_SA(0, 1), a2 + hstep, voffA);
            PG8_WAIT_V(8); PG8_WAIT_L(0); PG8_BAR; PG8_MMA(0, 0, At, B0); PG8_MMA(0, 1, At, B1); PG8_BAR; PG8_SCHED;
            PG8_LDA(At, 1, 1); PG8_STAGE(PG8_SB(1, 0), b3, voffB); PG8_STAGE(PG8_SB(1, 1), b3 + hstep, voffB); PG8_STAGE(PG8_SA(1, 0), a3, voffA);
            PG8_WAIT_V(8); PG8_WAIT_L(0); PG8_BAR; PG8_MMA(1, 0, At, B0); PG8_MMA(1, 1, At, B1); PG8_BAR; PG8_SCHED;
            } else {
            PG8_LDB(B0, 0, 0); PG8_SCHED; PG8_LDA(At, 0, 0); PG8_STAGE(PG8_SA(1, 1), a1 + hstep, voffA);
            PG8_WAIT_L(8); PG8_BAR; PG8_WAIT_L(0); PG8_MMA(0, 0, At, B0); PG8_BAR; PG8_SCHED;
            PG8_LDB(B1, 0, 1); PG8_STAGE(PG8_SB(0, 0), b2, voffB);
            PG8_BAR; PG8_WAIT_L(0); PG8_MMA(0, 1, At, B1); PG8_BAR;
            PG8_LDA(At, 0, 1); PG8_STAGE(PG8_SA(0, 0), a2, voffA);
            PG8_BAR; PG8_WAIT_L(0); PG8_MMA(1, 0, At, B0); PG8_BAR; PG8_SCHED;
            PG8_STAGE(PG8_SB(0, 1), b2 + hstep, voffB);
            PG8_WAIT_V(6); PG8_BAR; PG8_MMA(1, 1, At, B1); PG8_BAR;
            PG8_LDB(B0, 1, 0); PG8_SCHED; PG8_LDA(At, 1, 0); PG8_STAGE(PG8_SA(0, 1), a2 + hstep, voffA);
            PG8_WAIT_L(8); PG8_BAR; PG8_WAIT_L(0); PG8_MMA(0, 0, At, B0); PG8_BAR; PG8_SCHED;
            PG8_LDB(B1, 1, 1); PG8_STAGE(PG8_SB(1, 0), b3, voffB);
            PG8_BAR; PG8_WAIT_L(0); PG8_MMA(0, 1, At, B1); PG8_BAR;
            PG8_LDA(At, 1, 1); PG8_STAGE(PG8_SA(1, 0), a3, voffA);
            PG8_BAR; PG8_WAIT_L(0); PG8_MMA(1, 0, At, B0); PG8_BAR; PG8_SCHED;
            PG8_STAGE(PG8_SB(1, 1), b3 + hstep, voffB);
            PG8_WAIT_V(6); PG8_BAR; PG8_MMA(1, 1, At, B1); PG8_BAR;
            }
        }
        if constexpr (ALIGN_EPI) { if (wr == 0) PG8_BAR; }
        if constexpr (!Epi::AFTER_DRAIN) { E(acc, cur, wr, wc, fr, fq); S.done(cur); }
        if (!has_next) break;
#pragma unroll
        for (int a = 0; a < 2; ++a)
#pragma unroll
            for (int b = 0; b < 2; ++b)
#pragma unroll
                for (int m = 0; m < 4; ++m)
#pragma unroll
                    for (int n = 0; n < 2; ++n) acc[a][b][m][n] = (f32x4){0.f, 0.f, 0.f, 0.f};
        cur = nxt; cA = nA; cB = nB; ++ui;
        if constexpr (ALIGN_EPI) { if (wr == 1) PG8_BAR; }
    }
    PG8_WAIT_V(0);
    if constexpr (!ALIGN_EPI) { if (wr == 0) PG8_BAR; }
    PG8_BAR;
    if constexpr (Epi::AFTER_DRAIN) { E.fused(acc, cur, wr, wc, fr, fq, lds, wid, lane); S.done(cur); }
#undef PG8_SA
#undef PG8_SB
#undef PG8_STAGE
#undef PG8_LDA
#undef PG8_LDB
#undef PG8_MMA
#undef PG8_WAIT_V
#undef PG8_WAIT_L
#undef PG8_BAR
#undef PG8_SCHED
}
}

template <class Epi>
__device__ __forceinline__ void gemm_naive(const bf16_t* A, int lda, const float* W, int K, int N, unsigned char* lds, Epi epi) {
    float (*As)[132] = (float (*)[132])lds;
    float (*Bs)[128] = (float (*)[128])(lds + 16 * 132 * 4);
    const int tid = threadIdx.x, tx = tid & 31, ty = tid >> 5;
    const int ntm = M / 128, ntn = (N + 127) / 128;
    for (int tile = blockIdx.x; tile < ntm * ntn; tile += gridDim.x) {
        const int tm = tile / ntn, tn = tile % ntn;
        float acc[8][4];
#pragma unroll
        for (int i = 0; i < 8; ++i)
#pragma unroll
            for (int j = 0; j < 4; ++j) acc[i][j] = 0.f;
        for (int k0 = 0; k0 < K; k0 += 16) {
            {   const int r = tid >> 2, kq = (tid & 3) * 4;
                const ushort4 v = *(const ushort4*)(A + (size_t)(tm * 128 + r) * lda + k0 + kq);
                As[kq + 0][r] = bf2f(v.x); As[kq + 1][r] = bf2f(v.y); As[kq + 2][r] = bf2f(v.z); As[kq + 3][r] = bf2f(v.w); }
            {   const int kk = tid >> 5, n4 = (tid & 31) * 4; const int n = tn * 128 + n4;
                const float* wp = W + (size_t)(k0 + kk) * N + n;
                float4 v;
                v.x = (n + 0 < N) ? wp[0] : 0.f; v.y = (n + 1 < N) ? wp[1] : 0.f; v.z = (n + 2 < N) ? wp[2] : 0.f; v.w = (n + 3 < N) ? wp[3] : 0.f;
                *(float4*)&Bs[kk][n4] = v; }
            __syncthreads();
#pragma unroll 2
            for (int kk = 0; kk < 16; ++kk) {
                const float4 a0 = *(const float4*)&As[kk][ty * 8], a1 = *(const float4*)&As[kk][ty * 8 + 4];
                const float4 b = *(const float4*)&Bs[kk][tx * 4];
                const float a[8] = {a0.x, a0.y, a0.z, a0.w, a1.x, a1.y, a1.z, a1.w};
                const float bb[4] = {b.x, b.y, b.z, b.w};
#pragma unroll
                for (int i = 0; i < 8; ++i)
#pragma unroll
                    for (int j = 0; j < 4; ++j) acc[i][j] = fmaf(a[i], bb[j], acc[i][j]);
            }
            __syncthreads();
        }
#pragma unroll
        for (int i = 0; i < 8; ++i)
#pragma unroll
            for (int j = 0; j < 4; ++j) { const int m = tm * 128 + ty * 8 + i, n = tn * 128 + tx * 4 + j; if (n < N) epi(m, n, acc[i][j]); }
    }
}

namespace fa {
typedef short bf16x8 __attribute__((ext_vector_type(8)));
typedef short s16x4 __attribute__((ext_vector_type(4)));
typedef float f32x16 __attribute__((ext_vector_type(16)));
typedef unsigned u32x4 __attribute__((ext_vector_type(4)));
#define FA_SBAR() __builtin_amdgcn_sched_barrier(0)
__device__ __forceinline__ int crow(int r, int hi) { return (r & 3) + 8 * (r >> 2) + 4 * hi; }
__device__ __forceinline__ unsigned cvtpk(float lo, float hi) { unsigned r; asm volatile("v_cvt_pk_bf16_f32 %0, %1, %2" : "=v"(r) : "v"(lo), "v"(hi)); return r; }
template <int NCB> __device__ __forceinline__ int v_st(int k, int c) { const int kk = (k & ~0xC) | ((k & 4) << 1) | ((k & 8) >> 1); return ((kk >> 3) * NCB + (c >> 5)) * 512 + ((kk & 7) * 32 + (c & 31)) * 2; }
__device__ __forceinline__ int v_rd_base(int lane) { return ((lane & 3) << 3) | (((lane >> 2) & 3) << 6) | (((lane >> 4) & 1) << 5) | (((lane >> 5) & 1) << 8); }
__device__ __forceinline__ void mask_tile(f32x16& p0, f32x16& p1, int dq, unsigned W) {
    const float NEG = -__builtin_inff();
#pragma unroll
    for (int r = 0; r < 16; ++r) { const int cc = (r & 3) + 8 * (r >> 2);
        if ((unsigned)(dq - cc) >= W) p0[r] = NEG;
        if ((unsigned)(dq - cc - 32) >= W) p1[r] = NEG; }
}
__device__ __forceinline__ void softmax_tile(f32x16& p0, f32x16& p1, float& m_reg, float& l_reg, float& alpha, bf16x8& pa0, bf16x8& pa1, bf16x8& pa2, bf16x8& pa3) {
    float pmax = p0[0];
#pragma unroll
    for (int r = 1; r < 16; ++r) pmax = fmaxf(pmax, p0[r]);
#pragma unroll
    for (int r = 0; r < 16; ++r) pmax = fmaxf(pmax, p1[r]);
    { auto rr = __builtin_amdgcn_permlane32_swap(__float_as_uint(pmax), __float_as_uint(pmax), false, false); pmax = fmaxf(__uint_as_float(rr[0]), __uint_as_float(rr[1])); }
    const float mn = fmaxf(m_reg, pmax);
    alpha = __builtin_amdgcn_exp2f(m_reg - mn); m_reg = mn;
#pragma unroll
    for (int r = 0; r < 16; ++r) { p0[r] = __builtin_amdgcn_exp2f(p0[r] - mn); p1[r] = __builtin_amdgcn_exp2f(p1[r] - mn); }
    float ps = 0.f;
#pragma unroll
    for (int r = 0; r < 16; ++r) ps += p0[r];
#pragma unroll
    for (int r = 0; r < 16; ++r) ps += p1[r];
    { auto rr = __builtin_amdgcn_permlane32_swap(__float_as_uint(ps), __float_as_uint(ps), false, false); ps = __uint_as_float(rr[0]) + __uint_as_float(rr[1]); }
    l_reg = l_reg * alpha + ps;
#define FA_PK4(P, B_, OUT) do { unsigned a0 = cvtpk(P[B_+0], P[B_+1]), a1 = cvtpk(P[B_+2], P[B_+3]); unsigned b0 = cvtpk(P[B_+4], P[B_+5]), b1 = cvtpk(P[B_+6], P[B_+7]); \
        auto r0 = __builtin_amdgcn_permlane32_swap(a0, b0, false, false); auto r1 = __builtin_amdgcn_permlane32_swap(a1, b1, false, false); \
        u32x4 w = {r0[0], r1[0], r0[1], r1[1]}; OUT = __builtin_bit_cast(bf16x8, w); } while (0)
    FA_PK4(p0, 0, pa0); FA_PK4(p0, 8, pa1); FA_PK4(p1, 0, pa2); FA_PK4(p1, 8, pa3);
#undef FA_PK4
}
__device__ __forceinline__ void pack_p(const f32x16& p0, const f32x16& p1, bf16x8& pa0, bf16x8& pa1, bf16x8& pa2, bf16x8& pa3) {
#define FA_PK4(P, B_, OUT) do { unsigned a0 = cvtpk(P[B_+0], P[B_+1]), a1 = cvtpk(P[B_+2], P[B_+3]); unsigned b0 = cvtpk(P[B_+4], P[B_+5]), b1 = cvtpk(P[B_+6], P[B_+7]); \
        auto r0 = __builtin_amdgcn_permlane32_swap(a0, b0, false, false); auto r1 = __builtin_amdgcn_permlane32_swap(a1, b1, false, false); \
        u32x4 w = {r0[0], r1[0], r0[1], r1[1]}; OUT = __builtin_bit_cast(bf16x8, w); } while (0)
    FA_PK4(p0, 0, pa0); FA_PK4(p0, 8, pa1); FA_PK4(p1, 0, pa2); FA_PK4(p1, 8, pa3);
#undef FA_PK4
}
template <int ND0, int KROW>
__device__ __forceinline__ void qkt(f32x16& p0, f32x16& p1, const LAS unsigned char* kp, const bf16x8* qr) {
    p0 = f32x16{}; p1 = f32x16{};
#pragma unroll
    for (int d0 = 0; d0 < ND0; ++d0) {
        const bf16x8 b0 = *(const LAS bf16x8*)(kp + d0 * 32);
        const bf16x8 b1 = *(const LAS bf16x8*)(kp + 32 * KROW + d0 * 32);
        p0 = __builtin_amdgcn_mfma_f32_32x32x16_bf16(b0, qr[d0], p0, 0, 0, 0);
        p1 = __builtin_amdgcn_mfma_f32_32x32x16_bf16(b1, qr[d0], p1, 0, 0, 0);
    }
}
#define FA_TRRD(dst, off) asm volatile("ds_read_b64_tr_b16 %0, %1 offset:%2" : "=&v"(dst) : "v"(vb), "i"(off) : "memory")
template <int NCB, int D0>
__device__ __forceinline__ void pv_d0(f32x16* o, int vb, bf16x8 pa0, bf16x8 pa1, bf16x8 pa2, bf16x8 pa3) {
    s16x4 l0, l1, l2, l3, h0, h1, h2, h3; constexpr int b_ = D0 * 512, HS = NCB * 512, KS = 2 * NCB * 512;
    FA_TRRD(l0, b_); FA_TRRD(h0, b_ + HS); FA_TRRD(l1, b_ + KS); FA_TRRD(h1, b_ + KS + HS); FA_TRRD(l2, b_ + 2 * KS); FA_TRRD(h2, b_ + 2 * KS + HS); FA_TRRD(l3, b_ + 3 * KS); FA_TRRD(h3, b_ + 3 * KS + HS);
    asm volatile("s_waitcnt lgkmcnt(0)" ::: "memory"); FA_SBAR();
    o[D0] = __builtin_amdgcn_mfma_f32_32x32x16_bf16(pa0, (bf16x8){l0[0], l0[1], l0[2], l0[3], h0[0], h0[1], h0[2], h0[3]}, o[D0], 0, 0, 0);
    o[D0] = __builtin_amdgcn_mfma_f32_32x32x16_bf16(pa1, (bf16x8){l1[0], l1[1], l1[2], l1[3], h1[0], h1[1], h1[2], h1[3]}, o[D0], 0, 0, 0);
    o[D0] = __builtin_amdgcn_mfma_f32_32x32x16_bf16(pa2, (bf16x8){l2[0], l2[1], l2[2], l2[3], h2[0], h2[1], h2[2], h2[3]}, o[D0], 0, 0, 0);
    o[D0] = __builtin_amdgcn_mfma_f32_32x32x16_bf16(pa3, (bf16x8){l3[0], l3[1], l3[2], l3[3], h3[0], h3[1], h3[2], h3[3]}, o[D0], 0, 0, 0);
}
template <int NCB>
__device__ __forceinline__ void rescale_o(f32x16* o, float alpha, LAS float* al, int r32, int hi) {
    if (__any(alpha < 1.f)) {
        if (hi == 0) al[r32] = alpha;
        asm volatile("s_waitcnt lgkmcnt(0)" ::: "memory");
        float f[16]; const LAS float* alh = al + 4 * hi;
#pragma unroll
        for (int r = 0; r < 16; ++r) f[r] = alh[(r & 3) + 8 * (r >> 2)];
#pragma unroll
        for (int d = 0; d < NCB; ++d)
#pragma unroll
            for (int r = 0; r < 16; ++r) o[d][r] *= f[r];
    }
}
}

namespace mla {
constexpr int KROW = 400, KBUF = 64 * KROW, VBUF = 64 * 128 * 2;
constexpr int L_K = 0, L_V = 2 * KBUF, L_AL = L_V + 2 * VBUF, L_END = L_AL + 8 * 64 * 4;
using namespace fa;
__device__ __forceinline__ void unit(const Ctx& c, unsigned char* lds, int b, int h, int qb) {
    const int tid = threadIdx.x, lane = tid & 63, r32 = lane & 31, hi = lane >> 5; const int wid = __builtin_amdgcn_readfirstlane(tid >> 6);
    LAS unsigned char* L = (LAS unsigned char*)lds;
    const size_t rowbase = (size_t)b * SEQ; const int q0 = qb * 256;
    bf16x8 qr[12];
    { const bf16_t* qrow = c.Q1 + (rowbase + q0 + wid * 32 + r32) * 1536 + h * 192 + hi * 8;
#pragma unroll
      for (int d0 = 0; d0 < 12; ++d0) qr[d0] = *(const bf16x8*)(qrow + d0 * 16); }
    const bf16_t* kvb = c.KV1 + rowbase * 2048 + h * 256; const bf16_t* kpb = c.KPE + rowbase * 64;
    const unsigned koff = (unsigned)((tid >> 4) * 2048 + (tid & 15) * 8), kpoff = (unsigned)((tid >> 3) * 64 + (tid & 7) * 8);
    const int kw0 = (tid >> 4) * KROW + (tid & 15) * 16, kpw = (tid >> 3) * KROW + 256 + (tid & 7) * 16;
    const int vw0 = v_st<4>(tid >> 4, (tid & 15) * 8), vw1 = v_st<4>(32 + (tid >> 4), (tid & 15) * 8);
    u32x4 sk0, sk1, skp, sv0, sv1;
#define MLA_LOAD(j) do { const bf16_t* kn_ = kvb + (size_t)(j) * 64 * 2048; sk0 = *(const u32x4*)(kn_ + koff); sk1 = *(const u32x4*)(kn_ + koff + 32 * 2048); sv0 = *(const u32x4*)(kn_ + koff + 128); sv1 = *(const u32x4*)(kn_ + koff + 32 * 2048 + 128); \
        skp = *(const u32x4*)(kpb + (size_t)(j) * 64 * 64 + kpoff); } while (0)
#define MLA_WRITE(B) do { *(LAS u32x4*)(L + L_K + (B) * KBUF + kw0) = sk0; *(LAS u32x4*)(L + L_K + (B) * KBUF + kw0 + 32 * KROW) = sk1; *(LAS u32x4*)(L + L_K + (B) * KBUF + kpw) = skp; \
        *(LAS u32x4*)(L + L_V + (B) * VBUF + vw0) = sv0; *(LAS u32x4*)(L + L_V + (B) * VBUF + vw1) = sv1; } while (0)
    const LAS unsigned char* kp0 = L + L_K + r32 * KROW + hi * 16;
    const int vb0 = (int)(uintptr_t)lds + L_V + v_rd_base(lane);
    LAS float* al = (LAS float*)(L + L_AL) + wid * 64;
    const int NT = 4 * qb + 4;
    const int qm = q0 + wid * 32 + r32 - 4 * hi;
    float m_reg = -1e30f, l_reg = 0.f; f32x16 o[4] = {};
    MLA_LOAD(0); MLA_WRITE(0); __syncthreads();
#define MLA_STEP(t, B) do { \
        if ((t) + 1 < NT) MLA_LOAD((t) + 1); \
        f32x16 p0, p1; qkt<12, KROW>(p0, p1, kp0 + (B) * KBUF, qr); \
        if ((t) >= NT - 4) mask_tile(p0, p1, qm - 64 * (t), 0x7fffffffu); \
        float alpha; bf16x8 pa0, pa1, pa2, pa3; softmax_tile(p0, p1, m_reg, l_reg, alpha, pa0, pa1, pa2, pa3); \
        rescale_o<4>(o, alpha, al, r32, hi); \
        { const int vb = vb0 + (B) * VBUF; pv_d0<4, 0>(o, vb, pa0, pa1, pa2, pa3); pv_d0<4, 1>(o, vb, pa0, pa1, pa2, pa3); pv_d0<4, 2>(o, vb, pa0, pa1, pa2, pa3); pv_d0<4, 3>(o, vb, pa0, pa1, pa2, pa3); } \
        if ((t) + 1 < NT) MLA_WRITE((B) ^ 1); \
        __syncthreads(); } while (0)
    for (int t = 0; t < NT; t += 2) { MLA_STEP(t, 0); MLA_STEP(t + 1, 1); }
#undef MLA_STEP
#undef MLA_LOAD
#undef MLA_WRITE
    if (hi == 0) al[r32] = l_reg;
    asm volatile("s_waitcnt lgkmcnt(0)" ::: "memory");
    const size_t orow0 = rowbase + q0 + wid * 32;
    const LAS float* alh = al + 4 * hi;
    const bf16_t* gp0 = c.PC + (orow0 + 4 * hi) * PC_LD + PC_G + h * 128 + r32; bf16_t* op0 = c.O1 + (orow0 + 4 * hi) * DM + h * 128 + r32;
#pragma unroll
    for (int r = 0; r < 16; ++r) { const int rc = (r & 3) + 8 * (r >> 2); const float rl = 1.f / alh[rc];
        const bf16_t* gp = gp0 + rc * PC_LD; bf16_t* op = op0 + rc * DM;
#pragma unroll
        for (int d0 = 0; d0 < 4; ++d0) { const float v = o[d0][r] * rl * siluf(bf2f(gp[d0 * 32])); const float vn = __shfl_xor(v, 1);
            if ((r32 & 1) == 0) *(unsigned*)(op + d0 * 32) = cvtpk(v, vn); } }
    __syncthreads();
}
__device__ __forceinline__ void phase(const Ctx& c, unsigned char* lds) {
    const int G = gridDim.x, bx = blockIdx.x; const int vcu = (G % 8 == 0) ? (bx % 8) * (G / 8) + bx / 8 : bx;
    for (int item = vcu; item < 256; item += G) {
        const int bh = item >> 2, s_ = item & 3;
#pragma unroll 1
        for (int i = 0; i < 4; ++i) { const int qb = (i == 0) ? s_ : (i == 1) ? 7 - s_ : (i == 2) ? 8 + s_ : 15 - s_; unit(c, lds, bh >> 3, bh & 7, qb); }
    }
}
}

namespace nsa {
using namespace fa;
constexpr int KROW = 144, KBUF = 64 * KROW, VBUF = 64 * 64 * 2;
constexpr int L_K = 0, L_V = 4 * KBUF, L_AL = L_V + 4 * VBUF, L_IMP = L_AL + 8 * 64 * 4, L_SEL = L_IMP + 64 * 64 * 4, L_UNI = L_SEL + 64 * 8, L_END = L_UNI + 64;
#define NSA_QK(st) f32x16 p0, p1; qkt<4, KROW>(p0, p1, kp0 + (st) * KBUF, qr)
#define NSA_SM() float alpha; bf16x8 pa0, pa1, pa2, pa3; softmax_tile(p0, p1, m_reg, l_reg, alpha, pa0, pa1, pa2, pa3)
#define NSA_PV(st) do { rescale_o<2>(o, alpha, al, r32, hi); const int vb = vb0 + (st) * VBUF; pv_d0<2, 0>(o, vb, pa0, pa1, pa2, pa3); pv_d0<2, 1>(o, vb, pa0, pa1, pa2, pa3); } while (0)
#define NSA_LOAD(kptr, vptr) do { sk = *(const u32x4*)(kptr); sv = *(const u32x4*)(vptr); } while (0)
#define NSA_WRITE(st) do { *(LAS u32x4*)(L + L_K + (st) * KBUF + kw) = sk; *(LAS u32x4*)(L + L_V + (st) * VBUF + vw) = sv; } while (0)
#define NSA_FOLD(FIRST, fval) do { if (hi == 0) al[r32] = (fval); asm volatile("s_waitcnt lgkmcnt(0)" ::: "memory"); \
        _Pragma("unroll") for (int r = 0; r < 16; ++r) { const float ff = alh[(r & 3) + 8 * (r >> 2)]; \
            if (FIRST) { ot[0][r] = o[0][r] * ff; ot[1][r] = o[1][r] * ff; } else { ot[0][r] += o[0][r] * ff; ot[1][r] += o[1][r] * ff; } } } while (0)

__device__ __forceinline__ void unit(const Ctx& c, unsigned char* lds, int b, int g, int qt) {
    int tid_ = threadIdx.x; asm volatile("" : "+v"(tid_));
    const int tid = tid_, lane = tid & 63, r32 = lane & 31, hi = lane >> 5; const int wid = __builtin_amdgcn_readfirstlane(tid >> 6);
    LAS unsigned char* L = (LAS unsigned char*)lds;
    const size_t rowbase = (size_t)b * SEQ; const int t0 = qt * 64;
    const int hh = r32 >> 3, qi = 8 * wid + (r32 & 7), head = g * 4 + hh; const int tq = t0 + qi;
    const bf16_t* parow = c.PA + (rowbase + tq) * PA_LD;
    bf16x8 qr[4];
#pragma unroll
    for (int d0 = 0; d0 < 4; ++d0) qr[d0] = *(const bf16x8*)(parow + PA_Q + head * 64 + d0 * 16 + hi * 8);
    const float g_c = sigmoidf_(bf2f(parow[PA_GL + head * 3 + 0])), g_s = sigmoidf_(bf2f(parow[PA_GL + head * 3 + 1])), g_w = sigmoidf_(bf2f(parow[PA_GL + head * 3 + 2]));
    const int skey = tid >> 3, sch = tid & 7;
    const int kw = skey * KROW + sch * 16, vw = v_st<2>(skey, sch * 8);
    const unsigned poff = (unsigned)(skey * PA_LD + sch * 8), coff = (unsigned)(skey * 64 + sch * 8);
    const bf16_t* pab = c.PA + rowbase * PA_LD;
    u32x4 sk, sv;
    const LAS unsigned char* kp0 = L + L_K + r32 * KROW + hi * 16;
    const int vb0 = (int)(uintptr_t)lds + L_V + v_rd_base(lane);
    LAS float* al = (LAS float*)(L + L_AL) + wid * 64; const LAS float* alh = al + 4 * hi;
    LAS float* IMP = (LAS float*)(L + L_IMP); LAS unsigned* SEL = (LAS unsigned*)(L + L_SEL); LAS unsigned* UNI = (LAS unsigned*)(L + L_UNI);
    f32x16 o[2], ot[2];
    float m_reg, l_reg;

    {   const int NTc = (qt >> 4) + 1;
        const bf16_t* kcb = c.KCMP + (size_t)(b * 2 + g) * 256 * 64; const bf16_t* vcb = c.VCMP + (size_t)(b * 2 + g) * 256 * 64;
        const int cl = (tq - 31) >> 4;
#pragma unroll
        for (int jt = 0; jt < 4; ++jt) if (jt < NTc) { NSA_LOAD(kcb + jt * 4096 + coff, vcb + jt * 4096 + coff); NSA_WRITE(jt); }
        __syncthreads();
        float m_c = -1e30f, l_c = 0.f;
#pragma unroll
        for (int jt = 0; jt < 4; ++jt) if (jt < NTc) {
            NSA_QK(jt);
            mask_tile(p0, p1, cl - 64 * jt - 4 * hi, 0x7fffffffu);
            float pmax = p0[0];
#pragma unroll
            for (int r = 1; r < 16; ++r) pmax = fmaxf(pmax, p0[r]);
#pragma unroll
            for (int r = 0; r < 16; ++r) pmax = fmaxf(pmax, p1[r]);
            { auto rr = __builtin_amdgcn_permlane32_swap(__float_as_uint(pmax), __float_as_uint(pmax), false, false); pmax = fmaxf(__uint_as_float(rr[0]), __uint_as_float(rr[1])); }
            const float mn = fmaxf(m_c, pmax);
            float ps = 0.f;
#pragma unroll
            for (int r = 0; r < 16; ++r) ps += __builtin_amdgcn_exp2f(p0[r] - mn) + __builtin_amdgcn_exp2f(p1[r] - mn);
            { auto rr = __builtin_amdgcn_permlane32_swap(__float_as_uint(ps), __float_as_uint(ps), false, false); ps = __uint_as_float(rr[0]) + __uint_as_float(rr[1]); }
            l_c = l_c * __builtin_amdgcn_exp2f(m_c - mn) + ps; m_c = mn;
        }
        const float inv = l_c > 0.f ? 1.f / l_c : 0.f;
        float carry = 0.f;
        o[0] = f32x16{}; o[1] = f32x16{};
#pragma unroll
        for (int jt = 0; jt < 4; ++jt) if (jt < NTc) {
            NSA_QK(jt);
            mask_tile(p0, p1, cl - 64 * jt - 4 * hi, 0x7fffffffu);
#pragma unroll
            for (int r = 0; r < 16; ++r) { p0[r] = __builtin_amdgcn_exp2f(p0[r] - m_c) * inv; p1[r] = __builtin_amdgcn_exp2f(p1[r] - m_c) * inv; }
            float x0[4], x1[4];
#pragma unroll
            for (int j = 0; j < 4; ++j) {
                { const unsigned e = __float_as_uint(p0[4 * j + 3]); auto rr = __builtin_amdgcn_permlane32_swap(e, e, false, false); x0[j] = __uint_as_float(hi ? rr[0] : rr[1]); }
                { const unsigned e = __float_as_uint(p1[4 * j + 3]); auto rr = __builtin_amdgcn_permlane32_swap(e, e, false, false); x1[j] = __uint_as_float(hi ? rr[0] : rr[1]); } }
#pragma unroll
            for (int j = 0; j < 4; ++j) {
                const float g0 = (p0[4 * j] + p0[4 * j + 1]) + (p0[4 * j + 2] + p0[4 * j + 3]);
                const float g1 = (p1[4 * j] + p1[4 * j + 1]) + (p1[4 * j + 2] + p1[4 * j + 3]);
                const float e0 = hi ? x0[j] : (j > 0 ? x0[j > 0 ? j - 1 : 0] : carry);
                const float e1 = hi ? x1[j] : (j > 0 ? x1[j > 0 ? j - 1 : 0] : x0[3]);
                float v0 = g0 + e0, v1 = g1 + e1;
                v0 += __shfl_xor(v0, 8); v0 += __shfl_xor(v0, 16); v1 += __shfl_xor(v1, 8); v1 += __shfl_xor(v1, 16);
                if (r32 < 8) { IMP[qi * 64 + 16 * jt + 2 * j + hi] = v0; IMP[qi * 64 + 16 * jt + 8 + 2 * j + hi] = v1; } }
            carry = x1[3];
            bf16x8 pa0, pa1, pa2, pa3; pack_p(p0, p1, pa0, pa1, pa2, pa3);
            const int vb = vb0 + jt * VBUF; pv_d0<2, 0>(o, vb, pa0, pa1, pa2, pa3); pv_d0<2, 1>(o, vb, pa0, pa1, pa2, pa3);
        }
        NSA_FOLD(true, g_c);
    }
    __syncthreads();
    {   const int q_ = tid >> 3, sub = tid & 7;
        unsigned bits = 0u;
        if (qt < 16) { for (int e = 0; e < 8; ++e) if (sub * 8 + e <= qt) bits |= 1u << e; }
        else {
            float sc[8]; int rank[8];
#pragma unroll
            for (int e = 0; e < 8; ++e) { const int n = sub * 8 + e; const bool forced = (n == 0) || (n == qt) || (n == qt - 1); sc[e] = (n > qt) ? -1.f : (forced ? 1e4f : IMP[q_ * 64 + n]); rank[e] = 0; }
            for (int m2 = 0; m2 <= qt; ++m2) {
                const bool forced = (m2 == 0) || (m2 == qt) || (m2 == qt - 1); const float sm = forced ? 1e4f : IMP[q_ * 64 + m2];
#pragma unroll
                for (int e = 0; e < 8; ++e) rank[e] += (sm > sc[e] || (sm == sc[e] && m2 < sub * 8 + e)) ? 1 : 0;
            }
#pragma unroll
            for (int e = 0; e < 8; ++e) if (sub * 8 + e <= qt && rank[e] < 16) bits |= 1u << e;
        }
        unsigned lo = (sub < 4) ? (bits << (8 * sub)) : 0u, hi32 = (sub >= 4) ? (bits << (8 * (sub - 4))) : 0u;
        lo |= __shfl_xor(lo, 1); hi32 |= __shfl_xor(hi32, 1); lo |= __shfl_xor(lo, 2); hi32 |= __shfl_xor(hi32, 2); lo |= __shfl_xor(lo, 4); hi32 |= __shfl_xor(hi32, 4);
        if (sub == 0) { SEL[q_ * 2] = lo; SEL[q_ * 2 + 1] = hi32; }
        lo |= __shfl_xor(lo, 8); hi32 |= __shfl_xor(hi32, 8); lo |= __shfl_xor(lo, 16); hi32 |= __shfl_xor(hi32, 16); lo |= __shfl_xor(lo, 32); hi32 |= __shfl_xor(hi32, 32);
        if (lane == 0) { UNI[wid * 2] = lo; UNI[wid * 2 + 1] = hi32; }
    }
    __syncthreads();
    unsigned long long uni = 0ull;
#pragma unroll
    for (int w2 = 0; w2 < 8; ++w2) uni |= (unsigned long long)UNI[w2 * 2] | ((unsigned long long)UNI[w2 * 2 + 1] << 32);
    uni = ((unsigned long long)__builtin_amdgcn_readfirstlane((unsigned)(uni >> 32)) << 32) | (unsigned long long)__builtin_amdgcn_readfirstlane((unsigned)uni);
    const unsigned long long selm = (unsigned long long)SEL[qi * 2] | ((unsigned long long)SEL[qi * 2 + 1] << 32);

    {   m_reg = -1e30f; l_reg = 0.f; o[0] = f32x16{}; o[1] = f32x16{};
        unsigned long long rem = uni;
        int cur = __builtin_ctzll(rem); rem &= rem - 1; int st = 0;
        NSA_LOAD(pab + (size_t)cur * 64 * PA_LD + PA_KS + g * 64 + poff, pab + (size_t)cur * 64 * PA_LD + PA_VS + g * 64 + poff); NSA_WRITE(0); __syncthreads();
        for (;;) {
            const bool more = rem != 0ull; int nxt = 0;
            if (more) { nxt = __builtin_ctzll(rem); rem &= rem - 1; NSA_LOAD(pab + (size_t)nxt * 64 * PA_LD + PA_KS + g * 64 + poff, pab + (size_t)nxt * 64 * PA_LD + PA_VS + g * 64 + poff); }
            const bool on = ((selm >> cur) & 1ull) != 0ull;
            {   NSA_QK(st);
                if (cur == qt) mask_tile(p0, p1, qi - 4 * hi, 0x7fffffffu);
                if (!on) { const float NEG = -__builtin_inff();
#pragma unroll
                    for (int r = 0; r < 16; ++r) { p0[r] = NEG; p1[r] = NEG; } }
                NSA_SM();
                NSA_PV(st);
            }
            if (more) NSA_WRITE(st ^ 1);
            __syncthreads();
            if (!more) break;
            cur = nxt; st ^= 1;
        }
        NSA_FOLD(false, g_s / l_reg);
    }
    {   m_reg = -1e30f; l_reg = 0.f; o[0] = f32x16{}; o[1] = f32x16{};
        const int j0 = qt >= 8 ? 0 : 8 - qt;
        const bf16_t* wb = pab + (ptrdiff_t)(t0 - 512) * PA_LD;
        int st = 0;
        NSA_LOAD(wb + (ptrdiff_t)j0 * 64 * PA_LD + PA_KW + g * 64 + poff, wb + (ptrdiff_t)j0 * 64 * PA_LD + PA_VW + g * 64 + poff); NSA_WRITE(0); __syncthreads();
        for (int j = j0; j < 9; ++j) {
            if (j + 1 < 9) NSA_LOAD(wb + (ptrdiff_t)(j + 1) * 64 * PA_LD + PA_KW + g * 64 + poff, wb + (ptrdiff_t)(j + 1) * 64 * PA_LD + PA_VW + g * 64 + poff);
            {   NSA_QK(st);
                if (j == 0 || j == 8) mask_tile(p0, p1, qi + 512 - 64 * j - 4 * hi, 512u);
                NSA_SM();
                NSA_PV(st);
            }
            if (j + 1 < 9) NSA_WRITE(st ^ 1);
            __syncthreads();
            st ^= 1;
        }
        NSA_FOLD(false, g_w / l_reg);
    }
    {
#pragma unroll
        for (int r = 0; r < 16; ++r) { const int row = (r & 3) + 8 * (r >> 2) + 4 * hi; const int hd = g * 4 + (row >> 3); const size_t m = rowbase + t0 + 8 * wid + (row & 7);
            const bf16_t* gp = c.PA + m * PA_LD + PA_GA + hd * 64 + r32; bf16_t* op = c.MIX + m * DM + hd * 64 + r32;
#pragma unroll
            for (int d0 = 0; d0 < 2; ++d0) { const float v = ot[d0][r] * siluf(bf2f(gp[d0 * 32])); const float vn = __shfl_xor(v, 1);
                if ((r32 & 1) == 0) *(unsigned*)(op + d0 * 32) = cvtpk(v, vn); } }
    }
    __syncthreads();
}
#undef NSA_QK
#undef NSA_SM
#undef NSA_PV
#undef NSA_LOAD
#undef NSA_WRITE
#undef NSA_FOLD
__device__ __forceinline__ void phase(const Ctx& c, unsigned char* lds) {
    const int G = gridDim.x, bx = blockIdx.x; const int vcu = (G % 8 == 0) ? (bx % 8) * (G / 8) + bx / 8 : bx;
    for (int item = vcu; item < 256; item += G) {
        const int bg = item >> 4, s_ = item & 15;
#pragma unroll 1
        for (int i = 0; i < 4; ++i) { const int qt = (i == 0) ? s_ : (i == 1) ? 63 - s_ : (i == 2) ? 16 + s_ : 47 - s_; unit(c, lds, bg >> 1, bg & 1, qt); }
    }
}
}

__device__ __forceinline__ int natA(int p) {
    if (p < 768) { const int T = p >> 8, q = p & 255, half = q >> 7, hh = (q & 127) >> 5, i = q & 31;
        const int base = (T == 0) ? 64 * hh : (T == 1) ? 256 + 64 * hh : (hh < 2 ? 768 + 64 * hh : 1024 + 64 * (hh - 2));
        return base + 32 * half + i; }
    if (p < 1024) return 512 + (p - 768);
    if (p < 1152) return 896 + (p - 1024);
    if (p < 1280) return p;
    if (p < 3840) return p + 24;
    if (p < 3864) return 1280 + (p - 3840);
    return -1;
}
__device__ __forceinline__ int natC(int p) { return p < 512 ? p : (p < 1536 ? p + 64 : (p < 1600 ? 512 + (p - 1536) : -1)); }
__device__ __forceinline__ unsigned pk2(float lo, float hi) { return (unsigned)f2bf(lo) | ((unsigned)f2bf(hi) << 16); }
template <int MAP>
__device__ __forceinline__ void transpose_item(const float* W, int K, int Nsrc, int Ndst, bf16_t* WT, float* scr, int item, int lane) {
    const int nblk = Ndst / 32, kb = item / nblk, nb = item % nblk, k0 = 64 * kb, p0 = 32 * nb;
    const int p = p0 + (lane & 31);
    const int sc = (MAP == 0) ? natA(p) : (MAP == 1) ? natC(p) : p;
#pragma unroll 8
    for (int i = 0; i < 32; ++i) { const int kk = 2 * i + (lane >> 5); scr[kk * 33 + (lane & 31)] = (sc >= 0) ? W[(size_t)(k0 + kk) * Nsrc + sc] : 0.f; }
    WSYNC();
    const int c = lane & 7;
#pragma unroll
    for (int j = 0; j < 4; ++j) { const int n = (lane >> 3) + 8 * j; const float* sp = scr + (8 * c) * 33 + n;
        uint4 o; o.x = pk2(sp[0 * 33], sp[1 * 33]); o.y = pk2(sp[2 * 33], sp[3 * 33]); o.z = pk2(sp[4 * 33], sp[5 * 33]); o.w = pk2(sp[6 * 33], sp[7 * 33]);
        *(uint4*)(WT + (size_t)(p0 + n) * K + k0 + 8 * c) = o; }
    WSYNC();
}
__device__ __forceinline__ void ph0_weights(const Ctx& c, unsigned char* lds) {
    const int lane = threadIdx.x & 63, wave = threadIdx.x >> 6;
    float* scr = (float*)(lds + wave * 16384);
    const int gw = blockIdx.x * NWV + wave, NGW = gridDim.x * NWV;
    constexpr int I_A = 16 * 128, I_OA = 16 * 32, I_C = 16 * 56, I_UQ = 4 * 48, I_UKV = 4 * 64, I_OC = 16 * 32;
    constexpr int NITEMS = I_A + I_OA + I_C + I_UQ + I_UKV + I_OC;
    for (int it = gw; it < NITEMS; it += NGW) {
        int r = it;
        if (r < I_A) { transpose_item<0>(c.a_w_in, 1024, NIN_A, 4096, (bf16_t*)(c.ws + WS_WTA), scr, r, lane); continue; } r -= I_A;
        if (r < I_OA) { transpose_item<2>(c.a_w_out, 1024, 1024, 1024, (bf16_t*)(c.ws + WS_WTOA), scr, r, lane); continue; } r -= I_OA;
        if (r < I_C) { transpose_item<1>(c.c_w_in, 1024, NIN_C, 1792, (bf16_t*)(c.ws + WS_WTC), scr, r, lane); continue; } r -= I_C;
        if (r < I_UQ) { transpose_item<2>(c.w_uq, 256, 1536, 1536, (bf16_t*)(c.ws + WS_WTUQ), scr, r, lane); continue; } r -= I_UQ;
        if (r < I_UKV) { transpose_item<2>(c.w_ukv, 256, 2048, 2048, (bf16_t*)(c.ws + WS_WTUKV), scr, r, lane); continue; } r -= I_UKV;
        transpose_item<2>(c.c_w_out, 1024, 1024, 1024, (bf16_t*)(c.ws + WS_WTOC), scr, r, lane);
    }
}

__device__ __forceinline__ void ph0_prologue(const Ctx& c) {
    for (int idx = blockIdx.x * NTHR + threadIdx.x; idx < M * 32; idx += gridDim.x * NTHR) {
        const int m = idx >> 5, i = idx & 31;
        const float invf = (float)exp2(-(double)i * (13.287712379549449 / 32.0));
        const float ang = (float)c.pos[m] * invf;
        float s, co; sincos_acc(ang, s, co);
        c.CS[idx] = make_float2(co, s);
    }
    const int lane = threadIdx.x & 63, gw = blockIdx.x * NWV + (threadIdx.x >> 6), NGW = gridDim.x * NWV;
    for (int m = gw; m < M; m += NGW) rms_row_f32(c.x + (size_t)m * DM, c.a_norm, c.XN + (size_t)m * DM, lane);
}
__device__ __forceinline__ int pa_col(int n) { return n < 1280 ? n : (n < 1304 ? PA_GL + (n - 1280) : n - 24); }
__device__ __forceinline__ int pc_col(int n) { return n < 512 ? n : (n < 576 ? PC_KR + (n - 512) : n - 64); }

__device__ __forceinline__ void ph2_rope_a(const Ctx& c) {
    for (size_t idx = (size_t)blockIdx.x * NTHR + threadIdx.x; idx < (size_t)M * 12 * 32; idx += (size_t)gridDim.x * NTHR) {
        const int i = (int)(idx & 31); const size_t r = idx >> 5; const int slot = (int)(r % 12); const int m = (int)(r / 12);
        const int base = slot < 8 ? PA_Q + slot * 64 : (slot < 10 ? PA_KS + (slot - 8) * 64 : PA_KW + (slot - 10) * 64);
        const float sc = slot < 8 ? QSCALE_A : 1.f;
        bf16_t* p = c.PA + (size_t)m * PA_LD + base + i;
        const float x1 = bf2f(p[0]), x2 = bf2f(p[32]);
        const float2 cs = c.CS[(size_t)m * 32 + i];
        p[0] = f2bf((x1 * cs.x - x2 * cs.y) * sc); p[32] = f2bf((x2 * cs.x + x1 * cs.y) * sc);
    }
}

__device__ __forceinline__ void ph3_compress(const Ctx& c, unsigned char* lds) {
    float* blk = (float*)lds;
    float* part = blk + 8 * 2048;
    float* hid = part + 4 * 8 * 128;
    float* outp = hid + 8 * 128;
    float* outs = outp + 8 * 8 * 64;
    const int tid = threadIdx.x;
    for (int item = blockIdx.x; item < 2 * BATCH * 2 * 32; item += gridDim.x) {
        const int ct = item & 31, g = (item >> 5) & 1, b = (item >> 6) & 7, kv = item >> 9;
        const float* pe = kv ? c.pe_v : c.pe_k; const float* w1 = kv ? c.w_cv1 : c.w_ck1; const float* w2 = kv ? c.w_cv2 : c.w_ck2;
        const int col0 = (kv ? PA_VC : PA_KC) + g * 64;
        __syncthreads();
        for (int e = tid; e < 8 * 2048; e += NTHR) {
            const int ci = e >> 11, k = e & 2047, l = k >> 6, d = k & 63; const int cidx = ct * 8 + ci;
            float v = 0.f;
            if (cidx < 255) v = bf2f(c.PA[(size_t)(b * SEQ + 16 * cidx + l) * PA_LD + col0 + d]) + pe[l * 64 + d];
            blk[e] = v;
        }
        __syncthreads();
        {   const int j = tid & 127, pt = tid >> 7;
            float acc[8];
#pragma unroll
            for (int ci = 0; ci < 8; ++ci) acc[ci] = 0.f;
            for (int k = pt * 512; k < pt * 512 + 512; ++k) {
                const float w = w1[(size_t)k * 128 + j];
#pragma unroll
                for (int ci = 0; ci < 8; ++ci) acc[ci] = fmaf(blk[ci * 2048 + k], w, acc[ci]);
            }
#pragma unroll
            for (int ci = 0; ci < 8; ++ci) part[(pt * 8 + ci) * 128 + j] = acc[ci];
        }
        __syncthreads();
        for (int e = tid; e < 8 * 128; e += NTHR) { const int ci = e >> 7, j = e & 127; const float s = (part[(0 * 8 + ci) * 128 + j] + part[(1 * 8 + ci) * 128 + j]) + (part[(2 * 8 + ci) * 128 + j] + part[(3 * 8 + ci) * 128 + j]); hid[e] = siluf(s); }
        __syncthreads();
        {   const int d = tid & 63, pt = tid >> 6;
            float acc[8];
#pragma unroll
            for (int ci = 0; ci < 8; ++ci) acc[ci] = 0.f;
            for (int j = pt * 16; j < pt * 16 + 16; ++j) {
                const float w = w2[j * 64 + d];
#pragma unroll
                for (int ci = 0; ci < 8; ++ci) acc[ci] = fmaf(hid[ci * 128 + j], w, acc[ci]);
            }
#pragma unroll
            for (int ci = 0; ci < 8; ++ci) outp[(pt * 8 + ci) * 64 + d] = acc[ci];
        }
        __syncthreads();
        {   const int ci = tid >> 6, d = tid & 63; float s = 0.f;
#pragma unroll
            for (int pt = 0; pt < 8; ++pt) s += outp[(pt * 8 + ci) * 64 + d];
            outs[ci * 64 + d] = s; }
        __syncthreads();
        {   const int ci = tid >> 6, d = tid & 63; const int cidx = ct * 8 + ci;
            float v = outs[ci * 64 + d];
            if (kv == 0 && cidx < 255) {
                const int i = d & 31; const float2 cs = c.CS[(size_t)(b * SEQ + 16 * cidx + 31) * 32 + i];
                const float x1 = outs[ci * 64 + i], x2 = outs[ci * 64 + i + 32];
                v = (d < 32) ? (x1 * cs.x - x2 * cs.y) : (x2 * cs.x + x1 * cs.y);
            }
            if (cidx >= 255) v = 0.f;
            bf16_t* dst = (kv ? c.VCMP : c.KCMP) + ((size_t)(b * 2 + g) * 256 + cidx) * 64 + d;
            *dst = f2bf(v);
        }
    }
    __syncthreads();
}

__device__ __forceinline__ float dot64(const bf16_t* krow, const float* q) {
    float s = 0.f;
#pragma unroll
    for (int ch = 0; ch < 8; ++ch) {
        const uint4 v = *(const uint4*)(krow + ch * 8);
        const unsigned w[4] = {v.x, v.y, v.z, v.w};
#pragma unroll
        for (int e = 0; e < 4; ++e) { s = fmaf(__uint_as_float(w[e] << 16), q[ch * 8 + 2 * e], s); s = fmaf(__uint_as_float(w[e] & 0xffff0000u), q[ch * 8 + 2 * e + 1], s); }
    }
    return s;
}

__device__ __forceinline__ void ph4_nsa(const Ctx& c, unsigned char* lds) {
    const int lane = threadIdx.x & 63, wave = threadIdx.x >> 6;
    float* wq = (float*)(lds + wave * 12288);
    float* wp = wq + 64;
    float* wpc = wp + 1024;
    float* wres = wpc + 1024;
    const int gw = blockIdx.x * NWV + wave, NGW = gridDim.x * NWV;
    for (int item = gw; item < M * 2; item += NGW) {
        const int g = item & 1, m = item >> 1; const int b = m / SEQ, t = m % SEQ;
        const bf16_t* parow = c.PA + (size_t)m * PA_LD;
        const bf16_t* pab = c.PA + (size_t)b * SEQ * PA_LD;
        const bf16_t* kc = c.KCMP + (size_t)(b * 2 + g) * 256 * 64; const bf16_t* vc = c.VCMP + (size_t)(b * 2 + g) * 256 * 64;
        const int nvalid = t >= 31 ? min((t - 31) / 16 + 1, 255) : 0;
        for (int hh = 0; hh < 4; ++hh) {
            const int head = g * 4 + hh;
            WSYNC(); wq[lane] = bf2f(parow[PA_Q + head * 64 + lane]); WSYNC();
            float s[4]; float mx = -INFINITY;
#pragma unroll
            for (int jj = 0; jj < 4; ++jj) { const int ci = lane + 64 * jj; s[jj] = (ci < nvalid) ? dot64(kc + (size_t)ci * 64, wq) : -INFINITY; mx = fmaxf(mx, s[jj]); }
            mx = wave_max(mx);
            float sum = 0.f;
#pragma unroll
            for (int jj = 0; jj < 4; ++jj) { s[jj] = (nvalid > 0) ? exp2f(s[jj] - mx) : 0.f; sum += s[jj]; }
            sum = wave_sum(sum);
            const float inv = nvalid > 0 ? 1.f / sum : 0.f;
#pragma unroll
            for (int jj = 0; jj < 4; ++jj) wpc[hh * 256 + lane + 64 * jj] = s[jj] * inv;
            WSYNC();
            float o = 0.f;
            for (int ci = 0; ci < nvalid; ++ci) o = fmaf(wpc[hh * 256 + ci], bf2f(vc[(size_t)ci * 64 + lane]), o);
            wres[(hh * 3 + 0) * 64 + lane] = o;
        }
        unsigned long long selmask;
        {   const int n = lane; float imp = 0.f;
            const int c_lo = max(4 * n - 1, 0), c_hi = min(4 * n + 3, 254);
            for (int hh = 0; hh < 4; ++hh) for (int ci = c_lo; ci <= c_hi; ++ci) imp += wpc[hh * 256 + ci];
            const bool bv = (64 * n <= t); const int cur = t >> 6;
            const bool forced = (n == 0) || (n == cur) || (n == cur - 1);
            const float sc = bv ? (forced ? 1e4f : imp) : -1.f;
            int rank = 0;
            for (int mm = 0; mm < 64; ++mm) { const float o = __shfl(sc, mm); rank += (o > sc || (o == sc && mm < n)) ? 1 : 0; }
            selmask = __ballot(rank < 16 && bv);
        }
        for (int hh = 0; hh < 4; ++hh) {
            const int head = g * 4 + hh;
            WSYNC(); wq[lane] = bf2f(parow[PA_Q + head * 64 + lane]); WSYNC();
            {   unsigned long long sm = selmask; int slot = 0; float mx = -INFINITY;
                while (sm) { const int n = __builtin_ctzll(sm); sm &= sm - 1; const int tok = n * 64 + lane;
                    const float s = (tok <= t) ? dot64(pab + (size_t)tok * PA_LD + PA_KS + g * 64, wq) : -INFINITY;
                    wp[slot * 64 + lane] = s; mx = fmaxf(mx, s); ++slot; }
                mx = wave_max(mx);
                float sum = 0.f;
                for (int sl = 0; sl < slot; ++sl) { const float p = exp2f(wp[sl * 64 + lane] - mx); wp[sl * 64 + lane] = p; sum += p; }
                sum = wave_sum(sum); WSYNC();
                float o = 0.f; sm = selmask; slot = 0;
                while (sm) { const int n = __builtin_ctzll(sm); sm &= sm - 1;
                    const int kmax = min(63, t - n * 64);
                    for (int kk = 0; kk <= kmax; ++kk) o = fmaf(wp[slot * 64 + kk], bf2f(pab[(size_t)(n * 64 + kk) * PA_LD + PA_VS + g * 64 + lane]), o);
                    ++slot; }
                wres[(hh * 3 + 1) * 64 + lane] = o / sum; }
            WSYNC();
            {   float mx = -INFINITY;
                for (int j = 0; j < 8; ++j) { const int kp = t - 511 + 64 * j + lane;
                    const float s = (kp >= 0) ? dot64(pab + (size_t)kp * PA_LD + PA_KW + g * 64, wq) : -INFINITY;
                    wp[j * 64 + lane] = s; mx = fmaxf(mx, s); }
                mx = wave_max(mx);
                float sum = 0.f;
                for (int j = 0; j < 8; ++j) { const float p = exp2f(wp[j * 64 + lane] - mx); wp[j * 64 + lane] = p; sum += p; }
                sum = wave_sum(sum); WSYNC();
                float o = 0.f;
                const int k_lo = max(0, 511 - t);
                for (int kk = k_lo; kk < 512; ++kk) o = fmaf(wp[kk], bf2f(pab[(size_t)(t - 511 + kk) * PA_LD + PA_VW + g * 64 + lane]), o);
                wres[(hh * 3 + 2) * 64 + lane] = o / sum; }
        }
        for (int hh = 0; hh < 4; ++hh) {
            const int head = g * 4 + hh;
            const float g0 = sigmoidf_(bf2f(parow[PA_GL + head * 3 + 0])), g1 = sigmoidf_(bf2f(parow[PA_GL + head * 3 + 1])), g2 = sigmoidf_(bf2f(parow[PA_GL + head * 3 + 2]));
            const float o = g0 * wres[(hh * 3 + 0) * 64 + lane] + g1 * wres[(hh * 3 + 1) * 64 + lane] + g2 * wres[(hh * 3 + 2) * 64 + lane];
            const float ga = bf2f(parow[PA_GA + head * 64 + lane]);
            c.MIX[(size_t)m * DM + head * 64 + lane] = f2bf(siluf(ga) * o);
        }
    }
}

__device__ __forceinline__ void ph5_conv(const Ctx& c) {
    for (size_t idx = (size_t)blockIdx.x * NTHR + threadIdx.x; idx < (size_t)M * 512; idx += (size_t)gridDim.x * NTHR) {
        const int ch = (int)(idx & 511); const int m = (int)(idx >> 9); const int t = m % SEQ;
        const bf16_t* r0 = c.PA + (size_t)m * PA_LD;
        float y = c.conv_w[2 * 512 + ch] * bf2f(r0[PA_CC + ch]) * bf2f(r0[PA_CH + ch]);
        if (t >= 1) { const bf16_t* r1 = r0 - PA_LD; y += c.conv_w[1 * 512 + ch] * bf2f(r1[PA_CC + ch]) * bf2f(r1[PA_CH + ch]); }
        if (t >= 2) { const bf16_t* r2 = r0 - 2 * PA_LD; y += c.conv_w[0 * 512 + ch] * bf2f(r2[PA_CC + ch]) * bf2f(r2[PA_CH + ch]); }
        c.MIX[(size_t)m * DM + 512 + ch] = f2bf(siluf(bf2f(r0[PA_GB + ch])) * bf2f(r0[PA_CB + ch]) * y);
    }
}

__device__ __forceinline__ void ph7_norm1(const Ctx& c) {
    const int lane = threadIdx.x & 63, gw = blockIdx.x * NWV + (threadIdx.x >> 6), NGW = gridDim.x * NWV;
    for (int m = gw; m < M; m += NGW) rms_row_f32(c.out + (size_t)m * DM, c.c_norm, c.XN + (size_t)m * DM, lane);
}
__device__ __forceinline__ void ph_final(const Ctx& c) {
    const int lane = threadIdx.x & 63, gw = blockIdx.x * NWV + (threadIdx.x >> 6), NGW = gridDim.x * NWV;
    for (int m = gw; m < M; m += NGW) {
        float* xr = c.out + (size_t)m * DM;
        float4 v[4]; float s = 0.f;
#pragma unroll
        for (int j = 0; j < 4; ++j) { v[j] = *(const float4*)(xr + 4 * lane + 256 * j); s += (v[j].x * v[j].x + v[j].y * v[j].y) + (v[j].z * v[j].z + v[j].w * v[j].w); }
        const float rstd = 1.f / sqrtf(wave_sum(s) * (1.f / DM) + RMS_EPS);
#pragma unroll
        for (int j = 0; j < 4; ++j) { const float4 gg = *(const float4*)(c.final_norm + 4 * lane + 256 * j);
            float4 o; o.x = v[j].x * rstd * gg.x; o.y = v[j].y * rstd * gg.y; o.z = v[j].z * rstd * gg.z; o.w = v[j].w * rstd * gg.w;
            *(float4*)(xr + 4 * lane + 256 * j) = o; }
    }
}

__device__ __forceinline__ void ph9_lat_norm(const Ctx& c) {
    const int lane = threadIdx.x & 63, gw = blockIdx.x * NWV + (threadIdx.x >> 6), NGW = gridDim.x * NWV;
    for (int m = gw; m < M; m += NGW) {
        const bf16_t* r = c.PC + (size_t)m * PC_LD;
#pragma unroll
        for (int w = 0; w < 2; ++w) {
            const ushort4 v = *(const ushort4*)(r + (w ? PC_CKV : PC_CQ) + 4 * lane);
            const float a0 = bf2f(v.x), a1 = bf2f(v.y), a2 = bf2f(v.z), a3 = bf2f(v.w);
            const float rstd = 1.f / sqrtf(wave_sum(a0 * a0 + a1 * a1 + a2 * a2 + a3 * a3) * (1.f / 256.f) + RMS_EPS);
            const float4 gg = *(const float4*)((w ? c.kv_norm : c.q_norm) + 4 * lane);
            ushort4 o; o.x = f2bf(a0 * rstd * gg.x); o.y = f2bf(a1 * rstd * gg.y); o.z = f2bf(a2 * rstd * gg.z); o.w = f2bf(a3 * rstd * gg.w);
            *(ushort4*)((w ? c.CKVN : c.CQN) + (size_t)m * 256 + 4 * lane) = o;
        }
        if (lane < 32) {
            const float x1 = bf2f(r[PC_KR + lane]), x2 = bf2f(r[PC_KR + lane + 32]); const float2 cs = c.CS[(size_t)m * 32 + lane];
            c.KPE[(size_t)m * 64 + lane] = f2bf(x1 * cs.x - x2 * cs.y); c.KPE[(size_t)m * 64 + lane + 32] = f2bf(x2 * cs.x + x1 * cs.y);
        }
    }
}
__device__ __forceinline__ void ph11_rope_q1(const Ctx& c) {
    for (size_t idx = (size_t)blockIdx.x * NTHR + threadIdx.x; idx < (size_t)M * 8 * 96; idx += (size_t)gridDim.x * NTHR) {
        const int e = (int)(idx % 96); const size_t r = idx / 96; const int h = (int)(r & 7); const int m = (int)(r >> 3);
        bf16_t* q = c.Q1 + (size_t)m * 1536 + h * 192;
        if (e < 64) { q[e] = f2bf(bf2f(q[e]) * QSCALE_C); q[e + 64] = f2bf(bf2f(q[e + 64]) * QSCALE_C); }
        else { const int i = e - 64; const float2 cs = c.CS[(size_t)m * 32 + i];
            const float x1 = bf2f(q[128 + i]), x2 = bf2f(q[160 + i]);
            q[128 + i] = f2bf((x1 * cs.x - x2 * cs.y) * QSCALE_C); q[160 + i] = f2bf((x2 * cs.x + x1 * cs.y) * QSCALE_C); }
    }
}
__device__ __forceinline__ void ph12_mla(const Ctx& c, unsigned char* lds) {
    const int lane = threadIdx.x & 63, wave = threadIdx.x >> 6;
    float* wq = (float*)(lds + wave * 2048);
    float* wp = wq + 192;
    const int gw = blockIdx.x * NWV + wave, NGW = gridDim.x * NWV;
    for (int item = gw; item < M * 8; item += NGW) {
        const int h = item & 7, m = item >> 3; const int b = m / SEQ, t = m % SEQ;
        WSYNC();
        const bf16_t* qrow = c.Q1 + (size_t)m * 1536 + h * 192;
        wq[lane] = bf2f(qrow[lane]); wq[64 + lane] = bf2f(qrow[64 + lane]); wq[128 + lane] = bf2f(qrow[128 + lane]);
        WSYNC();
        float mrun = -1e30f, l = 0.f, o0 = 0.f, o1 = 0.f;
        const bf16_t* kvb = c.KV1 + (size_t)b * SEQ * 2048 + h * 256; const bf16_t* kpb = c.KPE + (size_t)b * SEQ * 64;
        for (int k0 = 0; k0 <= t; k0 += 64) {
            const int key = k0 + lane;
            float s = -INFINITY;
            if (key <= t) { const bf16_t* kr = kvb + (size_t)key * 2048; s = dot64(kr, wq) + dot64(kr + 64, wq + 64) + dot64(kpb + (size_t)key * 64, wq + 128); }
            const float cm = wave_max(s);
            const float mn = fmaxf(mrun, cm); const float alpha = exp2f(mrun - mn); mrun = mn;
            const float p = exp2f(s - mn);
            l = l * alpha + wave_sum(p); o0 *= alpha; o1 *= alpha;
            WSYNC(); wp[lane] = p; WSYNC();
            const int kmax = min(63, t - k0);
            for (int kk = 0; kk <= kmax; ++kk) { const bf16_t* vr = kvb + (size_t)(k0 + kk) * 2048 + 128; const float pp = wp[kk]; o0 = fmaf(pp, bf2f(vr[lane]), o0); o1 = fmaf(pp, bf2f(vr[64 + lane]), o1); }
        }
        const float inv = 1.f / l;
        const bf16_t* gr = c.PC + (size_t)m * PC_LD + PC_G + h * 128;
        c.O1[(size_t)m * DM + h * 128 + lane] = f2bf(siluf(bf2f(gr[lane])) * o0 * inv);
        c.O1[(size_t)m * DM + h * 128 + 64 + lane] = f2bf(siluf(bf2f(gr[64 + lane])) * o1 * inv);
    }
}

constexpr int NPHASE = 15;
__global__ void __launch_bounds__(NTHR, 2) mk_fwd(Args a) {
    extern __shared__ __attribute__((aligned(16))) unsigned char lds[];
    Ctx c;
    c.x = (const float*)a.in[0]; c.pos = (const int*)a.in[1]; c.a_norm = (const float*)a.in[2]; c.a_w_in = (const float*)a.in[3]; c.pe_k = (const float*)a.in[4]; c.pe_v = (const float*)a.in[5];
    c.w_ck1 = (const float*)a.in[6]; c.w_ck2 = (const float*)a.in[7]; c.w_cv1 = (const float*)a.in[8]; c.w_cv2 = (const float*)a.in[9]; c.conv_w = (const float*)a.in[10]; c.a_w_out = (const float*)a.in[11];
    c.c_norm = (const float*)a.in[12]; c.c_w_in = (const float*)a.in[13]; c.q_norm = (const float*)a.in[14]; c.kv_norm = (const float*)a.in[15]; c.w_uq = (const float*)a.in[16]; c.w_ukv = (const float*)a.in[17];
    c.c_w_out = (const float*)a.in[18]; c.final_norm = (const float*)a.in[19];
    c.out = a.out; c.ws = a.ws;
    c.CS = (float2*)(a.ws + WS_CS); c.KCMP = (bf16_t*)(a.ws + WS_KCMP); c.VCMP = (bf16_t*)(a.ws + WS_VCMP); c.XN = (bf16_t*)(a.ws + WS_XN); c.PA = (bf16_t*)(a.ws + WS_PA);
    c.MIX = (bf16_t*)(a.ws + WS_MIX); c.PC = (bf16_t*)(a.ws + WS_PC); c.Q1 = (bf16_t*)(a.ws + WS_Q1); c.KV1 = (bf16_t*)(a.ws + WS_KV1); c.CQN = (bf16_t*)(a.ws + WS_CQN);
    c.CKVN = (bf16_t*)(a.ws + WS_CKVN); c.KPE = (bf16_t*)(a.ws + WS_KPE); c.O1 = (bf16_t*)(a.ws + WS_O1);

    volatile LAS unsigned* misc = (volatile LAS unsigned*)((LAS unsigned char*)lds + (LDS_BYTES - 64));
    if (threadIdx.x < 16) misc[threadIdx.x] = 0u;
    __syncthreads();
    XcdBarrier bar; bar.bar = (unsigned*)(a.ws + WS_CTL) + 4096; bar.x = 0; bar.st = misc;
    const bool multi = (a.hi - a.lo) > 1;
    if (multi) bar = xcd_barrier_post((unsigned*)(a.ws + WS_CTL) + 4096, misc);

#define PHASE(k, ...) if (a.lo <= (k) && (k) < a.hi) { __VA_ARGS__; if ((k) + 1 < a.hi) xcd_barrier(bar); }
    LAS unsigned char* ldsl = (LAS unsigned char*)lds;
    PHASE(0, { ph0_weights(c, lds); ph0_prologue(c); })
    PHASE(1, { pg8::Gemm g{c.XN, (const bf16_t*)(c.ws + WS_WTA), M, 4096, 1024}; pg8::StaticOrder S; S.init(M, 4096, gridDim.x, blockIdx.x);
               pg8::EpiPA E{c.PA, c.CS}; pg8::gemm_phase<pg8::EpiPA, pg8::StaticOrder, true, true>(ldsl, g, S, E); })
    PHASE(3, ph3_compress(c, lds))
    PHASE(4, nsa::phase(c, lds))
    PHASE(5, ph5_conv(c))
    PHASE(6, { pg8::Gemm g{c.MIX, (const bf16_t*)(c.ws + WS_WTOA), M, 1024, 1024}; pg8::StaticOrder S; S.init(M, 1024, gridDim.x, blockIdx.x);
               pg8::EpiRes E{c.x, c.out}; pg8::gemm_phase<pg8::EpiRes, pg8::StaticOrder, true, true>(ldsl, g, S, E); })
    PHASE(7, ph7_norm1(c))
    PHASE(8, { pg8::Gemm g{c.XN, (const bf16_t*)(c.ws + WS_WTC), M, 1792, 1024}; pg8::StaticOrder S; S.init(M, 1792, gridDim.x, blockIdx.x);
               pg8::EpiPlain E{c.PC, PC_LD}; pg8::gemm_phase<pg8::EpiPlain, pg8::StaticOrder, true, true>(ldsl, g, S, E); })
    PHASE(9, ph9_lat_norm(c))
    PHASE(10, { for (int gi = 0; gi < 2; ++gi) {
                pg8::Gemm g{gi ? c.CKVN : c.CQN, (const bf16_t*)(c.ws + (gi ? WS_WTUKV : WS_WTUQ)), M, gi ? 2048 : 1536, 256}; pg8::StaticOrder S; S.init(M, gi ? 2048 : 1536, gridDim.x, blockIdx.x);
                pg8::EpiPlain E{gi ? c.KV1 : c.Q1, gi ? 2048 : 1536}; pg8::gemm_phase<pg8::EpiPlain, pg8::StaticOrder, true, true>(ldsl, g, S, E); __syncthreads(); } })
    PHASE(11, ph11_rope_q1(c))
    PHASE(12, mla::phase(c, lds))
    PHASE(13, { pg8::Gemm g{c.O1, (const bf16_t*)(c.ws + WS_WTOC), M, 1024, 1024}; pg8::StaticOrder S; S.init(M, 1024, gridDim.x, blockIdx.x);
               pg8::EpiRes E{c.out, c.out}; pg8::gemm_phase<pg8::EpiRes, pg8::StaticOrder, true, true>(ldsl, g, S, E); })
    PHASE(14, ph_final(c))
#undef PHASE
}

extern "C" void kernel_launch(void* const* d_in, const int* in_sizes, int n_in, void* d_out, int out_size, void* d_ws, size_t ws_size, hipStream_t stream) {
    static int grid = 0;
    if (grid == 0) {
        if (n_in != 20 || in_sizes[0] != M * DM || out_size != M * DM || ws_size < WS_END) {
            fprintf(stderr, "kernel_launch: unexpected shapes (n_in %d, in0 %d, out %d, ws %zu)\n", n_in, n_in > 0 ? in_sizes[0] : -1, out_size, ws_size); grid = -1; return; }
        int dev = 0, cus = 0;
        if (hipGetDevice(&dev) != hipSuccess || hipDeviceGetAttribute(&cus, hipDeviceAttributeMultiprocessorCount, dev) != hipSuccess || cus <= 0) { grid = -1; return; }
        if (hipFuncSetAttribute((const void*)mk_fwd, hipFuncAttributeMaxDynamicSharedMemorySize, LDS_BYTES) != hipSuccess) { fprintf(stderr, "kernel_launch: hipFuncSetAttribute failed\n"); grid = -1; return; }
        (void)hipGetLastError();
        grid = cus;
    }
    if (grid < 0) return;
    (void)hipMemsetAsync((char*)d_ws + WS_CTL, 0, CTL_BYTES, stream);
    Args a{};
    for (int i = 0; i < 20; ++i) a.in[i] = d_in[i];
    a.out = (float*)d_out; a.ws = (unsigned char*)d_ws;
#if MK_ONE_LAUNCH
    a.lo = 0; a.hi = NPHASE;
    hipLaunchKernelGGL(mk_fwd, dim3(grid), dim3(NTHR), LDS_BYTES, stream, a);
#else
    for (int ph = 0; ph < NPHASE; ++ph) { a.lo = ph; a.hi = ph + 1; hipLaunchKernelGGL(mk_fwd, dim3(grid), dim3(NTHR), LDS_BYTES, stream, a); }
#endif
}
```

```cpp
#include <hip/hip_runtime.h>
#include <cstdio>
#include <cstdint>
#include <cmath>

#ifndef MK_ONE_LAUNCH
#define MK_ONE_LAUNCH 1
#endif

constexpr int BATCH = 8, SEQ = 4096, DM = 1024, M = BATCH * SEQ;
constexpr int NIN_A = 3864, NIN_C = 1600;
constexpr int PA_LD = 4096;
constexpr int PC_LD = 1792;
constexpr int PA_Q = 0, PA_KC = 512, PA_VC = 640, PA_KS = 768, PA_VS = 896, PA_KW = 1024, PA_VW = 1152,
              PA_GA = 1280, PA_CB = 1792, PA_CC = 2304, PA_CH = 2816, PA_GB = 3328, PA_GL = 3840;
constexpr int PC_CQ = 0, PC_CKV = 256, PC_G = 512, PC_KR = 1536;
constexpr float LOG2E = 1.4426950408889634f;
constexpr float QSCALE_A = 0.125f * LOG2E;
constexpr float QSCALE_C = 0.07216878364870323f * LOG2E;
constexpr float RMS_EPS = 1e-6f;

constexpr size_t MiB = 1u << 20;
constexpr size_t WS_CTL = 0, CTL_BYTES = 1 * MiB;
constexpr size_t WS_CS = 1 * MiB;
constexpr size_t WS_KCMP = 9 * MiB;
constexpr size_t WS_VCMP = 9 * MiB + 512 * 1024;
constexpr size_t WS_WTA = 16 * MiB;
constexpr size_t WS_WTOA = 24 * MiB;
constexpr size_t WS_WTC = 26 * MiB;
constexpr size_t WS_WTUQ = 30 * MiB;
constexpr size_t WS_WTUKV = 31 * MiB;
constexpr size_t WS_WTOC = 32 * MiB;
constexpr size_t WS_XN = 48 * MiB;
constexpr size_t WS_PA = 112 * MiB;
constexpr size_t WS_MIX = 368 * MiB;
constexpr size_t WS_PC = 112 * MiB;
constexpr size_t WS_Q1 = 224 * MiB;
constexpr size_t WS_KV1 = 320 * MiB;
constexpr size_t WS_CQN = 448 * MiB;
constexpr size_t WS_CKVN = 464 * MiB;
constexpr size_t WS_KPE = 480 * MiB;
constexpr size_t WS_O1 = 48 * MiB;
constexpr size_t WS_END = 484 * MiB;

constexpr int LDS_BYTES = 147456;
constexpr int NTHR = 512, NWV = 8;

typedef unsigned short bf16_t;
#define LAS __attribute__((address_space(3)))

__device__ __forceinline__ float bf2f(bf16_t v) { return __uint_as_float(((unsigned)v) << 16); }
__device__ __forceinline__ bf16_t f2bf(float f) { unsigned u = __float_as_uint(f); return (bf16_t)((u + 0x7fffu + ((u >> 16) & 1u)) >> 16); }
__device__ __forceinline__ float wave_sum(float v) {
#pragma unroll
    for (int o = 1; o < 64; o <<= 1) v += __shfl_xor(v, o);
    return v;
}
__device__ __forceinline__ float wave_max(float v) {
#pragma unroll
    for (int o = 1; o < 64; o <<= 1) v = fmaxf(v, __shfl_xor(v, o));
    return v;
}
#define WSYNC() asm volatile("s_waitcnt lgkmcnt(0)" ::: "memory")
__device__ __forceinline__ float siluf(float x) { return x / (1.f + __expf(-x)); }
__device__ __forceinline__ float sigmoidf_(float x) { return 1.f / (1.f + __expf(-x)); }

#define XB_TMO      128
#define XB_XCNT(j)  (256  + 64 * (j))
#define XB_XSUB(j)  (1280 + 64 * (j))
#define XB_XGEN(j)  (2304 + 64 * (j))
#define XB_TOP      3328
#define XB_TOPGEN   3392
#define XCD_BAR_WORDS 3456
#define XB_SPIN_CAP (1u << 24)
__device__ __forceinline__ unsigned xb_ld(unsigned* p)              { return __hip_atomic_load(p, __ATOMIC_RELAXED, __HIP_MEMORY_SCOPE_AGENT); }
__device__ __forceinline__ unsigned xb_add(unsigned* p, unsigned v) { return __hip_atomic_fetch_add(p, v, __ATOMIC_RELAXED, __HIP_MEMORY_SCOPE_AGENT); }
__device__ __forceinline__ unsigned xb_xcc_id() { return (unsigned)__builtin_amdgcn_s_getreg((3 << 11) | 20) & 0xFu; }
#define XB_SPIN(cond, bar) do { unsigned _sp = 0; while (cond) { __builtin_amdgcn_s_sleep(1); \
    if ((++_sp & 255u) == 0u) { if (xb_ld(&(bar)[XB_TMO])) break; if (_sp > XB_SPIN_CAP) { atomicAdd(&(bar)[XB_TMO], 1u); break; } } } } while (0)
struct XcdBarrier { unsigned* bar; unsigned x; volatile LAS unsigned* st; };
__device__ __forceinline__ XcdBarrier xcd_barrier_post(unsigned* bar, volatile LAS unsigned* st) {
    XcdBarrier b; b.bar = bar; b.x = xb_xcc_id(); b.st = st;
    if (threadIdx.x == 0) (void)xb_add(&bar[XB_XCNT(b.x)], 1u);
    return b;
}
__device__ __forceinline__ void xcd_barrier_complete(unsigned* bar, unsigned x, unsigned& nloc, unsigned& nx) {
    const unsigned G = gridDim.x * gridDim.y * gridDim.z;
    unsigned sum, cnt, mine, sp = 0u;
    for (;;) {
        sum = 0u; cnt = 0u; mine = 0u;
#pragma unroll
        for (unsigned j = 0; j < 16; ++j) { const unsigned c = xb_ld(&bar[XB_XCNT(j)]); sum += c; cnt += (c > 0u) ? 1u : 0u; mine = (j == x) ? c : mine; }
        if (sum == G) break;
        __builtin_amdgcn_s_sleep(1);
        if ((++sp & 255u) == 0u) { if (xb_ld(&bar[XB_TMO])) break; if (sp > XB_SPIN_CAP) { atomicAdd(&bar[XB_TMO], 1u); break; } }
    }
    nloc = mine > 0u ? mine : 1u; nx = cnt > 0u ? cnt : 1u;
}
__device__ __forceinline__ void xcd_barrier(const XcdBarrier& b) {
    asm volatile("s_waitcnt vmcnt(0)" ::: "memory");
    __syncthreads();
    if (threadIdx.x == 0) {
        unsigned* bar = b.bar;
        __builtin_amdgcn_s_waitcnt(0);
        unsigned nloc = b.st[0], nx = b.st[1];
        if (nloc == 0u) { xcd_barrier_complete(bar, b.x, nloc, nx); b.st[0] = nloc; b.st[1] = nx; }
        const unsigned old = xb_add(&bar[XB_XSUB(b.x)], 1u);
        const unsigned gen = old / nloc;
        if (old + 1u == (gen + 1u) * nloc) {
            __builtin_amdgcn_fence(__ATOMIC_RELEASE, "agent");
            asm volatile("s_waitcnt vmcnt(0)" ::: "memory");
            const unsigned og = xb_add(&bar[XB_TOP], 1u);
            const unsigned tg = og / nx;
            if (og + 1u == (tg + 1u) * nx) xb_add(&bar[XB_TOPGEN], 1u);
            else XB_SPIN(xb_ld(&bar[XB_TOPGEN]) == tg, bar);
            __builtin_amdgcn_fence(__ATOMIC_ACQUIRE, "agent");
            xb_add(&bar[XB_XGEN(b.x)], 1u);
            asm volatile("s_waitcnt vmcnt(0)" ::: "memory");
        } else {
            XB_SPIN(xb_ld(&bar[XB_XGEN(b.x)]) == gen, bar);
            __builtin_amdgcn_fence(__ATOMIC_ACQUIRE, "agent");
            asm volatile("s_waitcnt vmcnt(0)" ::: "memory");
        }
    }
    __syncthreads();
}

struct Args { const void* in[20]; float* out; unsigned char* ws; int lo, hi; };
struct Ctx {
    const float* x; const int* pos; const float* a_norm; const float* a_w_in; const float* pe_k; const float* pe_v;
    const float* w_ck1; const float* w_ck2; const float* w_cv1; const float* w_cv2; const float* conv_w; const float* a_w_out;
    const float* c_norm; const float* c_w_in; const float* q_norm; const float* kv_norm; const float* w_uq; const float* w_ukv; const float* c_w_out; const float* final_norm;
    float* out; unsigned char* ws;
    float2* CS; bf16_t* KCMP; bf16_t* VCMP; bf16_t* XN; bf16_t* PA; bf16_t* MIX; bf16_t* PC; bf16_t* Q1; bf16_t* KV1; bf16_t* CQN; bf16_t* CKVN; bf16_t* KPE; bf16_t* O1;
};

__device__ __forceinline__ void sincos_acc(float angf, float& s, float& c) {
    const double x = (double)angf;
    const double k = rint(x * 0.6366197723675814);
    double r = fma(-k, 1.5707963267948966, x);
    r = fma(-k, 6.123233995736766e-17, r);
    const double r2 = r * r;
    double sp = -1.0 / 1307674368000.0;
    sp = fma(sp, r2, 1.0 / 6227020800.0);
    sp = fma(sp, r2, -1.0 / 39916800.0);
    sp = fma(sp, r2, 1.0 / 362880.0);
    sp = fma(sp, r2, -1.0 / 5040.0);
    sp = fma(sp, r2, 1.0 / 120.0);
    sp = fma(sp, r2, -1.0 / 6.0);
    const double sn = fma(sp * r2, r, r);
    double cp = 1.0 / 20922789888000.0;
    cp = fma(cp, r2, -1.0 / 87178291200.0);
    cp = fma(cp, r2, 1.0 / 479001600.0);
    cp = fma(cp, r2, -1.0 / 3628800.0);
    cp = fma(cp, r2, 1.0 / 40320.0);
    cp = fma(cp, r2, -1.0 / 720.0);
    cp = fma(cp, r2, 1.0 / 24.0);
    cp = fma(cp, r2, -0.5);
    const double cs = fma(cp, r2, 1.0);
    const int q = ((int)(long long)k) & 3;
    const double ss = (q == 0) ? sn : (q == 1) ? cs : (q == 2) ? -sn : -cs;
    const double cc = (q == 0) ? cs : (q == 1) ? -sn : (q == 2) ? -cs : sn;
    s = (float)ss; c = (float)cc;
}

__device__ __forceinline__ void rms_row_f32(const float* xr, const float* g, bf16_t* orow, int lane) {
    float4 v[4]; float s = 0.f;
#pragma unroll
    for (int j = 0; j < 4; ++j) { v[j] = *(const float4*)(xr + 4 * lane + 256 * j); s += (v[j].x * v[j].x + v[j].y * v[j].y) + (v[j].z * v[j].z + v[j].w * v[j].w); }
    const float rstd = 1.f / sqrtf(wave_sum(s) * (1.f / DM) + RMS_EPS);
#pragma unroll
    for (int j = 0; j < 4; ++j) {
        const float4 gg = *(const float4*)(g + 4 * lane + 256 * j);
        ushort4 o; o.x = f2bf(v[j].x * rstd * gg.x); o.y = f2bf(v[j].y * rstd * gg.y); o.z = f2bf(v[j].z * rstd * gg.z); o.w = f2bf(v[j].w * rstd * gg.w);
        *(ushort4*)(orow + 4 * lane + 256 * j) = o;
    }
}

namespace pg8 {
#define PG8_LAS __attribute__((address_space(3)))
typedef unsigned short bf16_t;
typedef short bf16x8 __attribute__((ext_vector_type(8)));
typedef float f32x4 __attribute__((ext_vector_type(4)));
typedef unsigned u32x4 __attribute__((ext_vector_type(4)));
constexpr int BM = 256, BK = 64, HALF = 128, HTB = HALF * BK * 2  , STAGE_BYTES = 8 * HTB, NXCD = 8, WGM = 8;

__host__ __device__ __forceinline__ int lds_byte(int r, int c) { const int st = (r >> 4) * 2 + (c >> 5), rr = r & 15, cc = c & 31, ob = rr * 64 + cc * 2; return st * 1024 + (ob ^ (((ob >> 9) & 1) << 5)); }
__host__ __device__ __forceinline__ void stage_rc(int b, int& R, int& C) { const int st = b / 1024, sb = b % 1024, swz = sb ^ (((sb >> 9) & 1) << 5); R = (st >> 1) * 16 + swz / 64; C = (st & 1) * 32 + (swz % 64) / 2; }
__host__ __device__ __forceinline__ int perm32(int rho) { const int n = rho >> 4, i = rho & 15; return 8 * (i >> 2) + 4 * n + (i & 3); }

struct Unit { int pm, pn; };
struct Gemm { const bf16_t* A; const bf16_t* Bt; int M, N, K; };

struct StaticOrder {
    int nM, nN, nwg, G, c;
    __host__ __device__ void init(int M, int N, int G_, int c_) { nM = M / BM; nN = N / BM; nwg = nM * nN; G = G_; c = c_; }
    __host__ __device__ bool next(int i, Unit& u) const {
        const long L = (long)i * G + c; if (L >= nwg) return false;
        int wgid = (int)L; { const int q = nwg / NXCD, r = nwg % NXCD, xcd = wgid % NXCD, off = wgid / NXCD; wgid = (xcd < r ? xcd * (q + 1) : r * (q + 1) + (xcd - r) * q) + off; }
        const int nig = WGM * nN, gid = wgid / nig, fm = gid * WGM, gsz = (nM - fm) < WGM ? (nM - fm) : WGM;
        u.pm = fm + ((wgid % nig) % gsz); u.pn = (wgid % nig) / gsz; return true;
    }
    __device__ __forceinline__ void a_ready(const Unit&) const {}
    __device__ __forceinline__ void done(const Unit&) const {}
};

__device__ __forceinline__ unsigned cvt_pk_bf16(float lo, float hi) { unsigned r; asm volatile("v_cvt_pk_bf16_f32 %0, %1, %2" : "=v"(r) : "v"(lo), "v"(hi)); return r; }

struct EpiPA {
    static constexpr bool PERM = true, AFTER_DRAIN = false;
    bf16_t* PA; const float2* CS;
    __device__ __forceinline__ void operator()(const f32x4 (&acc)[2][2][4][2], const Unit& u, int wr, int wc, int fr, int fq) const {
        const int row0 = u.pm * BM + wr * 64 + fr;
        if (u.pn < 3) {
            const int base = (u.pn == 0) ? 64 * wc : (u.pn == 1) ? 256 + 64 * wc : (wc < 2 ? 768 + 64 * wc : 1024 + 64 * (wc - 2));
            const float sc = u.pn < 2 ? QSCALE_A : 1.f;
#pragma unroll
            for (int ai = 0; ai < 2; ++ai)
#pragma unroll
                for (int m = 0; m < 4; ++m) {
                    const int row = row0 + ai * HALF + m * 16;
                    const f32x4* csp = (const f32x4*)(CS + (size_t)row * 32 + 8 * fq);
                    const f32x4 t0 = csp[0], t1 = csp[1], t2 = csp[2], t3 = csp[3];
                    const f32x4 a0 = acc[ai][0][m][0], a1 = acc[ai][0][m][1], b0 = acc[ai][1][m][0], b1 = acc[ai][1][m][1];
                    u32x4 w1, w2;
                    w1.x = cvt_pk_bf16((a0[0] * t0[0] - b0[0] * t0[1]) * sc, (a0[1] * t0[2] - b0[1] * t0[3]) * sc);
                    w1.y = cvt_pk_bf16((a0[2] * t1[0] - b0[2] * t1[1]) * sc, (a0[3] * t1[2] - b0[3] * t1[3]) * sc);
                    w1.z = cvt_pk_bf16((a1[0] * t2[0] - b1[0] * t2[1]) * sc, (a1[1] * t2[2] - b1[1] * t2[3]) * sc);
                    w1.w = cvt_pk_bf16((a1[2] * t3[0] - b1[2] * t3[1]) * sc, (a1[3] * t3[2] - b1[3] * t3[3]) * sc);
                    w2.x = cvt_pk_bf16((b0[0] * t0[0] + a0[0] * t0[1]) * sc, (b0[1] * t0[2] + a0[1] * t0[3]) * sc);
                    w2.y = cvt_pk_bf16((b0[2] * t1[0] + a0[2] * t1[1]) * sc, (b0[3] * t1[2] + a0[3] * t1[3]) * sc);
                    w2.z = cvt_pk_bf16((b1[0] * t2[0] + a1[0] * t2[1]) * sc, (b1[1] * t2[2] + a1[1] * t2[3]) * sc);
                    w2.w = cvt_pk_bf16((b1[2] * t3[0] + a1[2] * t3[1]) * sc, (b1[3] * t3[2] + a1[3] * t3[3]) * sc);
                    bf16_t* rp = PA + (size_t)row * PA_LD + base + 8 * fq;
                    *(u32x4*)rp = w1; *(u32x4*)(rp + 32) = w2;
                }
        } else {
            const int cb0 = (u.pn == 3) ? 512 : (u.pn == 4) ? 896 : 256 * u.pn;
            const int cb1 = (u.pn == 3) ? 640 : (u.pn == 4) ? 1152 : 256 * u.pn + 128;
#pragma unroll
            for (int ai = 0; ai < 2; ++ai)
#pragma unroll
                for (int m = 0; m < 4; ++m) {
                    bf16_t* rp = PA + (size_t)(row0 + ai * HALF + m * 16) * PA_LD + 32 * wc + 8 * fq;
#pragma unroll
                    for (int bj = 0; bj < 2; ++bj) { const f32x4 v0 = acc[ai][bj][m][0], v1 = acc[ai][bj][m][1];
                        u32x4 w; w.x = cvt_pk_bf16(v0[0], v0[1]); w.y = cvt_pk_bf16(v0[2], v0[3]); w.z = cvt_pk_bf16(v1[0], v1[1]); w.w = cvt_pk_bf16(v1[2], v1[3]);
                        *(u32x4*)(rp + (bj ? cb1 : cb0)) = w; }
                }
        }
    }
};
struct EpiPlain {
    static constexpr bool PERM = true, AFTER_DRAIN = false;
    bf16_t* O; int ldc;
    __device__ __forceinline__ void operator()(const f32x4 (&acc)[2][2][4][2], const Unit& u, int wr, int wc, int fr, int fq) const {
        const int row0 = u.pm * BM + wr * 64 + fr; const int col0 = u.pn * BM + wc * 32 + 8 * fq;
#pragma unroll
        for (int ai = 0; ai < 2; ++ai)
#pragma unroll
            for (int m = 0; m < 4; ++m) { bf16_t* rp = O + (size_t)(row0 + ai * HALF + m * 16) * ldc + col0;
#pragma unroll
                for (int bj = 0; bj < 2; ++bj) { const f32x4 v0 = acc[ai][bj][m][0], v1 = acc[ai][bj][m][1];
                    u32x4 w; w.x = cvt_pk_bf16(v0[0], v0[1]); w.y = cvt_pk_bf16(v0[2], v0[3]); w.z = cvt_pk_bf16(v1[0], v1[1]); w.w = cvt_pk_bf16(v1[2], v1[3]);
                    *(u32x4*)(rp + bj * HALF) = w; } }
    }
};
struct EpiRes {
    static constexpr bool PERM = false, AFTER_DRAIN = false;
    const float* base; float* out;
    __device__ __forceinline__ void operator()(const f32x4 (&acc)[2][2][4][2], const Unit& u, int wr, int wc, int fr, int fq) const {
        const int row0 = u.pm * BM + wr * 64 + fr; const int col0 = u.pn * BM + wc * 32 + 4 * fq;
#pragma unroll
        for (int ai = 0; ai < 2; ++ai)
#pragma unroll
            for (int m = 0; m < 4; ++m) { const size_t off = (size_t)(row0 + ai * HALF + m * 16) * 1024 + col0;
#pragma unroll
                for (int bj = 0; bj < 2; ++bj)
#pragma unroll
                    for (int n = 0; n < 2; ++n) { const f32x4 b = *(const f32x4*)(base + off + bj * HALF + n * 16); *(f32x4*)(out + off + bj * HALF + n * 16) = b + acc[ai][bj][m][n]; } }
    }
};
template <class Epi, class Sched, bool ALIGN_EPI = false, bool SP2 = false>
__device__ __forceinline__ void gemm_phase(PG8_LAS unsigned char* lds, const Gemm g, const Sched& S, const Epi& E) {
    const int tid = threadIdx.x, wid = __builtin_amdgcn_readfirstlane(tid >> 6), lane = tid & 63, wr = wid >> 2, wc = wid & 3, fr = lane & 15, fq = lane >> 4;
    const int K = g.K, nt = K / BK;
    unsigned voffA[2], voffB[2];
#pragma unroll
    for (int i = 0; i < 2; ++i) { int R, C; stage_rc(tid * 16 + i * 8192, R, C); const int Rb = Epi::PERM ? ((R & ~31) + perm32(R & 31)) : R;
        voffA[i] = (unsigned)(R * K + C) * 2u; voffB[i] = (unsigned)(Rb * K + C) * 2u; }
    const size_t kstep = (size_t)(BK * 2);
    const size_t hstep = (size_t)HALF * K * 2;
    const size_t tstep = 2 * hstep;
    const unsigned ldsw = (unsigned)wid * 1024u;
    const int aoff = lds_byte(wr * 64 + fr, fq * 8), boff = lds_byte(wc * 32 + fr, fq * 8);
#define PG8_SA(b, h) (((b) * 2 + (h)) * HTB)
#define PG8_SB(b, h) ((4 + (b) * 2 + (h)) * HTB)
#define PG8_STAGE(bufoff, gbase, voff) do { _Pragma("unroll") for (int _i = 0; _i < 2; ++_i) \
        __builtin_amdgcn_global_load_lds((const unsigned*)((const char*)(gbase) + (voff)[_i]), (PG8_LAS unsigned*)(lds + (bufoff) + ldsw + _i * 8192), 16, 0, 0); } while (0)
#define PG8_LDA(dst, b, h) do { _Pragma("unroll") for (int m = 0; m < 4; ++m) _Pragma("unroll") for (int k = 0; k < 2; ++k) dst[m][k] = *(const PG8_LAS bf16x8*)(lds + PG8_SA(b, h) + aoff + m * 2048 + k * 1024); } while (0)
#define PG8_LDB(dst, b, h) do { _Pragma("unroll") for (int n = 0; n < 2; ++n) _Pragma("unroll") for (int k = 0; k < 2; ++k) dst[n][k] = *(const PG8_LAS bf16x8*)(lds + PG8_SB(b, h) + boff + n * 2048 + k * 1024); } while (0)
#define PG8_MMA(ai, bj, At, Bt) do { __builtin_amdgcn_s_setprio(1); _Pragma("unroll") for (int m = 0; m < 4; ++m) _Pragma("unroll") for (int n = 0; n < 2; ++n) _Pragma("unroll") for (int k = 0; k < 2; ++k) \
        acc[ai][bj][m][n] = __builtin_amdgcn_mfma_f32_16x16x32_bf16(Bt[n][k], At[m][k], acc[ai][bj][m][n], 0, 0, 0); __builtin_amdgcn_s_setprio(0); } while (0)
#define PG8_WAIT_V(n) asm volatile("s_waitcnt vmcnt(" #n ")" ::: "memory")
#define PG8_WAIT_L(n) asm volatile("s_waitcnt lgkmcnt(" #n ")" ::: "memory")
#define PG8_BAR __builtin_amdgcn_s_barrier()
#define PG8_SCHED __builtin_amdgcn_sched_barrier(0)
    Unit cur, nxt; int ui = 0;
    if (!S.next(0, cur)) return;
    f32x4 acc[2][2][4][2];
#pragma unroll
    for (int a = 0; a < 2; ++a)
#pragma unroll
        for (int b = 0; b < 2; ++b)
#pragma unroll
            for (int m = 0; m < 4; ++m)
#pragma unroll
                for (int n = 0; n < 2; ++n) acc[a][b][m][n] = (f32x4){0.f, 0.f, 0.f, 0.f};
    bf16x8 At[4][2], B0[2][2], B1[2][2];
    const char* cA = (const char*)g.A + (size_t)cur.pm * tstep; const char* cB = (const char*)g.Bt + (size_t)cur.pn * tstep;
    S.a_ready(cur);
    if constexpr (SP2) {
        PG8_STAGE(PG8_SB(0, 0), cB, voffB); PG8_STAGE(PG8_SB(0, 1), cB + hstep, voffB); PG8_STAGE(PG8_SA(0, 0), cA, voffA); PG8_STAGE(PG8_SA(0, 1), cA + hstep, voffA);
        if (wr == 1) PG8_BAR;
        PG8_WAIT_V(2); PG8_BAR;
        PG8_STAGE(PG8_SB(1, 0), cB + kstep, voffB); PG8_STAGE(PG8_SA(1, 0), cA + kstep, voffA); PG8_STAGE(PG8_SB(1, 1), cB + hstep + kstep, voffB);
        PG8_WAIT_V(6); PG8_BAR;
    } else {
        PG8_STAGE(PG8_SB(0, 0), cB, voffB); PG8_STAGE(PG8_SA(0, 0), cA, voffA); PG8_STAGE(PG8_SB(0, 1), cB + hstep, voffB); PG8_STAGE(PG8_SA(0, 1), cA + hstep, voffA);
        if (wr == 1) PG8_BAR;
        PG8_WAIT_V(4); PG8_BAR;
        PG8_STAGE(PG8_SB(1, 0), cB + kstep, voffB); PG8_STAGE(PG8_SA(1, 0), cA + kstep, voffA); PG8_STAGE(PG8_SB(1, 1), cB + hstep + kstep, voffB);
        PG8_WAIT_V(6); PG8_BAR;
    }
    for (;;) {
        const bool has_next = S.next(ui + 1, nxt);
        const char* nA = has_next ? (const char*)g.A + (size_t)nxt.pm * tstep : cA; const char* nB = has_next ? (const char*)g.Bt + (size_t)nxt.pn * tstep : cB;
        for (int t = 0; t < nt; t += 2) {
            const bool last = (t == nt - 2);
            const char* a1 = cA + (size_t)(t + 1) * kstep;
            const char* a2 = last ? nA : cA + (size_t)(t + 2) * kstep; const char* b2 = last ? nB : cB + (size_t)(t + 2) * kstep;
            const char* a3 = a2 + kstep; const char* b3 = b2 + kstep;
            if (last && has_next) S.a_ready(nxt);
            if constexpr (SP2) {
            PG8_LDB(B0, 0, 0); PG8_LDB(B1, 0, 1); PG8_SCHED; PG8_LDA(At, 0, 0); PG8_STAGE(PG8_SA(1, 1), a1 + hstep, voffA);
            PG8_WAIT_V(8); PG8_WAIT_L(0); PG8_BAR; PG8_MMA(0, 0, At, B0); PG8_MMA(0, 1, At, B1); PG8_BAR; PG8_SCHED;
            PG8_LDA(At, 0, 1); PG8_STAGE(PG8_SB(0, 0), b2, voffB); PG8_STAGE(PG8_SB(0, 1), b2 + hstep, voffB); PG8_STAGE(PG8_SA(0, 0), a2, voffA);
            PG8_WAIT_V(8); PG8_WAIT_L(0); PG8_BAR; PG8_MMA(1, 0, At, B0); PG8_MMA(1, 1, At, B1); PG8_BAR; PG8_SCHED;
            PG8_LDB(B0, 1, 0); PG8_LDB(B1, 1, 1); PG8_SCHED; PG8_LDA(At, 1, 0); PG8_STAGE(PG8_SA(0, 1), a2 + hstep, voffA);
            PG8_WAIT_V(8); PG8_WAIT_L(0); PG8_BAR; PG8_MMA(0, 0, At, B0); PG8_MMA(0, 1, At, B1); PG8_BAR; PG8_SCHED;
            PG8_LDA(At, 1, 1); PG8_STAGE(PG8_SB(1, 0), b3, voffB); PG8_STAGE(PG8_SB(1, 1), b3 + hstep, voffB); PG8_STAGE(PG8_SA(1, 0), a3, voffA);
            PG8_WAIT_V(8); PG8_WAIT_L(0); PG8_BAR; PG8_MMA(1, 0, At, B0); PG8_MMA(1, 1, At, B1); PG8_BAR; PG8_SCHED;
            } else {
            PG8_LDB(B0, 0, 0); PG8_SCHED; PG8_LDA(At, 0, 0); PG8_STAGE(PG8_SA(1, 1), a1 + hstep, voffA);
            PG8_WAIT_L(8); PG8_BAR; PG8_WAIT_L(0); PG8_MMA(0, 0, At, B0); PG8_BAR; PG8_SCHED;
            PG8_LDB(B1, 0, 1); PG8_STAGE(PG8_SB(0, 0), b2, voffB);
            PG8_BAR; PG8_WAIT_L(0); PG8_MMA(0, 1, At, B1); PG8_BAR;
            PG8_LDA(At, 0, 1); PG8_STAGE(PG8_SA(0, 0), a2, voffA);
            PG8_BAR; PG8_WAIT_L(0); PG8_MMA(1, 0, At, B0); PG8_BAR; PG8_SCHED;
            PG8_STAGE(PG8_SB(0, 1), b2 + hstep, voffB);
            PG8_WAIT_V(6); PG8_BAR; PG8_MMA(1, 1, At, B1); PG8_BAR;
            PG8_LDB(B0, 1, 0); PG8_SCHED; PG8_LDA(At, 1, 0); PG8_STAGE(PG8_SA(0, 1), a2 + hstep, voffA);
            PG8_WAIT_L(8); PG8_BAR; PG8_WAIT_L(0); PG8_MMA(0, 0, At, B0); PG8_BAR; PG8_SCHED;
            PG8_LDB(B1, 1, 1); PG8_STAGE(PG8_SB(1, 0), b3, voffB);
            PG8_BAR; PG8_WAIT_L(0); PG8_MMA(0, 1, At, B1); PG8_BAR;
            PG8_LDA(At, 1, 1); PG8_STAGE(PG8_SA(1, 0), a3, voffA);
            PG8_BAR; PG8_WAIT_L(0); PG8_MMA(1, 0, At, B0); PG8_BAR; PG8_SCHED;
            PG8_STAGE(PG8_SB(1, 1), b3 + hstep, voffB);
            PG8_WAIT_V(6); PG8_BAR; PG8_MMA(1, 1, At, B1); PG8_BAR;
            }
        }
        if constexpr (ALIGN_EPI) { if (wr == 0) PG8_BAR; }
        if constexpr (!Epi::AFTER_DRAIN) { E(acc, cur, wr, wc, fr, fq); S.done(cur); }
        if (!has_next) break;
#pragma unroll
        for (int a = 0; a < 2; ++a)
#pragma unroll
            for (int b = 0; b < 2; ++b)
#pragma unroll
                for (int m = 0; m < 4; ++m)
#pragma unroll
                    for (int n = 0; n < 2; ++n) acc[a][b][m][n] = (f32x4){0.f, 0.f, 0.f, 0.f};
        cur = nxt; cA = nA; cB = nB; ++ui;
        if constexpr (ALIGN_EPI) { if (wr == 1) PG8_BAR; }
    }
    PG8_WAIT_V(0);
    if constexpr (!ALIGN_EPI) { if (wr == 0) PG8_BAR; }
    PG8_BAR;
    if constexpr (Epi::AFTER_DRAIN) { E.fused(acc, cur, wr, wc, fr, fq, lds, wid, lane); S.done(cur); }
#undef PG8_SA
#undef PG8_SB
#undef PG8_STAGE
#undef PG8_LDA
#undef PG8_LDB
#undef PG8_MMA
#undef PG8_WAIT_V
#undef PG8_WAIT_L
#undef PG8_BAR
#undef PG8_SCHED
}
}

template <class Epi>
__device__ __forceinline__ void gemm_naive(const bf16_t* A, int lda, const float* W, int K, int N, unsigned char* lds, Epi epi) {
    float (*As)[132] = (float (*)[132])lds;
    float (*Bs)[128] = (float (*)[128])(lds + 16 * 132 * 4);
    const int tid = threadIdx.x, tx = tid & 31, ty = tid >> 5;
    const int ntm = M / 128, ntn = (N + 127) / 128;
    for (int tile = blockIdx.x; tile < ntm * ntn; tile += gridDim.x) {
        const int tm = tile / ntn, tn = tile % ntn;
        float acc[8][4];
#pragma unroll
        for (int i = 0; i < 8; ++i)
#pragma unroll
            for (int j = 0; j < 4; ++j) acc[i][j] = 0.f;
        for (int k0 = 0; k0 < K; k0 += 16) {
            {   const int r = tid >> 2, kq = (tid & 3) * 4;
                const ushort4 v = *(const ushort4*)(A + (size_t)(tm * 128 + r) * lda + k0 + kq);
                As[kq + 0][r] = bf2f(v.x); As[kq + 1][r] = bf2f(v.y); As[kq + 2][r] = bf2f(v.z); As[kq + 3][r] = bf2f(v.w); }
            {   const int kk = tid >> 5, n4 = (tid & 31) * 4; const int n = tn * 128 + n4;
                const float* wp = W + (size_t)(k0 + kk) * N + n;
                float4 v;
                v.x = (n + 0 < N) ? wp[0] : 0.f; v.y = (n + 1 < N) ? wp[1] : 0.f; v.z = (n + 2 < N) ? wp[2] : 0.f; v.w = (n + 3 < N) ? wp[3] : 0.f;
                *(float4*)&Bs[kk][n4] = v; }
            __syncthreads();
#pragma unroll 2
            for (int kk = 0; kk < 16; ++kk) {
                const float4 a0 = *(const float4*)&As[kk][ty * 8], a1 = *(const float4*)&As[kk][ty * 8 + 4];
                const float4 b = *(const float4*)&Bs[kk][tx * 4];
                const float a[8] = {a0.x, a0.y, a0.z, a0.w, a1.x, a1.y, a1.z, a1.w};
                const float bb[4] = {b.x, b.y, b.z, b.w};
#pragma unroll
                for (int i = 0; i < 8; ++i)
#pragma unroll
                    for (int j = 0; j < 4; ++j) acc[i][j] = fmaf(a[i], bb[j], acc[i][j]);
            }
            __syncthreads();
        }
#pragma unroll
        for (int i = 0; i < 8; ++i)
#pragma unroll
            for (int j = 0; j < 4; ++j) { const int m = tm * 128 + ty * 8 + i, n = tn * 128 + tx * 4 + j; if (n < N) epi(m, n, acc[i][j]); }
    }
}

namespace fa {
typedef short bf16x8 __attribute__((ext_vector_type(8)));
typedef short s16x4 __attribute__((ext_vector_type(4)));
typedef float f32x16 __attribute__((ext_vector_type(16)));
typedef unsigned u32x4 __attribute__((ext_vector_type(4)));
#define FA_SBAR() __builtin_amdgcn_sched_barrier(0)
__device__ __forceinline__ int crow(int r, int hi) { return (r & 3) + 8 * (r >> 2) + 4 * hi; }
__device__ __forceinline__ unsigned cvtpk(float lo, float hi) { unsigned r; asm volatile("v_cvt_pk_bf16_f32 %0, %1, %2" : "=v"(r) : "v"(lo), "v"(hi)); return r; }
template <int NCB> __device__ __forceinline__ int v_st(int k, int c) { const int kk = (k & ~0xC) | ((k & 4) << 1) | ((k & 8) >> 1); return ((kk >> 3) * NCB + (c >> 5)) * 512 + ((kk & 7) * 32 + (c & 31)) * 2; }
__device__ __forceinline__ int v_rd_base(int lane) { return ((lane & 3) << 3) | (((lane >> 2) & 3) << 6) | (((lane >> 4) & 1) << 5) | (((lane >> 5) & 1) << 8); }
__device__ __forceinline__ void mask_tile(f32x16& p0, f32x16& p1, int dq, unsigned W) {
    const float NEG = -__builtin_inff();
#pragma unroll
    for (int r = 0; r < 16; ++r) { const int cc = (r & 3) + 8 * (r >> 2);
        if ((unsigned)(dq - cc) >= W) p0[r] = NEG;
        if ((unsigned)(dq - cc - 32) >= W) p1[r] = NEG; }
}
__device__ __forceinline__ void softmax_tile(f32x16& p0, f32x16& p1, float& m_reg, float& l_reg, float& alpha, bf16x8& pa0, bf16x8& pa1, bf16x8& pa2, bf16x8& pa3) {
    float pmax = p0[0];
#pragma unroll
    for (int r = 1; r < 16; ++r) pmax = fmaxf(pmax, p0[r]);
#pragma unroll
    for (int r = 0; r < 16; ++r) pmax = fmaxf(pmax, p1[r]);
    { auto rr = __builtin_amdgcn_permlane32_swap(__float_as_uint(pmax), __float_as_uint(pmax), false, false); pmax = fmaxf(__uint_as_float(rr[0]), __uint_as_float(rr[1])); }
    const float mn = fmaxf(m_reg, pmax);
    alpha = __builtin_amdgcn_exp2f(m_reg - mn); m_reg = mn;
#pragma unroll
    for (int r = 0; r < 16; ++r) { p0[r] = __builtin_amdgcn_exp2f(p0[r] - mn); p1[r] = __builtin_amdgcn_exp2f(p1[r] - mn); }
    float ps = 0.f;
#pragma unroll
    for (int r = 0; r < 16; ++r) ps += p0[r];
#pragma unroll
    for (int r = 0; r < 16; ++r) ps += p1[r];
    { auto rr = __builtin_amdgcn_permlane32_swap(__float_as_uint(ps), __float_as_uint(ps), false, false); ps = __uint_as_float(rr[0]) + __uint_as_float(rr[1]); }
    l_reg = l_reg * alpha + ps;
#define FA_PK4(P, B_, OUT) do { unsigned a0 = cvtpk(P[B_+0], P[B_+1]), a1 = cvtpk(P[B_+2], P[B_+3]); unsigned b0 = cvtpk(P[B_+4], P[B_+5]), b1 = cvtpk(P[B_+6], P[B_+7]); \
        auto r0 = __builtin_amdgcn_permlane32_swap(a0, b0, false, false); auto r1 = __builtin_amdgcn_permlane32_swap(a1, b1, false, false); \
        u32x4 w = {r0[0], r1[0], r0[1], r1[1]}; OUT = __builtin_bit_cast(bf16x8, w); } while (0)
    FA_PK4(p0, 0, pa0); FA_PK4(p0, 8, pa1); FA_PK4(p1, 0, pa2); FA_PK4(p1, 8, pa3);
#undef FA_PK4
}
__device__ __forceinline__ void pack_p(const f32x16& p0, const f32x16& p1, bf16x8& pa0, bf16x8& pa1, bf16x8& pa2, bf16x8& pa3) {
#define FA_PK4(P, B_, OUT) do { unsigned a0 = cvtpk(P[B_+0], P[B_+1]), a1 = cvtpk(P[B_+2], P[B_+3]); unsigned b0 = cvtpk(P[B_+4], P[B_+5]), b1 = cvtpk(P[B_+6], P[B_+7]); \
        auto r0 = __builtin_amdgcn_permlane32_swap(a0, b0, false, false); auto r1 = __builtin_amdgcn_permlane32_swap(a1, b1, false, false); \
        u32x4 w = {r0[0], r1[0], r0[1], r1[1]}; OUT = __builtin_bit_cast(bf16x8, w); } while (0)
    FA_PK4(p0, 0, pa0); FA_PK4(p0, 8, pa1); FA_PK4(p1, 0, pa2); FA_PK4(p1, 8, pa3);
#undef FA_PK4
}
template <int ND0, int KROW>
__device__ __forceinline__ void qkt(f32x16& p0, f32x16& p1, const LAS unsigned char* kp, const bf16x8* qr) {
    p0 = f32x16{}; p1 = f32x16{};
#pragma unroll
    for (int d0 = 0; d0 < ND0; ++d0) {
        const bf16x8 b0 = *(const LAS bf16x8*)(kp + d0 * 32);
        const bf16x8 b1 = *(const LAS bf16x8*)(kp + 32 * KROW + d0 * 32);
        p0 = __builtin_amdgcn_mfma_f32_32x32x16_bf16(b0, qr[d0], p0, 0, 0, 0);
        p1 = __builtin_amdgcn_mfma_f32_32x32x16_bf16(b1, qr[d0], p1, 0, 0, 0);
    }
}
#define FA_TRRD(dst, off) asm volatile("ds_read_b64_tr_b16 %0, %1 offset:%2" : "=&v"(dst) : "v"(vb), "i"(off) : "memory")
template <int NCB, int D0>
__device__ __forceinline__ void pv_d0(f32x16* o, int vb, bf16x8 pa0, bf16x8 pa1, bf16x8 pa2, bf16x8 pa3) {
    s16x4 l0, l1, l2, l3, h0, h1, h2, h3; constexpr int b_ = D0 * 512, HS = NCB * 512, KS = 2 * NCB * 512;
    FA_TRRD(l0, b_); FA_TRRD(h0, b_ + HS); FA_TRRD(l1, b_ + KS); FA_TRRD(h1, b_ + KS + HS); FA_TRRD(l2, b_ + 2 * KS); FA_TRRD(h2, b_ + 2 * KS + HS); FA_TRRD(l3, b_ + 3 * KS); FA_TRRD(h3, b_ + 3 * KS + HS);
    asm volatile("s_waitcnt lgkmcnt(0)" ::: "memory"); FA_SBAR();
    o[D0] = __builtin_amdgcn_mfma_f32_32x32x16_bf16(pa0, (bf16x8){l0[0], l0[1], l0[2], l0[3], h0[0], h0[1], h0[2], h0[3]}, o[D0], 0, 0, 0);
    o[D0] = __builtin_amdgcn_mfma_f32_32x32x16_bf16(pa1, (bf16x8){l1[0], l1[1], l1[2], l1[3], h1[0], h1[1], h1[2], h1[3]}, o[D0], 0, 0, 0);
    o[D0] = __builtin_amdgcn_mfma_f32_32x32x16_bf16(pa2, (bf16x8){l2[0], l2[1], l2[2], l2[3], h2[0], h2[1], h2[2], h2[3]}, o[D0], 0, 0, 0);
    o[D0] = __builtin_amdgcn_mfma_f32_32x32x16_bf16(pa3, (bf16x8){l3[0], l3[1], l3[2], l3[3], h3[0], h3[1], h3[2], h3[3]}, o[D0], 0, 0, 0);
}
template <int NCB>
__device__ __forceinline__ void rescale_o(f32x16* o, float alpha, LAS float* al, int r32, int hi) {
    if (__any(alpha < 1.f)) {
        if (hi == 0) al[r32] = alpha;
        asm volatile("s_waitcnt lgkmcnt(0)" ::: "memory");
        float f[16]; const LAS float* alh = al + 4 * hi;
#pragma unroll
        for (int r = 0; r < 16; ++r) f[r] = alh[(r & 3) + 8 * (r >> 2)];
#pragma unroll
        for (int d = 0; d < NCB; ++d)
#pragma unroll
            for (int r = 0; r < 16; ++r) o[d][r] *= f[r];
    }
}
}

namespace mla {
constexpr int KROW = 400, KBUF = 64 * KROW, VBUF = 64 * 128 * 2;
constexpr int L_K = 0, L_V = 2 * KBUF, L_AL = L_V + 2 * VBUF, L_END = L_AL + 8 * 64 * 4;
using namespace fa;
__device__ __forceinline__ void unit(const Ctx& c, unsigned char* lds, int b, int h, int qb) {
    const int tid = threadIdx.x, lane = tid & 63, r32 = lane & 31, hi = lane >> 5; const int wid = __builtin_amdgcn_readfirstlane(tid >> 6);
    LAS unsigned char* L = (LAS unsigned char*)lds;
    const size_t rowbase = (size_t)b * SEQ; const int q0 = qb * 256;
    bf16x8 qr[12];
    { const bf16_t* qrow = c.Q1 + (rowbase + q0 + wid * 32 + r32) * 1536 + h * 192 + hi * 8;
#pragma unroll
      for (int d0 = 0; d0 < 12; ++d0) qr[d0] = *(const bf16x8*)(qrow + d0 * 16); }
    const bf16_t* kvb = c.KV1 + rowbase * 2048 + h * 256; const bf16_t* kpb = c.KPE + rowbase * 64;
    const unsigned koff = (unsigned)((tid >> 4) * 2048 + (tid & 15) * 8), kpoff = (unsigned)((tid >> 3) * 64 + (tid & 7) * 8);
    const int kw0 = (tid >> 4) * KROW + (tid & 15) * 16, kpw = (tid >> 3) * KROW + 256 + (tid & 7) * 16;
    const int vw0 = v_st<4>(tid >> 4, (tid & 15) * 8), vw1 = v_st<4>(32 + (tid >> 4), (tid & 15) * 8);
    u32x4 sk0, sk1, skp, sv0, sv1;
#define MLA_LOAD(j) do { const bf16_t* kn_ = kvb + (size_t)(j) * 64 * 2048; sk0 = *(const u32x4*)(kn_ + koff); sk1 = *(const u32x4*)(kn_ + koff + 32 * 2048); sv0 = *(const u32x4*)(kn_ + koff + 128); sv1 = *(const u32x4*)(kn_ + koff + 32 * 2048 + 128); \
        skp = *(const u32x4*)(kpb + (size_t)(j) * 64 * 64 + kpoff); } while (0)
#define MLA_WRITE(B) do { *(LAS u32x4*)(L + L_K + (B) * KBUF + kw0) = sk0; *(LAS u32x4*)(L + L_K + (B) * KBUF + kw0 + 32 * KROW) = sk1; *(LAS u32x4*)(L + L_K + (B) * KBUF + kpw) = skp; \
        *(LAS u32x4*)(L + L_V + (B) * VBUF + vw0) = sv0; *(LAS u32x4*)(L + L_V + (B) * VBUF + vw1) = sv1; } while (0)
    const LAS unsigned char* kp0 = L + L_K + r32 * KROW + hi * 16;
    const int vb0 = (int)(uintptr_t)lds + L_V + v_rd_base(lane);
    LAS float* al = (LAS float*)(L + L_AL) + wid * 64;
    const int NT = 4 * qb + 4;
    const int qm = q0 + wid * 32 + r32 - 4 * hi;
    float m_reg = -1e30f, l_reg = 0.f; f32x16 o[4] = {};
    MLA_LOAD(0); MLA_WRITE(0); __syncthreads();
#define MLA_STEP(t, B) do { \
        if ((t) + 1 < NT) MLA_LOAD((t) + 1); \
        f32x16 p0, p1; qkt<12, KROW>(p0, p1, kp0 + (B) * KBUF, qr); \
        if ((t) >= NT - 4) mask_tile(p0, p1, qm - 64 * (t), 0x7fffffffu); \
        float alpha; bf16x8 pa0, pa1, pa2, pa3; softmax_tile(p0, p1, m_reg, l_reg, alpha, pa0, pa1, pa2, pa3); \
        rescale_o<4>(o, alpha, al, r32, hi); \
        { const int vb = vb0 + (B) * VBUF; pv_d0<4, 0>(o, vb, pa0, pa1, pa2, pa3); pv_d0<4, 1>(o, vb, pa0, pa1, pa2, pa3); pv_d0<4, 2>(o, vb, pa0, pa1, pa2, pa3); pv_d0<4, 3>(o, vb, pa0, pa1, pa2, pa3); } \
        if ((t) + 1 < NT) MLA_WRITE((B) ^ 1); \
        __syncthreads(); } while (0)
    for (int t = 0; t < NT; t += 2) { MLA_STEP(t, 0); MLA_STEP(t + 1, 1); }
#undef MLA_STEP
#undef MLA_LOAD
#undef MLA_WRITE
    if (hi == 0) al[r32] = l_reg;
    asm volatile("s_waitcnt lgkmcnt(0)" ::: "memory");
    const size_t orow0 = rowbase + q0 + wid * 32;
    const LAS float* alh = al + 4 * hi;
    const bf16_t* gp0 = c.PC + (orow0 + 4 * hi) * PC_LD + PC_G + h * 128 + r32; bf16_t* op0 = c.O1 + (orow0 + 4 * hi) * DM + h * 128 + r32;
#pragma unroll
    for (int dh = 0; dh < 2; ++dh) {
        float gv[2][16];
#pragma unroll
        for (int r = 0; r < 16; ++r) { const int rc = (r & 3) + 8 * (r >> 2); const bf16_t* gp = gp0 + rc * PC_LD + dh * 64; gv[0][r] = bf2f(gp[0]); gv[1][r] = bf2f(gp[32]); }
#pragma unroll
        for (int r = 0; r < 16; ++r) { const int rc = (r & 3) + 8 * (r >> 2); const float rl = 1.f / alh[rc]; bf16_t* op = op0 + rc * DM + dh * 64;
#pragma unroll
            for (int d1 = 0; d1 < 2; ++d1) { const float v = o[dh * 2 + d1][r] * rl * siluf(gv[d1][r]); const float vn = __shfl_xor(v, 1);
                if ((r32 & 1) == 0) *(unsigned*)(op + d1 * 32) = cvtpk(v, vn); } }
    }
    __syncthreads();
}
__device__ __forceinline__ void phase(const Ctx& c, unsigned char* lds) {
    const int G = gridDim.x, bx = blockIdx.x; const int vcu = (G % 8 == 0) ? (bx % 8) * (G / 8) + bx / 8 : bx;
    for (int item = vcu; item < 256; item += G) {
        const int bh = item >> 2, s_ = item & 3;
#pragma unroll 1
        for (int i = 0; i < 4; ++i) { const int qb = (i == 0) ? s_ : (i == 1) ? 7 - s_ : (i == 2) ? 8 + s_ : 15 - s_; unit(c, lds, bh >> 3, bh & 7, qb); }
    }
}
}

namespace nsa {
using namespace fa;
constexpr int KROW = 144, KBUF = 64 * KROW, VBUF = 64 * 64 * 2;
constexpr int L_K = 0, L_V = 4 * KBUF, L_AL = L_V + 4 * VBUF, L_IMP = L_AL + 8 * 64 * 4, L_SEL = L_IMP + 64 * 64 * 4, L_UNI = L_SEL + 64 * 8, L_END = L_UNI + 64;
#define NSA_QK(st) f32x16 p0, p1; qkt<4, KROW>(p0, p1, kp0 + (st) * KBUF, qr)
#define NSA_SM() float alpha; bf16x8 pa0, pa1, pa2, pa3; softmax_tile(p0, p1, m_reg, l_reg, alpha, pa0, pa1, pa2, pa3)
#define NSA_PV(st) do { rescale_o<2>(o, alpha, al, r32, hi); const int vb = vb0 + (st) * VBUF; pv_d0<2, 0>(o, vb, pa0, pa1, pa2, pa3); pv_d0<2, 1>(o, vb, pa0, pa1, pa2, pa3); } while (0)
#define NSA_LOAD(kptr, vptr) do { sk = *(const u32x4*)(kptr); sv = *(const u32x4*)(vptr); } while (0)
#define NSA_WRITE(st) do { *(LAS u32x4*)(L + L_K + (st) * KBUF + kw) = sk; *(LAS u32x4*)(L + L_V + (st) * VBUF + vw) = sv; } while (0)
#define NSA_FOLD(FIRST, fval) do { if (hi == 0) al[r32] = (fval); asm volatile("s_waitcnt lgkmcnt(0)" ::: "memory"); \
        _Pragma("unroll") for (int r = 0; r < 16; ++r) { const float ff = alh[(r & 3) + 8 * (r >> 2)]; \
            if (FIRST) { ot[0][r] = o[0][r] * ff; ot[1][r] = o[1][r] * ff; } else { ot[0][r] += o[0][r] * ff; ot[1][r] += o[1][r] * ff; } } } while (0)

__device__ __forceinline__ void unit(const Ctx& c, unsigned char* lds, int b, int g, int qt) {
    int tid_ = threadIdx.x; asm volatile("" : "+v"(tid_));
    const int tid = tid_, lane = tid & 63, r32 = lane & 31, hi = lane >> 5; const int wid = __builtin_amdgcn_readfirstlane(tid >> 6);
    LAS unsigned char* L = (LAS unsigned char*)lds;
    const size_t rowbase = (size_t)b * SEQ; const int t0 = qt * 64;
    const int hh = r32 >> 3, qi = 8 * wid + (r32 & 7), head = g * 4 + hh; const int tq = t0 + qi;
    const bf16_t* parow = c.PA + (rowbase + tq) * PA_LD;
    bf16x8 qr[4];
#pragma unroll
    for (int d0 = 0; d0 < 4; ++d0) qr[d0] = *(const bf16x8*)(parow + PA_Q + head * 64 + d0 * 16 + hi * 8);
    const float g_c = sigmoidf_(bf2f(parow[PA_GL + head * 3 + 0])), g_s = sigmoidf_(bf2f(parow[PA_GL + head * 3 + 1])), g_w = sigmoidf_(bf2f(parow[PA_GL + head * 3 + 2]));
    const int skey = tid >> 3, sch = tid & 7;
    const int kw = skey * KROW + sch * 16, vw = v_st<2>(skey, sch * 8);
    const unsigned poff = (unsigned)(skey * PA_LD + sch * 8), coff = (unsigned)(skey * 64 + sch * 8);
    const bf16_t* pab = c.PA + rowbase * PA_LD;
    u32x4 sk, sv;
    const LAS unsigned char* kp0 = L + L_K + r32 * KROW + hi * 16;
    const int vb0 = (int)(uintptr_t)lds + L_V + v_rd_base(lane);
    LAS float* al = (LAS float*)(L + L_AL) + wid * 64; const LAS float* alh = al + 4 * hi;
    LAS float* IMP = (LAS float*)(L + L_IMP); LAS unsigned* SEL = (LAS unsigned*)(L + L_SEL); LAS unsigned* UNI = (LAS unsigned*)(L + L_UNI);
    f32x16 o[2], ot[2];
    float m_reg, l_reg;

    {   const int NTc = (qt >> 4) + 1;
        const bf16_t* kcb = c.KCMP + (size_t)(b * 2 + g) * 256 * 64; const bf16_t* vcb = c.VCMP + (size_t)(b * 2 + g) * 256 * 64;
        const int cl = (tq - 31) >> 4;
#pragma unroll
        for (int jt = 0; jt < 4; ++jt) if (jt < NTc) { NSA_LOAD(kcb + jt * 4096 + coff, vcb + jt * 4096 + coff); NSA_WRITE(jt); }
        __syncthreads();
        float m_c = -1e30f, l_c = 0.f;
#pragma unroll
        for (int jt = 0; jt < 4; ++jt) if (jt < NTc) {
            NSA_QK(jt);
            mask_tile(p0, p1, cl - 64 * jt - 4 * hi, 0x7fffffffu);
            float pmax = p0[0];
#pragma unroll
            for (int r = 1; r < 16; ++r) pmax = fmaxf(pmax, p0[r]);
#pragma unroll
            for (int r = 0; r < 16; ++r) pmax = fmaxf(pmax, p1[r]);
            { auto rr = __builtin_amdgcn_permlane32_swap(__float_as_uint(pmax), __float_as_uint(pmax), false, false); pmax = fmaxf(__uint_as_float(rr[0]), __uint_as_float(rr[1])); }
            const float mn = fmaxf(m_c, pmax);
            float ps = 0.f;
#pragma unroll
            for (int r = 0; r < 16; ++r) ps += __builtin_amdgcn_exp2f(p0[r] - mn) + __builtin_amdgcn_exp2f(p1[r] - mn);
            { auto rr = __builtin_amdgcn_permlane32_swap(__float_as_uint(ps), __float_as_uint(ps), false, false); ps = __uint_as_float(rr[0]) + __uint_as_float(rr[1]); }
            l_c = l_c * __builtin_amdgcn_exp2f(m_c - mn) + ps; m_c = mn;
        }
        const float inv = l_c > 0.f ? 1.f / l_c : 0.f;
        float carry = 0.f;
        o[0] = f32x16{}; o[1] = f32x16{};
#pragma unroll
        for (int jt = 0; jt < 4; ++jt) if (jt < NTc) {
            NSA_QK(jt);
            mask_tile(p0, p1, cl - 64 * jt - 4 * hi, 0x7fffffffu);
#pragma unroll
            for (int r = 0; r < 16; ++r) { p0[r] = __builtin_amdgcn_exp2f(p0[r] - m_c) * inv; p1[r] = __builtin_amdgcn_exp2f(p1[r] - m_c) * inv; }
            float x0[4], x1[4];
#pragma unroll
            for (int j = 0; j < 4; ++j) {
                { const unsigned e = __float_as_uint(p0[4 * j + 3]); auto rr = __builtin_amdgcn_permlane32_swap(e, e, false, false); x0[j] = __uint_as_float(hi ? rr[0] : rr[1]); }
                { const unsigned e = __float_as_uint(p1[4 * j + 3]); auto rr = __builtin_amdgcn_permlane32_swap(e, e, false, false); x1[j] = __uint_as_float(hi ? rr[0] : rr[1]); } }
#pragma unroll
            for (int j = 0; j < 4; ++j) {
                const float g0 = (p0[4 * j] + p0[4 * j + 1]) + (p0[4 * j + 2] + p0[4 * j + 3]);
                const float g1 = (p1[4 * j] + p1[4 * j + 1]) + (p1[4 * j + 2] + p1[4 * j + 3]);
                const float e0 = hi ? x0[j] : (j > 0 ? x0[j > 0 ? j - 1 : 0] : carry);
                const float e1 = hi ? x1[j] : (j > 0 ? x1[j > 0 ? j - 1 : 0] : x0[3]);
                float v0 = g0 + e0, v1 = g1 + e1;
                v0 += __shfl_xor(v0, 8); v0 += __shfl_xor(v0, 16); v1 += __shfl_xor(v1, 8); v1 += __shfl_xor(v1, 16);
                if (r32 < 8) { IMP[qi * 64 + 16 * jt + 2 * j + hi] = v0; IMP[qi * 64 + 16 * jt + 8 + 2 * j + hi] = v1; } }
            carry = x1[3];
            bf16x8 pa0, pa1, pa2, pa3; pack_p(p0, p1, pa0, pa1, pa2, pa3);
            const int vb = vb0 + jt * VBUF; pv_d0<2, 0>(o, vb, pa0, pa1, pa2, pa3); pv_d0<2, 1>(o, vb, pa0, pa1, pa2, pa3);
        }
        NSA_FOLD(true, g_c);
    }
    __syncthreads();
    {   const int q_ = tid >> 3, sub = tid & 7;
        unsigned bits = 0u;
        if (qt < 16) { for (int e = 0; e < 8; ++e) if (sub * 8 + e <= qt) bits |= 1u << e; }
        else {
            float sc[8]; int rank[8];
#pragma unroll
            for (int e = 0; e < 8; ++e) { const int n = sub * 8 + e; const bool forced = (n == 0) || (n == qt) || (n == qt - 1); sc[e] = (n > qt) ? -1.f : (forced ? 1e4f : IMP[q_ * 64 + n]); rank[e] = 0; }
            for (int m2 = 0; m2 <= qt; ++m2) {
                const bool forced = (m2 == 0) || (m2 == qt) || (m2 == qt - 1); const float sm = forced ? 1e4f : IMP[q_ * 64 + m2];
#pragma unroll
                for (int e = 0; e < 8; ++e) rank[e] += (sm > sc[e] || (sm == sc[e] && m2 < sub * 8 + e)) ? 1 : 0;
            }
#pragma unroll
            for (int e = 0; e < 8; ++e) if (sub * 8 + e <= qt && rank[e] < 16) bits |= 1u << e;
        }
        unsigned lo = (sub < 4) ? (bits << (8 * sub)) : 0u, hi32 = (sub >= 4) ? (bits << (8 * (sub - 4))) : 0u;
        lo |= __shfl_xor(lo, 1); hi32 |= __shfl_xor(hi32, 1); lo |= __shfl_xor(lo, 2); hi32 |= __shfl_xor(hi32, 2); lo |= __shfl_xor(lo, 4); hi32 |= __shfl_xor(hi32, 4);
        if (sub == 0) { SEL[q_ * 2] = lo; SEL[q_ * 2 + 1] = hi32; }
        lo |= __shfl_xor(lo, 8); hi32 |= __shfl_xor(hi32, 8); lo |= __shfl_xor(lo, 16); hi32 |= __shfl_xor(hi32, 16); lo |= __shfl_xor(lo, 32); hi32 |= __shfl_xor(hi32, 32);
        if (lane == 0) { UNI[wid * 2] = lo; UNI[wid * 2 + 1] = hi32; }
    }
    __syncthreads();
    unsigned long long uni = 0ull;
#pragma unroll
    for (int w2 = 0; w2 < 8; ++w2) uni |= (unsigned long long)UNI[w2 * 2] | ((unsigned long long)UNI[w2 * 2 + 1] << 32);
    uni = ((unsigned long long)__builtin_amdgcn_readfirstlane((unsigned)(uni >> 32)) << 32) | (unsigned long long)__builtin_amdgcn_readfirstlane((unsigned)uni);
    const unsigned long long selm = (unsigned long long)SEL[qi * 2] | ((unsigned long long)SEL[qi * 2 + 1] << 32);

    {   m_reg = -1e30f; l_reg = 0.f; o[0] = f32x16{}; o[1] = f32x16{};
        unsigned long long rem = uni;
        int cur = __builtin_ctzll(rem); rem &= rem - 1; int st = 0;
        NSA_LOAD(pab + (size_t)cur * 64 * PA_LD + PA_KS + g * 64 + poff, pab + (size_t)cur * 64 * PA_LD + PA_VS + g * 64 + poff); NSA_WRITE(0); __syncthreads();
        for (;;) {
            const bool more = rem != 0ull; int nxt = 0;
            if (more) { nxt = __builtin_ctzll(rem); rem &= rem - 1; NSA_LOAD(pab + (size_t)nxt * 64 * PA_LD + PA_KS + g * 64 + poff, pab + (size_t)nxt * 64 * PA_LD + PA_VS + g * 64 + poff); }
            const bool on = ((selm >> cur) & 1ull) != 0ull;
            {   NSA_QK(st);
                if (cur == qt) mask_tile(p0, p1, qi - 4 * hi, 0x7fffffffu);
                if (!on) { const float NEG = -__builtin_inff();
#pragma unroll
                    for (int r = 0; r < 16; ++r) { p0[r] = NEG; p1[r] = NEG; } }
                NSA_SM();
                NSA_PV(st);
            }
            if (more) NSA_WRITE(st ^ 1);
            __syncthreads();
            if (!more) break;
            cur = nxt; st ^= 1;
        }
        NSA_FOLD(false, g_s / l_reg);
    }
    {   m_reg = -1e30f; l_reg = 0.f; o[0] = f32x16{}; o[1] = f32x16{};
        const int j0 = qt >= 8 ? 0 : 8 - qt;
        const bf16_t* wb = pab + (ptrdiff_t)(t0 - 512) * PA_LD;
        int st = 0;
        NSA_LOAD(wb + (ptrdiff_t)j0 * 64 * PA_LD + PA_KW + g * 64 + poff, wb + (ptrdiff_t)j0 * 64 * PA_LD + PA_VW + g * 64 + poff); NSA_WRITE(0); __syncthreads();
        for (int j = j0; j < 9; ++j) {
            if (j + 1 < 9) NSA_LOAD(wb + (ptrdiff_t)(j + 1) * 64 * PA_LD + PA_KW + g * 64 + poff, wb + (ptrdiff_t)(j + 1) * 64 * PA_LD + PA_VW + g * 64 + poff);
            {   NSA_QK(st);
                if (j == 0 || j == 8) mask_tile(p0, p1, qi + 512 - 64 * j - 4 * hi, 512u);
                NSA_SM();
                NSA_PV(st);
            }
            if (j + 1 < 9) NSA_WRITE(st ^ 1);
            __syncthreads();
            st ^= 1;
        }
        NSA_FOLD(false, g_w / l_reg);
    }
    {
        float gv[2][16];
#pragma unroll
        for (int r = 0; r < 16; ++r) { const int row = (r & 3) + 8 * (r >> 2) + 4 * hi; const int hd = g * 4 + (row >> 3); const size_t m = rowbase + t0 + 8 * wid + (row & 7);
            const bf16_t* gp = c.PA + m * PA_LD + PA_GA + hd * 64 + r32; gv[0][r] = bf2f(gp[0]); gv[1][r] = bf2f(gp[32]); }
#pragma unroll
        for (int r = 0; r < 16; ++r) { const int row = (r & 3) + 8 * (r >> 2) + 4 * hi; const int hd = g * 4 + (row >> 3); const size_t m = rowbase + t0 + 8 * wid + (row & 7);
            bf16_t* op = c.MIX + m * DM + hd * 64 + r32;
#pragma unroll
            for (int d0 = 0; d0 < 2; ++d0) { const float v = ot[d0][r] * siluf(gv[d0][r]); const float vn = __shfl_xor(v, 1);
                if ((r32 & 1) == 0) *(unsigned*)(op + d0 * 32) = cvtpk(v, vn); } }
    }
    __syncthreads();
}
#undef NSA_QK
#undef NSA_SM
#undef NSA_PV
#undef NSA_LOAD
#undef NSA_WRITE
#undef NSA_FOLD
__device__ __forceinline__ void phase(const Ctx& c, unsigned char* lds) {
    const int G = gridDim.x, bx = blockIdx.x; const int vcu = (G % 8 == 0) ? (bx % 8) * (G / 8) + bx / 8 : bx;
    for (int item = vcu; item < 256; item += G) {
        const int bg = item >> 4, s_ = item & 15;
#pragma unroll 1
        for (int i = 0; i < 4; ++i) { const int qt = (i == 0) ? s_ : (i == 1) ? 63 - s_ : (i == 2) ? 16 + s_ : 47 - s_; unit(c, lds, bg >> 1, bg & 1, qt); }
    }
}
}

__device__ __forceinline__ int natA(int p) {
    if (p < 768) { const int T = p >> 8, q = p & 255, half = q >> 7, hh = (q & 127) >> 5, i = q & 31;
        const int base = (T == 0) ? 64 * hh : (T == 1) ? 256 + 64 * hh : (hh < 2 ? 768 + 64 * hh : 1024 + 64 * (hh - 2));
        return base + 32 * half + i; }
    if (p < 1024) return 512 + (p - 768);
    if (p < 1152) return 896 + (p - 1024);
    if (p < 1280) return p;
    if (p < 3840) return p + 24;
    if (p < 3864) return 1280 + (p - 3840);
    return -1;
}
__device__ __forceinline__ int natC(int p) { return p < 512 ? p : (p < 1536 ? p + 64 : (p < 1600 ? 512 + (p - 1536) : -1)); }
__device__ __forceinline__ unsigned pk2(float lo, float hi) { return (unsigned)f2bf(lo) | ((unsigned)f2bf(hi) << 16); }
template <int MAP>
__device__ __forceinline__ void transpose_item(const float* W, int K, int Nsrc, int Ndst, bf16_t* WT, float* scr, int item, int lane) {
    const int nblk = Ndst / 32, kb = item / nblk, nb = item % nblk, k0 = 64 * kb, p0 = 32 * nb;
    const int p = p0 + (lane & 31);
    const int sc = (MAP == 0) ? natA(p) : (MAP == 1) ? natC(p) : p;
#pragma unroll 8
    for (int i = 0; i < 32; ++i) { const int kk = 2 * i + (lane >> 5); scr[kk * 33 + (lane & 31)] = (sc >= 0) ? W[(size_t)(k0 + kk) * Nsrc + sc] : 0.f; }
    WSYNC();
    const int c = lane & 7;
#pragma unroll
    for (int j = 0; j < 4; ++j) { const int n = (lane >> 3) + 8 * j; const float* sp = scr + (8 * c) * 33 + n;
        uint4 o; o.x = pk2(sp[0 * 33], sp[1 * 33]); o.y = pk2(sp[2 * 33], sp[3 * 33]); o.z = pk2(sp[4 * 33], sp[5 * 33]); o.w = pk2(sp[6 * 33], sp[7 * 33]);
        *(uint4*)(WT + (size_t)(p0 + n) * K + k0 + 8 * c) = o; }
    WSYNC();
}
__device__ __forceinline__ void ph0_weights(const Ctx& c, unsigned char* lds) {
    const int lane = threadIdx.x & 63, wave = threadIdx.x >> 6;
    float* scr = (float*)(lds + wave * 16384);
    const int gw = blockIdx.x * NWV + wave, NGW = gridDim.x * NWV;
    constexpr int I_A = 16 * 128, I_OA = 16 * 32, I_C = 16 * 56, I_UQ = 4 * 48, I_UKV = 4 * 64, I_OC = 16 * 32;
    constexpr int NITEMS = I_A + I_OA + I_C + I_UQ + I_UKV + I_OC;
    for (int it = gw; it < NITEMS; it += NGW) {
        int r = it;
        if (r < I_A) { transpose_item<0>(c.a_w_in, 1024, NIN_A, 4096, (bf16_t*)(c.ws + WS_WTA), scr, r, lane); continue; } r -= I_A;
        if (r < I_OA) { transpose_item<2>(c.a_w_out, 1024, 1024, 1024, (bf16_t*)(c.ws + WS_WTOA), scr, r, lane); continue; } r -= I_OA;
        if (r < I_C) { transpose_item<1>(c.c_w_in, 1024, NIN_C, 1792, (bf16_t*)(c.ws + WS_WTC), scr, r, lane); continue; } r -= I_C;
        if (r < I_UQ) { transpose_item<2>(c.w_uq, 256, 1536, 1536, (bf16_t*)(c.ws + WS_WTUQ), scr, r, lane); continue; } r -= I_UQ;
        if (r < I_UKV) { transpose_item<2>(c.w_ukv, 256, 2048, 2048, (bf16_t*)(c.ws + WS_WTUKV), scr, r, lane); continue; } r -= I_UKV;
        transpose_item<2>(c.c_w_out, 1024, 1024, 1024, (bf16_t*)(c.ws + WS_WTOC), scr, r, lane);
    }
}

__device__ __forceinline__ void ph0_prologue(const Ctx& c) {
    for (int idx = blockIdx.x * NTHR + threadIdx.x; idx < M * 32; idx += gridDim.x * NTHR) {
        const int m = idx >> 5, i = idx & 31;
        const float invf = (float)exp2(-(double)i * (13.287712379549449 / 32.0));
        const float ang = (float)c.pos[m] * invf;
        float s, co; sincos_acc(ang, s, co);
        c.CS[idx] = make_float2(co, s);
    }
    const int lane = threadIdx.x & 63, gw = blockIdx.x * NWV + (threadIdx.x >> 6), NGW = gridDim.x * NWV;
    for (int m = gw; m < M; m += NGW) rms_row_f32(c.x + (size_t)m * DM, c.a_norm, c.XN + (size_t)m * DM, lane);
}
__device__ __forceinline__ int pa_col(int n) { return n < 1280 ? n : (n < 1304 ? PA_GL + (n - 1280) : n - 24); }
__device__ __forceinline__ int pc_col(int n) { return n < 512 ? n : (n < 576 ? PC_KR + (n - 512) : n - 64); }

__device__ __forceinline__ void ph2_rope_a(const Ctx& c) {
    for (size_t idx = (size_t)blockIdx.x * NTHR + threadIdx.x; idx < (size_t)M * 12 * 32; idx += (size_t)gridDim.x * NTHR) {
        const int i = (int)(idx & 31); const size_t r = idx >> 5; const int slot = (int)(r % 12); const int m = (int)(r / 12);
        const int base = slot < 8 ? PA_Q + slot * 64 : (slot < 10 ? PA_KS + (slot - 8) * 64 : PA_KW + (slot - 10) * 64);
        const float sc = slot < 8 ? QSCALE_A : 1.f;
        bf16_t* p = c.PA + (size_t)m * PA_LD + base + i;
        const float x1 = bf2f(p[0]), x2 = bf2f(p[32]);
        const float2 cs = c.CS[(size_t)m * 32 + i];
        p[0] = f2bf((x1 * cs.x - x2 * cs.y) * sc); p[32] = f2bf((x2 * cs.x + x1 * cs.y) * sc);
    }
}

__device__ __forceinline__ void ph3_compress(const Ctx& c, unsigned char* lds) {
    float* blk = (float*)lds;
    float* part = blk + 8 * 2048;
    float* hid = part + 4 * 8 * 128;
    float* outp = hid + 8 * 128;
    float* outs = outp + 8 * 8 * 64;
    const int tid = threadIdx.x;
    for (int item = blockIdx.x; item < 2 * BATCH * 2 * 32; item += gridDim.x) {
        const int ct = item & 31, g = (item >> 5) & 1, b = (item >> 6) & 7, kv = item >> 9;
        const float* pe = kv ? c.pe_v : c.pe_k; const float* w1 = kv ? c.w_cv1 : c.w_ck1; const float* w2 = kv ? c.w_cv2 : c.w_ck2;
        const int col0 = (kv ? PA_VC : PA_KC) + g * 64;
        __syncthreads();
        for (int e = tid; e < 8 * 2048; e += NTHR) {
            const int ci = e >> 11, k = e & 2047, l = k >> 6, d = k & 63; const int cidx = ct * 8 + ci;
            float v = 0.f;
            if (cidx < 255) v = bf2f(c.PA[(size_t)(b * SEQ + 16 * cidx + l) * PA_LD + col0 + d]) + pe[l * 64 + d];
            blk[e] = v;
        }
        __syncthreads();
        {   const int j = tid & 127, pt = tid >> 7;
            float acc[8];
#pragma unroll
            for (int ci = 0; ci < 8; ++ci) acc[ci] = 0.f;
            for (int k = pt * 512; k < pt * 512 + 512; ++k) {
                const float w = w1[(size_t)k * 128 + j];
#pragma unroll
                for (int ci = 0; ci < 8; ++ci) acc[ci] = fmaf(blk[ci * 2048 + k], w, acc[ci]);
            }
#pragma unroll
            for (int ci = 0; ci < 8; ++ci) part[(pt * 8 + ci) * 128 + j] = acc[ci];
        }
        __syncthreads();
        for (int e = tid; e < 8 * 128; e += NTHR) { const int ci = e >> 7, j = e & 127; const float s = (part[(0 * 8 + ci) * 128 + j] + part[(1 * 8 + ci) * 128 + j]) + (part[(2 * 8 + ci) * 128 + j] + part[(3 * 8 + ci) * 128 + j]); hid[e] = siluf(s); }
        __syncthreads();
        {   const int d = tid & 63, pt = tid >> 6;
            float acc[8];
#pragma unroll
            for (int ci = 0; ci < 8; ++ci) acc[ci] = 0.f;
            for (int j = pt * 16; j < pt * 16 + 16; ++j) {
                const float w = w2[j * 64 + d];
#pragma unroll
                for (int ci = 0; ci < 8; ++ci) acc[ci] = fmaf(hid[ci * 128 + j], w, acc[ci]);
            }
#pragma unroll
            for (int ci = 0; ci < 8; ++ci) outp[(pt * 8 + ci) * 64 + d] = acc[ci];
        }
        __syncthreads();
        {   const int ci = tid >> 6, d = tid & 63; float s = 0.f;
#pragma unroll
            for (int pt = 0; pt < 8; ++pt) s += outp[(pt * 8 + ci) * 64 + d];
            outs[ci * 64 + d] = s; }
        __syncthreads();
        {   const int ci = tid >> 6, d = tid & 63; const int cidx = ct * 8 + ci;
            float v = outs[ci * 64 + d];
            if (kv == 0 && cidx < 255) {
                const int i = d & 31; const float2 cs = c.CS[(size_t)(b * SEQ + 16 * cidx + 31) * 32 + i];
                const float x1 = outs[ci * 64 + i], x2 = outs[ci * 64 + i + 32];
                v = (d < 32) ? (x1 * cs.x - x2 * cs.y) : (x2 * cs.x + x1 * cs.y);
            }
            if (cidx >= 255) v = 0.f;
            bf16_t* dst = (kv ? c.VCMP : c.KCMP) + ((size_t)(b * 2 + g) * 256 + cidx) * 64 + d;
            *dst = f2bf(v);
        }
    }
    __syncthreads();
}

__device__ __forceinline__ float dot64(const bf16_t* krow, const float* q) {
    float s = 0.f;
#pragma unroll
    for (int ch = 0; ch < 8; ++ch) {
        const uint4 v = *(const uint4*)(krow + ch * 8);
        const unsigned w[4] = {v.x, v.y, v.z, v.w};
#pragma unroll
        for (int e = 0; e < 4; ++e) { s = fmaf(__uint_as_float(w[e] << 16), q[ch * 8 + 2 * e], s); s = fmaf(__uint_as_float(w[e] & 0xffff0000u), q[ch * 8 + 2 * e + 1], s); }
    }
    return s;
}

__device__ __forceinline__ void ph4_nsa(const Ctx& c, unsigned char* lds) {
    const int lane = threadIdx.x & 63, wave = threadIdx.x >> 6;
    float* wq = (float*)(lds + wave * 12288);
    float* wp = wq + 64;
    float* wpc = wp + 1024;
    float* wres = wpc + 1024;
    const int gw = blockIdx.x * NWV + wave, NGW = gridDim.x * NWV;
    for (int item = gw; item < M * 2; item += NGW) {
        const int g = item & 1, m = item >> 1; const int b = m / SEQ, t = m % SEQ;
        const bf16_t* parow = c.PA + (size_t)m * PA_LD;
        const bf16_t* pab = c.PA + (size_t)b * SEQ * PA_LD;
        const bf16_t* kc = c.KCMP + (size_t)(b * 2 + g) * 256 * 64; const bf16_t* vc = c.VCMP + (size_t)(b * 2 + g) * 256 * 64;
        const int nvalid = t >= 31 ? min((t - 31) / 16 + 1, 255) : 0;
        for (int hh = 0; hh < 4; ++hh) {
            const int head = g * 4 + hh;
            WSYNC(); wq[lane] = bf2f(parow[PA_Q + head * 64 + lane]); WSYNC();
            float s[4]; float mx = -INFINITY;
#pragma unroll
            for (int jj = 0; jj < 4; ++jj) { const int ci = lane + 64 * jj; s[jj] = (ci < nvalid) ? dot64(kc + (size_t)ci * 64, wq) : -INFINITY; mx = fmaxf(mx, s[jj]); }
            mx = wave_max(mx);
            float sum = 0.f;
#pragma unroll
            for (int jj = 0; jj < 4; ++jj) { s[jj] = (nvalid > 0) ? exp2f(s[jj] - mx) : 0.f; sum += s[jj]; }
            sum = wave_sum(sum);
            const float inv = nvalid > 0 ? 1.f / sum : 0.f;
#pragma unroll
            for (int jj = 0; jj < 4; ++jj) wpc[hh * 256 + lane + 64 * jj] = s[jj] * inv;
            WSYNC();
            float o = 0.f;
            for (int ci = 0; ci < nvalid; ++ci) o = fmaf(wpc[hh * 256 + ci], bf2f(vc[(size_t)ci * 64 + lane]), o);
            wres[(hh * 3 + 0) * 64 + lane] = o;
        }
        unsigned long long selmask;
        {   const int n = lane; float imp = 0.f;
            const int c_lo = max(4 * n - 1, 0), c_hi = min(4 * n + 3, 254);
            for (int hh = 0; hh < 4; ++hh) for (int ci = c_lo; ci <= c_hi; ++ci) imp += wpc[hh * 256 + ci];
            const bool bv = (64 * n <= t); const int cur = t >> 6;
            const bool forced = (n == 0) || (n == cur) || (n == cur - 1);
            const float sc = bv ? (forced ? 1e4f : imp) : -1.f;
            int rank = 0;
            for (int mm = 0; mm < 64; ++mm) { const float o = __shfl(sc, mm); rank += (o > sc || (o == sc && mm < n)) ? 1 : 0; }
            selmask = __ballot(rank < 16 && bv);
        }
        for (int hh = 0; hh < 4; ++hh) {
            const int head = g * 4 + hh;
            WSYNC(); wq[lane] = bf2f(parow[PA_Q + head * 64 + lane]); WSYNC();
            {   unsigned long long sm = selmask; int slot = 0; float mx = -INFINITY;
                while (sm) { const int n = __builtin_ctzll(sm); sm &= sm - 1; const int tok = n * 64 + lane;
                    const float s = (tok <= t) ? dot64(pab + (size_t)tok * PA_LD + PA_KS + g * 64, wq) : -INFINITY;
                    wp[slot * 64 + lane] = s; mx = fmaxf(mx, s); ++slot; }
                mx = wave_max(mx);
                float sum = 0.f;
                for (int sl = 0; sl < slot; ++sl) { const float p = exp2f(wp[sl * 64 + lane] - mx); wp[sl * 64 + lane] = p; sum += p; }
                sum = wave_sum(sum); WSYNC();
                float o = 0.f; sm = selmask; slot = 0;
                while (sm) { const int n = __builtin_ctzll(sm); sm &= sm - 1;
                    const int kmax = min(63, t - n * 64);
                    for (int kk = 0; kk <= kmax; ++kk) o = fmaf(wp[slot * 64 + kk], bf2f(pab[(size_t)(n * 64 + kk) * PA_LD + PA_VS + g * 64 + lane]), o);
                    ++slot; }
                wres[(hh * 3 + 1) * 64 + lane] = o / sum; }
            WSYNC();
            {   float mx = -INFINITY;
                for (int j = 0; j < 8; ++j) { const int kp = t - 511 + 64 * j + lane;
                    const float s = (kp >= 0) ? dot64(pab + (size_t)kp * PA_LD + PA_KW + g * 64, wq) : -INFINITY;
                    wp[j * 64 + lane] = s; mx = fmaxf(mx, s); }
                mx = wave_max(mx);
                float sum = 0.f;
                for (int j = 0; j < 8; ++j) { const float p = exp2f(wp[j * 64 + lane] - mx); wp[j * 64 + lane] = p; sum += p; }
                sum = wave_sum(sum); WSYNC();
                float o = 0.f;
                const int k_lo = max(0, 511 - t);
                for (int kk = k_lo; kk < 512; ++kk) o = fmaf(wp[kk], bf2f(pab[(size_t)(t - 511 + kk) * PA_LD + PA_VW + g * 64 + lane]), o);
                wres[(hh * 3 + 2) * 64 + lane] = o / sum; }
        }
        for (int hh = 0; hh < 4; ++hh) {
            const int head = g * 4 + hh;
            const float g0 = sigmoidf_(bf2f(parow[PA_GL + head * 3 + 0])), g1 = sigmoidf_(bf2f(parow[PA_GL + head * 3 + 1])), g2 = sigmoidf_(bf2f(parow[PA_GL + head * 3 + 2]));
            const float o = g0 * wres[(hh * 3 + 0) * 64 + lane] + g1 * wres[(hh * 3 + 1) * 64 + lane] + g2 * wres[(hh * 3 + 2) * 64 + lane];
            const float ga = bf2f(parow[PA_GA + head * 64 + lane]);
            c.MIX[(size_t)m * DM + head * 64 + lane] = f2bf(siluf(ga) * o);
        }
    }
}

__device__ __forceinline__ void ph5_conv(const Ctx& c) {
    for (size_t idx = (size_t)blockIdx.x * NTHR + threadIdx.x; idx < (size_t)M * 512; idx += (size_t)gridDim.x * NTHR) {
        const int ch = (int)(idx & 511); const int m = (int)(idx >> 9); const int t = m % SEQ;
        const bf16_t* r0 = c.PA + (size_t)m * PA_LD;
        float y = c.conv_w[2 * 512 + ch] * bf2f(r0[PA_CC + ch]) * bf2f(r0[PA_CH + ch]);
        if (t >= 1) { const bf16_t* r1 = r0 - PA_LD; y += c.conv_w[1 * 512 + ch] * bf2f(r1[PA_CC + ch]) * bf2f(r1[PA_CH + ch]); }
        if (t >= 2) { const bf16_t* r2 = r0 - 2 * PA_LD; y += c.conv_w[0 * 512 + ch] * bf2f(r2[PA_CC + ch]) * bf2f(r2[PA_CH + ch]); }
        c.MIX[(size_t)m * DM + 512 + ch] = f2bf(siluf(bf2f(r0[PA_GB + ch])) * bf2f(r0[PA_CB + ch]) * y);
    }
}

__device__ __forceinline__ void ph7_norm1(const Ctx& c) {
    const int lane = threadIdx.x & 63, gw = blockIdx.x * NWV + (threadIdx.x >> 6), NGW = gridDim.x * NWV;
    for (int m = gw; m < M; m += NGW) rms_row_f32(c.out + (size_t)m * DM, c.c_norm, c.XN + (size_t)m * DM, lane);
}
__device__ __forceinline__ void ph_final(const Ctx& c) {
    const int lane = threadIdx.x & 63, gw = blockIdx.x * NWV + (threadIdx.x >> 6), NGW = gridDim.x * NWV;
    for (int m = gw; m < M; m += NGW) {
        float* xr = c.out + (size_t)m * DM;
        float4 v[4]; float s = 0.f;
#pragma unroll
        for (int j = 0; j < 4; ++j) { v[j] = *(const float4*)(xr + 4 * lane + 256 * j); s += (v[j].x * v[j].x + v[j].y * v[j].y) + (v[j].z * v[j].z + v[j].w * v[j].w); }
        const float rstd = 1.f / sqrtf(wave_sum(s) * (1.f / DM) + RMS_EPS);
#pragma unroll
        for (int j = 0; j < 4; ++j) { const float4 gg = *(const float4*)(c.final_norm + 4 * lane + 256 * j);
            float4 o; o.x = v[j].x * rstd * gg.x; o.y = v[j].y * rstd * gg.y; o.z = v[j].z * rstd * gg.z; o.w = v[j].w * rstd * gg.w;
            *(float4*)(xr + 4 * lane + 256 * j) = o; }
    }
}

__device__ __forceinline__ void ph9_lat_norm(const Ctx& c) {
    const int lane = threadIdx.x & 63, gw = blockIdx.x * NWV + (threadIdx.x >> 6), NGW = gridDim.x * NWV;
    for (int m = gw; m < M; m += NGW) {
        const bf16_t* r = c.PC + (size_t)m * PC_LD;
#pragma unroll
        for (int w = 0; w < 2; ++w) {
            const ushort4 v = *(const ushort4*)(r + (w ? PC_CKV : PC_CQ) + 4 * lane);
            const float a0 = bf2f(v.x), a1 = bf2f(v.y), a2 = bf2f(v.z), a3 = bf2f(v.w);
            const float rstd = 1.f / sqrtf(wave_sum(a0 * a0 + a1 * a1 + a2 * a2 + a3 * a3) * (1.f / 256.f) + RMS_EPS);
            const float4 gg = *(const float4*)((w ? c.kv_norm : c.q_norm) + 4 * lane);
            ushort4 o; o.x = f2bf(a0 * rstd * gg.x); o.y = f2bf(a1 * rstd * gg.y); o.z = f2bf(a2 * rstd * gg.z); o.w = f2bf(a3 * rstd * gg.w);
            *(ushort4*)((w ? c.CKVN : c.CQN) + (size_t)m * 256 + 4 * lane) = o;
        }
        if (lane < 32) {
            const float x1 = bf2f(r[PC_KR + lane]), x2 = bf2f(r[PC_KR + lane + 32]); const float2 cs = c.CS[(size_t)m * 32 + lane];
            c.KPE[(size_t)m * 64 + lane] = f2bf(x1 * cs.x - x2 * cs.y); c.KPE[(size_t)m * 64 + lane + 32] = f2bf(x2 * cs.x + x1 * cs.y);
        }
    }
}
__device__ __forceinline__ void ph11_rope_q1(const Ctx& c) {
    for (size_t idx = (size_t)blockIdx.x * NTHR + threadIdx.x; idx < (size_t)M * 8 * 96; idx += (size_t)gridDim.x * NTHR) {
        const int e = (int)(idx % 96); const size_t r = idx / 96; const int h = (int)(r & 7); const int m = (int)(r >> 3);
        bf16_t* q = c.Q1 + (size_t)m * 1536 + h * 192;
        if (e < 64) { q[e] = f2bf(bf2f(q[e]) * QSCALE_C); q[e + 64] = f2bf(bf2f(q[e + 64]) * QSCALE_C); }
        else { const int i = e - 64; const float2 cs = c.CS[(size_t)m * 32 + i];
            const float x1 = bf2f(q[128 + i]), x2 = bf2f(q[160 + i]);
            q[128 + i] = f2bf((x1 * cs.x - x2 * cs.y) * QSCALE_C); q[160 + i] = f2bf((x2 * cs.x + x1 * cs.y) * QSCALE_C); }
    }
}
__device__ __forceinline__ void ph12_mla(const Ctx& c, unsigned char* lds) {
    const int lane = threadIdx.x & 63, wave = threadIdx.x >> 6;
    float* wq = (float*)(lds + wave * 2048);
    float* wp = wq + 192;
    const int gw = blockIdx.x * NWV + wave, NGW = gridDim.x * NWV;
    for (int item = gw; item < M * 8; item += NGW) {
        const int h = item & 7, m = item >> 3; const int b = m / SEQ, t = m % SEQ;
        WSYNC();
        const bf16_t* qrow = c.Q1 + (size_t)m * 1536 + h * 192;
        wq[lane] = bf2f(qrow[lane]); wq[64 + lane] = bf2f(qrow[64 + lane]); wq[128 + lane] = bf2f(qrow[128 + lane]);
        WSYNC();
        float mrun = -1e30f, l = 0.f, o0 = 0.f, o1 = 0.f;
        const bf16_t* kvb = c.KV1 + (size_t)b * SEQ * 2048 + h * 256; const bf16_t* kpb = c.KPE + (size_t)b * SEQ * 64;
        for (int k0 = 0; k0 <= t; k0 += 64) {
            const int key = k0 + lane;
            float s = -INFINITY;
            if (key <= t) { const bf16_t* kr = kvb + (size_t)key * 2048; s = dot64(kr, wq) + dot64(kr + 64, wq + 64) + dot64(kpb + (size_t)key * 64, wq + 128); }
            const float cm = wave_max(s);
            const float mn = fmaxf(mrun, cm); const float alpha = exp2f(mrun - mn); mrun = mn;
            const float p = exp2f(s - mn);
            l = l * alpha + wave_sum(p); o0 *= alpha; o1 *= alpha;
            WSYNC(); wp[lane] = p; WSYNC();
            const int kmax = min(63, t - k0);
            for (int kk = 0; kk <= kmax; ++kk) { const bf16_t* vr = kvb + (size_t)(k0 + kk) * 2048 + 128; const float pp = wp[kk]; o0 = fmaf(pp, bf2f(vr[lane]), o0); o1 = fmaf(pp, bf2f(vr[64 + lane]), o1); }
        }
        const float inv = 1.f / l;
        const bf16_t* gr = c.PC + (size_t)m * PC_LD + PC_G + h * 128;
        c.O1[(size_t)m * DM + h * 128 + lane] = f2bf(siluf(bf2f(gr[lane])) * o0 * inv);
        c.O1[(size_t)m * DM + h * 128 + 64 + lane] = f2bf(siluf(bf2f(gr[64 + lane])) * o1 * inv);
    }
}

constexpr int NPHASE = 15;
__global__ void __launch_bounds__(NTHR, 2) mk_fwd(Args a) {
    extern __shared__ __attribute__((aligned(16))) unsigned char lds[];
    Ctx c;
    c.x = (const float*)a.in[0]; c.pos = (const int*)a.in[1]; c.a_norm = (const float*)a.in[2]; c.a_w_in = (const float*)a.in[3]; c.pe_k = (const float*)a.in[4]; c.pe_v = (const float*)a.in[5];
    c.w_ck1 = (const float*)a.in[6]; c.w_ck2 = (const float*)a.in[7]; c.w_cv1 = (const float*)a.in[8]; c.w_cv2 = (const float*)a.in[9]; c.conv_w = (const float*)a.in[10]; c.a_w_out = (const float*)a.in[11];
    c.c_norm = (const float*)a.in[12]; c.c_w_in = (const float*)a.in[13]; c.q_norm = (const float*)a.in[14]; c.kv_norm = (const float*)a.in[15]; c.w_uq = (const float*)a.in[16]; c.w_ukv = (const float*)a.in[17];
    c.c_w_out = (const float*)a.in[18]; c.final_norm = (const float*)a.in[19];
    c.out = a.out; c.ws = a.ws;
    c.CS = (float2*)(a.ws + WS_CS); c.KCMP = (bf16_t*)(a.ws + WS_KCMP); c.VCMP = (bf16_t*)(a.ws + WS_VCMP); c.XN = (bf16_t*)(a.ws + WS_XN); c.PA = (bf16_t*)(a.ws + WS_PA);
    c.MIX = (bf16_t*)(a.ws + WS_MIX); c.PC = (bf16_t*)(a.ws + WS_PC); c.Q1 = (bf16_t*)(a.ws + WS_Q1); c.KV1 = (bf16_t*)(a.ws + WS_KV1); c.CQN = (bf16_t*)(a.ws + WS_CQN);
    c.CKVN = (bf16_t*)(a.ws + WS_CKVN); c.KPE = (bf16_t*)(a.ws + WS_KPE); c.O1 = (bf16_t*)(a.ws + WS_O1);

    volatile LAS unsigned* misc = (volatile LAS unsigned*)((LAS unsigned char*)lds + (LDS_BYTES - 64));
    if (threadIdx.x < 16) misc[threadIdx.x] = 0u;
    __syncthreads();
    XcdBarrier bar; bar.bar = (unsigned*)(a.ws + WS_CTL) + 4096; bar.x = 0; bar.st = misc;
    const bool multi = (a.hi - a.lo) > 1;
    if (multi) bar = xcd_barrier_post((unsigned*)(a.ws + WS_CTL) + 4096, misc);

#ifndef PROBE_DUP
#define PROBE_DUP -1
#endif
#define PHASE(k, ...) if (a.lo <= (k) && (k) < a.hi) { __VA_ARGS__; if ((k) == PROBE_DUP) { xcd_barrier(bar); __VA_ARGS__; } if ((k) + 1 < a.hi) xcd_barrier(bar); }
    LAS unsigned char* ldsl = (LAS unsigned char*)lds;
    PHASE(0, { ph0_weights(c, lds); ph0_prologue(c); })
    PHASE(1, { pg8::Gemm g{c.XN, (const bf16_t*)(c.ws + WS_WTA), M, 4096, 1024}; pg8::StaticOrder S; S.init(M, 4096, gridDim.x, blockIdx.x);
               pg8::EpiPA E{c.PA, c.CS}; pg8::gemm_phase<pg8::EpiPA, pg8::StaticOrder, true, true>(ldsl, g, S, E); })
    PHASE(3, ph3_compress(c, lds))
    PHASE(4, nsa::phase(c, lds))
    PHASE(5, ph5_conv(c))
    PHASE(6, { pg8::Gemm g{c.MIX, (const bf16_t*)(c.ws + WS_WTOA), M, 1024, 1024}; pg8::StaticOrder S; S.init(M, 1024, gridDim.x, blockIdx.x);
               pg8::EpiRes E{c.x, c.out}; pg8::gemm_phase<pg8::EpiRes, pg8::StaticOrder, true, true>(ldsl, g, S, E); })
    PHASE(7, ph7_norm1(c))
    PHASE(8, { pg8::Gemm g{c.XN, (const bf16_t*)(c.ws + WS_WTC), M, 1792, 1024}; pg8::StaticOrder S; S.init(M, 1792, gridDim.x, blockIdx.x);
               pg8::EpiPlain E{c.PC, PC_LD}; pg8::gemm_phase<pg8::EpiPlain, pg8::StaticOrder, true, true>(ldsl, g, S, E); })
    PHASE(9, ph9_lat_norm(c))
    PHASE(10, { for (int gi = 0; gi < 2; ++gi) {
                pg8::Gemm g{gi ? c.CKVN : c.CQN, (const bf16_t*)(c.ws + (gi ? WS_WTUKV : WS_WTUQ)), M, gi ? 2048 : 1536, 256}; pg8::StaticOrder S; S.init(M, gi ? 2048 : 1536, gridDim.x, blockIdx.x);
                pg8::EpiPlain E{gi ? c.KV1 : c.Q1, gi ? 2048 : 1536}; pg8::gemm_phase<pg8::EpiPlain, pg8::StaticOrder, true, true>(ldsl, g, S, E); __syncthreads(); } })
    PHASE(11, ph11_rope_q1(c))
    PHASE(12, mla::phase(c, lds))
    PHASE(13, { pg8::Gemm g{c.O1, (const bf16_t*)(c.ws + WS_WTOC), M, 1024, 1024}; pg8::StaticOrder S; S.init(M, 1024, gridDim.x, blockIdx.x);
               pg8::EpiRes E{c.out, c.out}; pg8::gemm_phase<pg8::EpiRes, pg8::StaticOrder, true, true>(ldsl, g, S, E); })
    PHASE(14, ph_final(c))
#undef PHASE
}

extern "C" void kernel_launch(void* const* d_in, const int* in_sizes, int n_in, void* d_out, int out_size, void* d_ws, size_t ws_size, hipStream_t stream) {
    static int grid = 0;
    if (grid == 0) {
        if (n_in != 20 || in_sizes[0] != M * DM || out_size != M * DM || ws_size < WS_END) {
            fprintf(stderr, "kernel_launch: unexpected shapes (n_in %d, in0 %d, out %d, ws %zu)\n", n_in, n_in > 0 ? in_sizes[0] : -1, out_size, ws_size); grid = -1; return; }
        int dev = 0, cus = 0;
        if (hipGetDevice(&dev) != hipSuccess || hipDeviceGetAttribute(&cus, hipDeviceAttributeMultiprocessorCount, dev) != hipSuccess || cus <= 0) { grid = -1; return; }
        if (hipFuncSetAttribute((const void*)mk_fwd, hipFuncAttributeMaxDynamicSharedMemorySize, LDS_BYTES) != hipSuccess) { fprintf(stderr, "kernel_launch: hipFuncSetAttribute failed\n"); grid = -1; return; }
        (void)hipGetLastError();
        grid = cus;
    }
    if (grid < 0) return;
    (void)hipMemsetAsync((char*)d_ws + WS_CTL, 0, CTL_BYTES, stream);
    Args a{};
    for (int i = 0; i < 20; ++i) a.in[i] = d_in[i];
    a.out = (float*)d_out; a.ws = (unsigned char*)d_ws;
#if MK_ONE_LAUNCH
    a.lo = 0; a.hi = NPHASE;
    hipLaunchKernelGGL(mk_fwd, dim3(grid), dim3(NTHR), LDS_BYTES, stream, a);
#else
    for (int ph = 0; ph < NPHASE; ++ph) { a.lo = ph; a.hi = ph + 1; hipLaunchKernelGGL(mk_fwd, dim3(grid), dim3(NTHR), LDS_BYTES, stream, a); }
#endif
}
```

```cpp
#include <hip/hip_runtime.h>
#include <cstdio>
#include <cstdint>
#include <cmath>

#ifndef MK_ONE_LAUNCH
#define MK_ONE_LAUNCH 1
#endif

constexpr int BATCH = 8, SEQ = 4096, DM = 1024, M = BATCH * SEQ;
constexpr int NIN_A = 3864, NIN_C = 1600;
constexpr int PA_LD = 4096;
constexpr int PC_LD = 1792;
constexpr int PA_Q = 0, PA_KC = 512, PA_VC = 640, PA_KS = 768, PA_VS = 896, PA_KW = 1024, PA_VW = 1152,
              PA_GA = 1280, PA_CB = 1792, PA_CC = 2304, PA_CH = 2816, PA_GB = 3328, PA_GL = 3840;
constexpr int PC_CQ = 0, PC_CKV = 256, PC_G = 512, PC_KR = 1536;
constexpr float LOG2E = 1.4426950408889634f;
constexpr float QSCALE_A = 0.125f * LOG2E;
constexpr float QSCALE_C = 0.07216878364870323f * LOG2E;
constexpr float RMS_EPS = 1e-6f;

constexpr size_t MiB = 1u << 20;
constexpr size_t WS_CTL = 0, CTL_BYTES = 1 * MiB;
constexpr size_t WS_CS = 1 * MiB;
constexpr size_t WS_KCMP = 9 * MiB;
constexpr size_t WS_VCMP = 9 * MiB + 512 * 1024;
constexpr size_t WS_STAT1 = 10 * MiB;
constexpr size_t WS_STAT2 = 12 * MiB;
constexpr size_t WS_WTA = 16 * MiB;
constexpr size_t WS_WTOA = 24 * MiB;
constexpr size_t WS_WTC = 26 * MiB;
constexpr size_t WS_WTUQ = 30 * MiB;
constexpr size_t WS_WTUKV = 31 * MiB;
constexpr size_t WS_WTOC = 32 * MiB;
constexpr size_t WS_XN = 48 * MiB;
constexpr size_t WS_PA = 112 * MiB;
constexpr size_t WS_MIX = 368 * MiB;
constexpr size_t WS_PC = 112 * MiB;
constexpr size_t WS_Q1 = 224 * MiB;
constexpr size_t WS_KV1 = 320 * MiB;
constexpr size_t WS_CQN = 448 * MiB;
constexpr size_t WS_CKVN = 464 * MiB;
constexpr size_t WS_KPE = 480 * MiB;
constexpr size_t WS_O1 = 48 * MiB;
constexpr size_t WS_END = 484 * MiB;

constexpr int LDS_BYTES = 147456;
constexpr int NTHR = 512, NWV = 8;

typedef unsigned short bf16_t;
#define LAS __attribute__((address_space(3)))

__device__ __forceinline__ float bf2f(bf16_t v) { return __uint_as_float(((unsigned)v) << 16); }
__device__ __forceinline__ bf16_t f2bf(float f) { unsigned u = __float_as_uint(f); return (bf16_t)((u + 0x7fffu + ((u >> 16) & 1u)) >> 16); }
__device__ __forceinline__ float wave_sum(float v) {
#pragma unroll
    for (int o = 1; o < 64; o <<= 1) v += __shfl_xor(v, o);
    return v;
}
__device__ __forceinline__ float wave_max(float v) {
#pragma unroll
    for (int o = 1; o < 64; o <<= 1) v = fmaxf(v, __shfl_xor(v, o));
    return v;
}
#define WSYNC() asm volatile("s_waitcnt lgkmcnt(0)" ::: "memory")
__device__ __forceinline__ float siluf(float x) { return x / (1.f + __expf(-x)); }
__device__ __forceinline__ float sigmoidf_(float x) { return 1.f / (1.f + __expf(-x)); }

#define XB_TMO      128
#define XB_XCNT(j)  (256  + 64 * (j))
#define XB_XSUB(j)  (1280 + 64 * (j))
#define XB_XGEN(j)  (2304 + 64 * (j))
#define XB_TOP      3328
#define XB_TOPGEN   3392
#define XCD_BAR_WORDS 3456
#define XB_SPIN_CAP (1u << 24)
__device__ __forceinline__ unsigned xb_ld(unsigned* p)              { return __hip_atomic_load(p, __ATOMIC_RELAXED, __HIP_MEMORY_SCOPE_AGENT); }
__device__ __forceinline__ unsigned xb_add(unsigned* p, unsigned v) { return __hip_atomic_fetch_add(p, v, __ATOMIC_RELAXED, __HIP_MEMORY_SCOPE_AGENT); }
__device__ __forceinline__ unsigned xb_xcc_id() { return (unsigned)__builtin_amdgcn_s_getreg((3 << 11) | 20) & 0xFu; }
#define XB_SPIN(cond, bar) do { unsigned _sp = 0; while (cond) { __builtin_amdgcn_s_sleep(1); \
    if ((++_sp & 255u) == 0u) { if (xb_ld(&(bar)[XB_TMO])) break; if (_sp > XB_SPIN_CAP) { atomicAdd(&(bar)[XB_TMO], 1u); break; } } } } while (0)
struct XcdBarrier { unsigned* bar; unsigned x; volatile LAS unsigned* st; };
__device__ __forceinline__ XcdBarrier xcd_barrier_post(unsigned* bar, volatile LAS unsigned* st) {
    XcdBarrier b; b.bar = bar; b.x = xb_xcc_id(); b.st = st;
    if (threadIdx.x == 0) (void)xb_add(&bar[XB_XCNT(b.x)], 1u);
    return b;
}
__device__ __forceinline__ void xcd_barrier_complete(unsigned* bar, unsigned x, unsigned& nloc, unsigned& nx) {
    const unsigned G = gridDim.x * gridDim.y * gridDim.z;
    unsigned sum, cnt, mine, sp = 0u;
    for (;;) {
        sum = 0u; cnt = 0u; mine = 0u;
#pragma unroll
        for (unsigned j = 0; j < 16; ++j) { const unsigned c = xb_ld(&bar[XB_XCNT(j)]); sum += c; cnt += (c > 0u) ? 1u : 0u; mine = (j == x) ? c : mine; }
        if (sum == G) break;
        __builtin_amdgcn_s_sleep(1);
        if ((++sp & 255u) == 0u) { if (xb_ld(&bar[XB_TMO])) break; if (sp > XB_SPIN_CAP) { atomicAdd(&bar[XB_TMO], 1u); break; } }
    }
    nloc = mine > 0u ? mine : 1u; nx = cnt > 0u ? cnt : 1u;
}
__device__ __forceinline__ void xcd_barrier(const XcdBarrier& b) {
    asm volatile("s_waitcnt vmcnt(0)" ::: "memory");
    __syncthreads();
    if (threadIdx.x == 0) {
        unsigned* bar = b.bar;
        __builtin_amdgcn_s_waitcnt(0);
        unsigned nloc = b.st[0], nx = b.st[1];
        if (nloc == 0u) { xcd_barrier_complete(bar, b.x, nloc, nx); b.st[0] = nloc; b.st[1] = nx; }
        const unsigned old = xb_add(&bar[XB_XSUB(b.x)], 1u);
        const unsigned gen = old / nloc;
        if (old + 1u == (gen + 1u) * nloc) {
            __builtin_amdgcn_fence(__ATOMIC_RELEASE, "agent");
            asm volatile("s_waitcnt vmcnt(0)" ::: "memory");
            const unsigned og = xb_add(&bar[XB_TOP], 1u);
            const unsigned tg = og / nx;
            if (og + 1u == (tg + 1u) * nx) xb_add(&bar[XB_TOPGEN], 1u);
            else XB_SPIN(xb_ld(&bar[XB_TOPGEN]) == tg, bar);
            __builtin_amdgcn_fence(__ATOMIC_ACQUIRE, "agent");
            xb_add(&bar[XB_XGEN(b.x)], 1u);
            asm volatile("s_waitcnt vmcnt(0)" ::: "memory");
        } else {
            XB_SPIN(xb_ld(&bar[XB_XGEN(b.x)]) == gen, bar);
            __builtin_amdgcn_fence(__ATOMIC_ACQUIRE, "agent");
            asm volatile("s_waitcnt vmcnt(0)" ::: "memory");
        }
    }
    __syncthreads();
}

struct Args { const void* in[20]; float* out; unsigned char* ws; int lo, hi; };
struct Ctx {
    const float* x; const int* pos; const float* a_norm; const float* a_w_in; const float* pe_k; const float* pe_v;
    const float* w_ck1; const float* w_ck2; const float* w_cv1; const float* w_cv2; const float* conv_w; const float* a_w_out;
    const float* c_norm; const float* c_w_in; const float* q_norm; const float* kv_norm; const float* w_uq; const float* w_ukv; const float* c_w_out; const float* final_norm;
    float* out; unsigned char* ws;
    float2* CS; bf16_t* KCMP; bf16_t* VCMP; bf16_t* XN; bf16_t* PA; bf16_t* MIX; bf16_t* PC; bf16_t* Q1; bf16_t* KV1; bf16_t* CQN; bf16_t* CKVN; bf16_t* KPE; bf16_t* O1;
};

__device__ __forceinline__ void sincos_acc(float angf, float& s, float& c) {
    const double x = (double)angf;
    const double k = rint(x * 0.6366197723675814);
    double r = fma(-k, 1.5707963267948966, x);
    r = fma(-k, 6.123233995736766e-17, r);
    const double r2 = r * r;
    double sp = -1.0 / 1307674368000.0;
    sp = fma(sp, r2, 1.0 / 6227020800.0);
    sp = fma(sp, r2, -1.0 / 39916800.0);
    sp = fma(sp, r2, 1.0 / 362880.0);
    sp = fma(sp, r2, -1.0 / 5040.0);
    sp = fma(sp, r2, 1.0 / 120.0);
    sp = fma(sp, r2, -1.0 / 6.0);
    const double sn = fma(sp * r2, r, r);
    double cp = 1.0 / 20922789888000.0;
    cp = fma(cp, r2, -1.0 / 87178291200.0);
    cp = fma(cp, r2, 1.0 / 479001600.0);
    cp = fma(cp, r2, -1.0 / 3628800.0);
    cp = fma(cp, r2, 1.0 / 40320.0);
    cp = fma(cp, r2, -1.0 / 720.0);
    cp = fma(cp, r2, 1.0 / 24.0);
    cp = fma(cp, r2, -0.5);
    const double cs = fma(cp, r2, 1.0);
    const int q = ((int)(long long)k) & 3;
    const double ss = (q == 0) ? sn : (q == 1) ? cs : (q == 2) ? -sn : -cs;
    const double cc = (q == 0) ? cs : (q == 1) ? -sn : (q == 2) ? -cs : sn;
    s = (float)ss; c = (float)cc;
}

__device__ __forceinline__ void rms_row_f32(const float* xr, const float* g, bf16_t* orow, int lane) {
    float4 v[4]; float s = 0.f;
#pragma unroll
    for (int j = 0; j < 4; ++j) { v[j] = *(const float4*)(xr + 4 * lane + 256 * j); s += (v[j].x * v[j].x + v[j].y * v[j].y) + (v[j].z * v[j].z + v[j].w * v[j].w); }
    const float rstd = 1.f / sqrtf(wave_sum(s) * (1.f / DM) + RMS_EPS);
#pragma unroll
    for (int j = 0; j < 4; ++j) {
        const float4 gg = *(const float4*)(g + 4 * lane + 256 * j);
        ushort4 o; o.x = f2bf(v[j].x * rstd * gg.x); o.y = f2bf(v[j].y * rstd * gg.y); o.z = f2bf(v[j].z * rstd * gg.z); o.w = f2bf(v[j].w * rstd * gg.w);
        *(ushort4*)(orow + 4 * lane + 256 * j) = o;
    }
}

namespace pg8 {
#define PG8_LAS __attribute__((address_space(3)))
typedef unsigned short bf16_t;
typedef short bf16x8 __attribute__((ext_vector_type(8)));
typedef float f32x4 __attribute__((ext_vector_type(4)));
typedef unsigned u32x4 __attribute__((ext_vector_type(4)));
constexpr int BM = 256, BK = 64, HALF = 128, HTB = HALF * BK * 2  , STAGE_BYTES = 8 * HTB, NXCD = 8, WGM = 8;

__host__ __device__ __forceinline__ int lds_byte(int r, int c) { const int st = (r >> 4) * 2 + (c >> 5), rr = r & 15, cc = c & 31, ob = rr * 64 + cc * 2; return st * 1024 + (ob ^ (((ob >> 9) & 1) << 5)); }
__host__ __device__ __forceinline__ void stage_rc(int b, int& R, int& C) { const int st = b / 1024, sb = b % 1024, swz = sb ^ (((sb >> 9) & 1) << 5); R = (st >> 1) * 16 + swz / 64; C = (st & 1) * 32 + (swz % 64) / 2; }
__host__ __device__ __forceinline__ int perm32(int rho) { const int n = rho >> 4, i = rho & 15; return 8 * (i >> 2) + 4 * n + (i & 3); }

struct Unit { int pm, pn; };
struct Gemm { const bf16_t* A; const bf16_t* Bt; int M, N, K; };

struct StaticOrder {
    int nM, nN, nwg, G, c;
    __host__ __device__ void init(int M, int N, int G_, int c_) { nM = M / BM; nN = N / BM; nwg = nM * nN; G = G_; c = c_; }
    __host__ __device__ bool next(int i, Unit& u) const {
        const long L = (long)i * G + c; if (L >= nwg) return false;
        int wgid = (int)L; { const int q = nwg / NXCD, r = nwg % NXCD, xcd = wgid % NXCD, off = wgid / NXCD; wgid = (xcd < r ? xcd * (q + 1) : r * (q + 1) + (xcd - r) * q) + off; }
        const int nig = WGM * nN, gid = wgid / nig, fm = gid * WGM, gsz = (nM - fm) < WGM ? (nM - fm) : WGM;
        u.pm = fm + ((wgid % nig) % gsz); u.pn = (wgid % nig) / gsz; return true;
    }
    __device__ __forceinline__ void a_ready(const Unit&) const {}
    __device__ __forceinline__ void done(const Unit&) const {}
};

__device__ __forceinline__ unsigned cvt_pk_bf16(float lo, float hi) { unsigned r; asm volatile("v_cvt_pk_bf16_f32 %0, %1, %2" : "=v"(r) : "v"(lo), "v"(hi)); return r; }

struct EpiPA {
    static constexpr bool PERM = true, AFTER_DRAIN = false;
    bf16_t* PA; const float2* CS;
    __device__ __forceinline__ void operator()(const f32x4 (&acc)[2][2][4][2], const Unit& u, int wr, int wc, int fr, int fq) const {
        const int row0 = u.pm * BM + wr * 64 + fr;
        if (u.pn < 3) {
            const int base = (u.pn == 0) ? 64 * wc : (u.pn == 1) ? 256 + 64 * wc : (wc < 2 ? 768 + 64 * wc : 1024 + 64 * (wc - 2));
            const float sc = u.pn < 2 ? QSCALE_A : 1.f;
#pragma unroll
            for (int ai = 0; ai < 2; ++ai)
#pragma unroll
                for (int m = 0; m < 4; ++m) {
                    const int row = row0 + ai * HALF + m * 16;
                    const f32x4* csp = (const f32x4*)(CS + (size_t)row * 32 + 8 * fq);
                    const f32x4 t0 = csp[0], t1 = csp[1], t2 = csp[2], t3 = csp[3];
                    const f32x4 a0 = acc[ai][0][m][0], a1 = acc[ai][0][m][1], b0 = acc[ai][1][m][0], b1 = acc[ai][1][m][1];
                    u32x4 w1, w2;
                    w1.x = cvt_pk_bf16((a0[0] * t0[0] - b0[0] * t0[1]) * sc, (a0[1] * t0[2] - b0[1] * t0[3]) * sc);
                    w1.y = cvt_pk_bf16((a0[2] * t1[0] - b0[2] * t1[1]) * sc, (a0[3] * t1[2] - b0[3] * t1[3]) * sc);
                    w1.z = cvt_pk_bf16((a1[0] * t2[0] - b1[0] * t2[1]) * sc, (a1[1] * t2[2] - b1[1] * t2[3]) * sc);
                    w1.w = cvt_pk_bf16((a1[2] * t3[0] - b1[2] * t3[1]) * sc, (a1[3] * t3[2] - b1[3] * t3[3]) * sc);
                    w2.x = cvt_pk_bf16((b0[0] * t0[0] + a0[0] * t0[1]) * sc, (b0[1] * t0[2] + a0[1] * t0[3]) * sc);
                    w2.y = cvt_pk_bf16((b0[2] * t1[0] + a0[2] * t1[1]) * sc, (b0[3] * t1[2] + a0[3] * t1[3]) * sc);
                    w2.z = cvt_pk_bf16((b1[0] * t2[0] + a1[0] * t2[1]) * sc, (b1[1] * t2[2] + a1[1] * t2[3]) * sc);
                    w2.w = cvt_pk_bf16((b1[2] * t3[0] + a1[2] * t3[1]) * sc, (b1[3] * t3[2] + a1[3] * t3[3]) * sc);
                    bf16_t* rp = PA + (size_t)row * PA_LD + base + 8 * fq;
                    *(u32x4*)rp = w1; *(u32x4*)(rp + 32) = w2;
                }
        } else {
            const int cb0 = (u.pn == 3) ? 512 : (u.pn == 4) ? 896 : 256 * u.pn;
            const int cb1 = (u.pn == 3) ? 640 : (u.pn == 4) ? 1152 : 256 * u.pn + 128;
#pragma unroll
            for (int ai = 0; ai < 2; ++ai)
#pragma unroll
                for (int m = 0; m < 4; ++m) {
                    bf16_t* rp = PA + (size_t)(row0 + ai * HALF + m * 16) * PA_LD + 32 * wc + 8 * fq;
#pragma unroll
                    for (int bj = 0; bj < 2; ++bj) { const f32x4 v0 = acc[ai][bj][m][0], v1 = acc[ai][bj][m][1];
                        u32x4 w; w.x = cvt_pk_bf16(v0[0], v0[1]); w.y = cvt_pk_bf16(v0[2], v0[3]); w.z = cvt_pk_bf16(v1[0], v1[1]); w.w = cvt_pk_bf16(v1[2], v1[3]);
                        *(u32x4*)(rp + (bj ? cb1 : cb0)) = w; }
                }
        }
    }
};
struct EpiPlain {
    static constexpr bool PERM = true, AFTER_DRAIN = false;
    bf16_t* O; int ldc;
    __device__ __forceinline__ void operator()(const f32x4 (&acc)[2][2][4][2], const Unit& u, int wr, int wc, int fr, int fq) const {
        const int row0 = u.pm * BM + wr * 64 + fr; const int col0 = u.pn * BM + wc * 32 + 8 * fq;
#pragma unroll
        for (int ai = 0; ai < 2; ++ai)
#pragma unroll
            for (int m = 0; m < 4; ++m) { bf16_t* rp = O + (size_t)(row0 + ai * HALF + m * 16) * ldc + col0;
#pragma unroll
                for (int bj = 0; bj < 2; ++bj) { const f32x4 v0 = acc[ai][bj][m][0], v1 = acc[ai][bj][m][1];
                    u32x4 w; w.x = cvt_pk_bf16(v0[0], v0[1]); w.y = cvt_pk_bf16(v0[2], v0[3]); w.z = cvt_pk_bf16(v1[0], v1[1]); w.w = cvt_pk_bf16(v1[2], v1[3]);
                    *(u32x4*)(rp + bj * HALF) = w; } }
    }
};
struct EpiRes {
    static constexpr bool PERM = false, AFTER_DRAIN = false;
    const float* base; float* out;
    __device__ __forceinline__ void operator()(const f32x4 (&acc)[2][2][4][2], const Unit& u, int wr, int wc, int fr, int fq) const {
        const int row0 = u.pm * BM + wr * 64 + fr; const int col0 = u.pn * BM + wc * 32 + 4 * fq;
#pragma unroll
        for (int ai = 0; ai < 2; ++ai)
#pragma unroll
            for (int m = 0; m < 4; ++m) { const size_t off = (size_t)(row0 + ai * HALF + m * 16) * 1024 + col0;
#pragma unroll
                for (int bj = 0; bj < 2; ++bj)
#pragma unroll
                    for (int n = 0; n < 2; ++n) { const f32x4 b = *(const f32x4*)(base + off + bj * HALF + n * 16); *(f32x4*)(out + off + bj * HALF + n * 16) = b + acc[ai][bj][m][n]; } }
    }
};
struct EpiRes2 {
    static constexpr bool PERM = false, AFTER_DRAIN = false;
    const float* base; float* out; bf16_t* xn; const float* g; float* stat;
    __device__ __forceinline__ void operator()(const f32x4 (&acc)[2][2][4][2], const Unit& u, int wr, int wc, int fr, int fq) const {
        asm volatile("" : "+v"(fr), "+v"(fq));
        const int row0 = u.pm * BM + wr * 64 + fr; const int col0 = u.pn * BM + wc * 32 + 4 * fq;
        f32x4 gv[2][2];
#pragma unroll
        for (int bj = 0; bj < 2; ++bj)
#pragma unroll
            for (int n = 0; n < 2; ++n) gv[bj][n] = *(const f32x4*)(g + col0 + bj * HALF + n * 16);
#pragma unroll
        for (int ai = 0; ai < 2; ++ai)
#pragma unroll
            for (int m = 0; m < 4; ++m) { const int row = row0 + ai * HALF + m * 16; const size_t off = (size_t)row * 1024 + col0; float ss = 0.f;
#pragma unroll
                for (int bj = 0; bj < 2; ++bj)
#pragma unroll
                    for (int n = 0; n < 2; ++n) { const f32x4 x = *(const f32x4*)(base + off + bj * HALF + n * 16) + acc[ai][bj][m][n]; *(f32x4*)(out + off + bj * HALF + n * 16) = x;
                        ss += (x[0] * x[0] + x[1] * x[1]) + (x[2] * x[2] + x[3] * x[3]); const f32x4 y = x * gv[bj][n];
                        typedef unsigned u32x2_t __attribute__((ext_vector_type(2))); u32x2_t w; w.x = cvt_pk_bf16(y[0], y[1]); w.y = cvt_pk_bf16(y[2], y[3]); *(u32x2_t*)(xn + off + bj * HALF + n * 16) = w; }
                ss += __shfl_xor(ss, 16); ss += __shfl_xor(ss, 32);
                if (fq == 0) stat[(size_t)row * 16 + u.pn * 4 + wc] = ss; }
    }
};
template <int NS> __device__ __forceinline__ float row_rstd(const float* st, float invn) {
    float s = 0.f;
#pragma unroll
    for (int i = 0; i < NS; i += 4) { const f32x4 v = *(const f32x4*)(st + i); s += (v[0] + v[1]) + (v[2] + v[3]); }
    asm volatile("" ::: "memory");
    return 1.f / sqrtf(s * invn + RMS_EPS);
}
struct EpiPC2 {
    static constexpr bool PERM = true, AFTER_DRAIN = false;
    bf16_t* PC; bf16_t* CQN; bf16_t* CKVN; bf16_t* KPE; const float* qn; const float* kvn; const float* stat1; float* stat2; const float2* CS;
    __device__ __forceinline__ void operator()(const f32x4 (&acc)[2][2][4][2], const Unit& u, int wr, int wc, int fr, int fq) const {
        asm volatile("" : "+v"(fr), "+v"(fq));
        const int row0 = u.pm * BM + wr * 64 + fr; const int cl0 = wc * 32 + 8 * fq;
        if (u.pn == 6 && wc != 0) return;
        f32x4 gv[2][2];
        if (u.pn < 2) { const float* gsrc = u.pn ? kvn : qn;
#pragma unroll
            for (int bj = 0; bj < 2; ++bj) { gv[bj][0] = *(const f32x4*)(gsrc + cl0 + bj * HALF); gv[bj][1] = *(const f32x4*)(gsrc + cl0 + bj * HALF + 4); } }
#pragma unroll
        for (int ai = 0; ai < 2; ++ai)
#pragma unroll
            for (int m = 0; m < 4; ++m) { const int row = row0 + ai * HALF + m * 16; const float rs = row_rstd<16>(stat1 + (size_t)row * 16, 1.f / 1024.f);
                if (u.pn < 2) { bf16_t* dst = (u.pn ? CKVN : CQN) + (size_t)row * 256 + cl0; float ss = 0.f;
#pragma unroll
                    for (int bj = 0; bj < 2; ++bj) { const f32x4 v0 = acc[ai][bj][m][0] * rs, v1 = acc[ai][bj][m][1] * rs;
                        ss += ((v0[0] * v0[0] + v0[1] * v0[1]) + (v0[2] * v0[2] + v0[3] * v0[3])) + ((v1[0] * v1[0] + v1[1] * v1[1]) + (v1[2] * v1[2] + v1[3] * v1[3]));
                        const f32x4 y0 = v0 * gv[bj][0], y1 = v1 * gv[bj][1];
                        u32x4 w; w.x = cvt_pk_bf16(y0[0], y0[1]); w.y = cvt_pk_bf16(y0[2], y0[3]); w.z = cvt_pk_bf16(y1[0], y1[1]); w.w = cvt_pk_bf16(y1[2], y1[3]); *(u32x4*)(dst + bj * HALF) = w; }
                    ss += __shfl_xor(ss, 16); ss += __shfl_xor(ss, 32);
                    if (fq == 0) stat2[(size_t)row * 8 + u.pn * 4 + wc] = ss;
                } else if (u.pn < 6) { bf16_t* dst = PC + (size_t)row * PC_LD + u.pn * BM + cl0;
#pragma unroll
                    for (int bj = 0; bj < 2; ++bj) { const f32x4 v0 = acc[ai][bj][m][0] * rs, v1 = acc[ai][bj][m][1] * rs;
                        u32x4 w; w.x = cvt_pk_bf16(v0[0], v0[1]); w.y = cvt_pk_bf16(v0[2], v0[3]); w.z = cvt_pk_bf16(v1[0], v1[1]); w.w = cvt_pk_bf16(v1[2], v1[3]); *(u32x4*)(dst + bj * HALF) = w; }
                } else {
                    const f32x4* csp = (const f32x4*)(CS + (size_t)row * 32 + 8 * fq);
                    const f32x4 t0 = csp[0], t1 = csp[1], t2 = csp[2], t3 = csp[3];
                    const f32x4 a0 = acc[ai][0][m][0] * rs, a1 = acc[ai][0][m][1] * rs, b0 = acc[ai][1][m][0] * rs, b1 = acc[ai][1][m][1] * rs;
                    u32x4 w1, w2;
                    w1.x = cvt_pk_bf16(a0[0] * t0[0] - b0[0] * t0[1], a0[1] * t0[2] - b0[1] * t0[3]); w1.y = cvt_pk_bf16(a0[2] * t1[0] - b0[2] * t1[1], a0[3] * t1[2] - b0[3] * t1[3]);
                    w1.z = cvt_pk_bf16(a1[0] * t2[0] - b1[0] * t2[1], a1[1] * t2[2] - b1[1] * t2[3]); w1.w = cvt_pk_bf16(a1[2] * t3[0] - b1[2] * t3[1], a1[3] * t3[2] - b1[3] * t3[3]);
                    w2.x = cvt_pk_bf16(b0[0] * t0[0] + a0[0] * t0[1], b0[1] * t0[2] + a0[1] * t0[3]); w2.y = cvt_pk_bf16(b0[2] * t1[0] + a0[2] * t1[1], b0[3] * t1[2] + a0[3] * t1[3]);
                    w2.z = cvt_pk_bf16(b1[0] * t2[0] + a1[0] * t2[1], b1[1] * t2[2] + a1[1] * t2[3]); w2.w = cvt_pk_bf16(b1[2] * t3[0] + a1[2] * t3[1], b1[3] * t3[2] + a1[3] * t3[3]);
                    bf16_t* rp = KPE + (size_t)row * 64 + 8 * fq; *(u32x4*)rp = w1; *(u32x4*)(rp + 32) = w2;
                } }
    }
};
struct EpiQ1 {
    static constexpr bool PERM = true, AFTER_DRAIN = false;
    bf16_t* Q1; const float* stat2; const float2* CS;
    __device__ __forceinline__ void operator()(const f32x4 (&acc)[2][2][4][2], const Unit& u, int wr, int wc, int fr, int fq) const {
        asm volatile("" : "+v"(fr), "+v"(fq));
        const int row0 = u.pm * BM + wr * 64 + fr;
#pragma unroll
        for (int ai = 0; ai < 2; ++ai)
#pragma unroll
            for (int m = 0; m < 4; ++m) { const int row = row0 + ai * HALF + m * 16; const float rs = row_rstd<4>(stat2 + (size_t)row * 8, 1.f / 256.f) * QSCALE_C;
                if (u.pn < 4) {
#pragma unroll
                    for (int bj = 0; bj < 2; ++bj) { const f32x4 v0 = acc[ai][bj][m][0] * rs, v1 = acc[ai][bj][m][1] * rs;
                        u32x4 w; w.x = cvt_pk_bf16(v0[0], v0[1]); w.y = cvt_pk_bf16(v0[2], v0[3]); w.z = cvt_pk_bf16(v1[0], v1[1]); w.w = cvt_pk_bf16(v1[2], v1[3]);
                        *(u32x4*)(Q1 + (size_t)row * 1536 + (2 * u.pn + bj) * 192 + wc * 32 + 8 * fq) = w; }
                } else { const int head = (u.pn - 4) * 4 + wc;
                    const f32x4* csp = (const f32x4*)(CS + (size_t)row * 32 + 8 * fq);
                    const f32x4 t0 = csp[0], t1 = csp[1], t2 = csp[2], t3 = csp[3];
                    const f32x4 a0 = acc[ai][0][m][0] * rs, a1 = acc[ai][0][m][1] * rs, b0 = acc[ai][1][m][0] * rs, b1 = acc[ai][1][m][1] * rs;
                    u32x4 w1, w2;
                    w1.x = cvt_pk_bf16(a0[0] * t0[0] - b0[0] * t0[1], a0[1] * t0[2] - b0[1] * t0[3]); w1.y = cvt_pk_bf16(a0[2] * t1[0] - b0[2] * t1[1], a0[3] * t1[2] - b0[3] * t1[3]);
                    w1.z = cvt_pk_bf16(a1[0] * t2[0] - b1[0] * t2[1], a1[1] * t2[2] - b1[1] * t2[3]); w1.w = cvt_pk_bf16(a1[2] * t3[0] - b1[2] * t3[1], a1[3] * t3[2] - b1[3] * t3[3]);
                    w2.x = cvt_pk_bf16(b0[0] * t0[0] + a0[0] * t0[1], b0[1] * t0[2] + a0[1] * t0[3]); w2.y = cvt_pk_bf16(b0[2] * t1[0] + a0[2] * t1[1], b0[3] * t1[2] + a0[3] * t1[3]);
                    w2.z = cvt_pk_bf16(b1[0] * t2[0] + a1[0] * t2[1], b1[1] * t2[2] + a1[1] * t2[3]); w2.w = cvt_pk_bf16(b1[2] * t3[0] + a1[2] * t3[1], b1[3] * t3[2] + a1[3] * t3[3]);
                    bf16_t* rp = Q1 + (size_t)row * 1536 + head * 192 + 128 + 8 * fq; *(u32x4*)rp = w1; *(u32x4*)(rp + 32) = w2;
                }
                asm volatile("" ::: "memory"); }
    }
};
struct EpiKV1 {
    static constexpr bool PERM = true, AFTER_DRAIN = false;
    bf16_t* O; const float* stat2;
    __device__ __forceinline__ void operator()(const f32x4 (&acc)[2][2][4][2], const Unit& u, int wr, int wc, int fr, int fq) const {
        asm volatile("" : "+v"(fr), "+v"(fq));
        const int row0 = u.pm * BM + wr * 64 + fr; const int col0 = u.pn * BM + wc * 32 + 8 * fq;
#pragma unroll
        for (int ai = 0; ai < 2; ++ai)
#pragma unroll
            for (int m = 0; m < 4; ++m) { const int row = row0 + ai * HALF + m * 16; const float rs = row_rstd<4>(stat2 + (size_t)row * 8 + 4, 1.f / 256.f);
                bf16_t* rp = O + (size_t)row * 2048 + col0;
#pragma unroll
                for (int bj = 0; bj < 2; ++bj) { const f32x4 v0 = acc[ai][bj][m][0] * rs, v1 = acc[ai][bj][m][1] * rs;
                    u32x4 w; w.x = cvt_pk_bf16(v0[0], v0[1]); w.y = cvt_pk_bf16(v0[2], v0[3]); w.z = cvt_pk_bf16(v1[0], v1[1]); w.w = cvt_pk_bf16(v1[2], v1[3]);
                    *(u32x4*)(rp + bj * HALF) = w; } }
    }
};
template <class Epi, class Sched, bool ALIGN_EPI = false, bool SP2 = false>
__device__ __forceinline__ void gemm_phase(PG8_LAS unsigned char* lds, const Gemm g, const Sched& S, const Epi& E) {
    int tid_ = threadIdx.x; asm volatile("" : "+v"(tid_));
    const int tid = tid_, wid = __builtin_amdgcn_readfirstlane(tid >> 6), lane = tid & 63, wr = wid >> 2, wc = wid & 3, fr = lane & 15, fq = lane >> 4;
    const int K = g.K, nt = K / BK;
    unsigned voffA[2], voffB[2];
#pragma unroll
    for (int i = 0; i < 2; ++i) { int R, C; stage_rc(tid * 16 + i * 8192, R, C); const int Rb = Epi::PERM ? ((R & ~31) + perm32(R & 31)) : R;
        voffA[i] = (unsigned)(R * K + C) * 2u; voffB[i] = (unsigned)(Rb * K + C) * 2u; }
    const size_t kstep = (size_t)(BK * 2);
    const size_t hstep = (size_t)HALF * K * 2;
    const size_t tstep = 2 * hstep;
    const unsigned ldsw = (unsigned)wid * 1024u;
    const int aoff = lds_byte(wr * 64 + fr, fq * 8), boff = lds_byte(wc * 32 + fr, fq * 8);
#define PG8_SA(b, h) (((b) * 2 + (h)) * HTB)
#define PG8_SB(b, h) ((4 + (b) * 2 + (h)) * HTB)
#define PG8_STAGE(bufoff, gbase, voff) do { _Pragma("unroll") for (int _i = 0; _i < 2; ++_i) \
        __builtin_amdgcn_global_load_lds((const unsigned*)((const char*)(gbase) + (voff)[_i]), (PG8_LAS unsigned*)(lds + (bufoff) + ldsw + _i * 8192), 16, 0, 0); } while (0)
#define PG8_LDA(dst, b, h) do { _Pragma("unroll") for (int m = 0; m < 4; ++m) _Pragma("unroll") for (int k = 0; k < 2; ++k) dst[m][k] = *(const PG8_LAS bf16x8*)(lds + PG8_SA(b, h) + aoff + m * 2048 + k * 1024); } while (0)
#define PG8_LDB(dst, b, h) do { _Pragma("unroll") for (int n = 0; n < 2; ++n) _Pragma("unroll") for (int k = 0; k < 2; ++k) dst[n][k] = *(const PG8_LAS bf16x8*)(lds + PG8_SB(b, h) + boff + n * 2048 + k * 1024); } while (0)
#define PG8_MMA(ai, bj, At, Bt) do { __builtin_amdgcn_s_setprio(1); _Pragma("unroll") for (int m = 0; m < 4; ++m) _Pragma("unroll") for (int n = 0; n < 2; ++n) _Pragma("unroll") for (int k = 0; k < 2; ++k) \
        acc[ai][bj][m][n] = __builtin_amdgcn_mfma_f32_16x16x32_bf16(Bt[n][k], At[m][k], acc[ai][bj][m][n], 0, 0, 0); __builtin_amdgcn_s_setprio(0); } while (0)
#define PG8_WAIT_V(n) asm volatile("s_waitcnt vmcnt(" #n ")" ::: "memory")
#define PG8_WAIT_L(n) asm volatile("s_waitcnt lgkmcnt(" #n ")" ::: "memory")
#define PG8_BAR __builtin_amdgcn_s_barrier()
#define PG8_SCHED __builtin_amdgcn_sched_barrier(0)
    Unit cur, nxt; int ui = 0;
    if (!S.next(0, cur)) return;
    f32x4 acc[2][2][4][2];
#pragma unroll
    for (int a = 0; a < 2; ++a)
#pragma unroll
        for (int b = 0; b < 2; ++b)
#pragma unroll
            for (int m = 0; m < 4; ++m)
#pragma unroll
                for (int n = 0; n < 2; ++n) acc[a][b][m][n] = (f32x4){0.f, 0.f, 0.f, 0.f};
    bf16x8 At[4][2], B0[2][2], B1[2][2];
    const char* cA = (const char*)g.A + (size_t)cur.pm * tstep; const char* cB = (const char*)g.Bt + (size_t)cur.pn * tstep;
    S.a_ready(cur);
    if constexpr (SP2) {
        PG8_STAGE(PG8_SB(0, 0), cB, voffB); PG8_STAGE(PG8_SB(0, 1), cB + hstep, voffB); PG8_STAGE(PG8_SA(0, 0), cA, voffA); PG8_STAGE(PG8_SA(0, 1), cA + hstep, voffA);
        if (wr == 1) PG8_BAR;
        PG8_WAIT_V(2); PG8_BAR;
        PG8_STAGE(PG8_SB(1, 0), cB + kstep, voffB); PG8_STAGE(PG8_SA(1, 0), cA + kstep, voffA); PG8_STAGE(PG8_SB(1, 1), cB + hstep + kstep, voffB);
        PG8_WAIT_V(6); PG8_BAR;
    } else {
        PG8_STAGE(PG8_SB(0, 0), cB, voffB); PG8_STAGE(PG8_SA(0, 0), cA, voffA); PG8_STAGE(PG8_SB(0, 1), cB + hstep, voffB); PG8_STAGE(PG8_SA(0, 1), cA + hstep, voffA);
        if (wr == 1) PG8_BAR;
        PG8_WAIT_V(4); PG8_BAR;
        PG8_STAGE(PG8_SB(1, 0), cB + kstep, voffB); PG8_STAGE(PG8_SA(1, 0), cA + kstep, voffA); PG8_STAGE(PG8_SB(1, 1), cB + hstep + kstep, voffB);
        PG8_WAIT_V(6); PG8_BAR;
    }
    for (;;) {
        const bool has_next = S.next(ui + 1, nxt);
        const char* nA = has_next ? (const char*)g.A + (size_t)nxt.pm * tstep : cA; const char* nB = has_next ? (const char*)g.Bt + (size_t)nxt.pn * tstep : cB;
        for (int t = 0; t < nt; t += 2) {
            const bool last = (t == nt - 2);
            const char* a1 = cA + (size_t)(t + 1) * kstep;
            const char* a2 = last ? nA : cA + (size_t)(t + 2) * kstep; const char* b2 = last ? nB : cB + (size_t)(t + 2) * kstep;
            const char* a3 = a2 + kstep; const char* b3 = b2 + kstep;
            if (last && has_next) S.a_ready(nxt);
            if constexpr (SP2) {
            PG8_LDB(B0, 0, 0); PG8_LDB(B1, 0, 1); PG8_SCHED; PG8_LDA(At, 0, 0); PG8_STAGE(PG8_SA(1, 1), a1 + hstep, voffA);
            PG8_WAIT_V(8); PG8_WAIT_L(0); PG8_BAR; PG8_MMA(0, 0, At, B0); PG8_MMA(0, 1, At, B1); PG8_BAR; PG8_SCHED;
            PG8_LDA(At, 0, 1); PG8_STAGE(PG8_SB(0, 0), b2, voffB); PG8_STAGE(PG8_SB(0, 1), b2 + hstep, voffB); PG8_STAGE(PG8_SA(0, 0), a2, voffA);
            PG8_WAIT_V(8); PG8_WAIT_L(0); PG8_BAR; PG8_MMA(1, 0, At, B0); PG8_MMA(1, 1, At, B1); PG8_BAR; PG8_SCHED;
            PG8_LDB(B0, 1, 0); PG8_LDB(B1, 1, 1); PG8_SCHED; PG8_LDA(At, 1, 0); PG8_STAGE(PG8_SA(0, 1), a2 + hstep, voffA);
            PG8_WAIT_V(8); PG8_WAIT_L(0); PG8_BAR; PG8_MMA(0, 0, At, B0); PG8_MMA(0, 1, At, B1); PG8_BAR; PG8_SCHED;
            PG8_LDA(At, 1, 1); PG8_STAGE(PG8_SB(1, 0), b3, voffB); PG8_STAGE(PG8_SB(1, 1), b3 + hstep, voffB); PG8_STAGE(PG8_SA(1, 0), a3, voffA);
            PG8_WAIT_V(8); PG8_WAIT_L(0); PG8_BAR; PG8_MMA(1, 0, At, B0); PG8_MMA(1, 1, At, B1); PG8_BAR; PG8_SCHED;
            } else {
            PG8_LDB(B0, 0, 0); PG8_SCHED; PG8_LDA(At, 0, 0); PG8_STAGE(PG8_SA(1, 1), a1 + hstep, voffA);
            PG8_WAIT_L(8); PG8_BAR; PG8_WAIT_L(0); PG8_MMA(0, 0, At, B0); PG8_BAR; PG8_SCHED;
            PG8_LDB(B1, 0, 1); PG8_STAGE(PG8_SB(0, 0), b2, voffB);
            PG8_BAR; PG8_WAIT_L(0); PG8_MMA(0, 1, At, B1); PG8_BAR;
            PG8_LDA(At, 0, 1); PG8_STAGE(PG8_SA(0, 0), a2, voffA);
            PG8_BAR; PG8_WAIT_L(0); PG8_MMA(1, 0, At, B0); PG8_BAR; PG8_SCHED;
            PG8_STAGE(PG8_SB(0, 1), b2 + hstep, voffB);
            PG8_WAIT_V(6); PG8_BAR; PG8_MMA(1, 1, At, B1); PG8_BAR;
            PG8_LDB(B0, 1, 0); PG8_SCHED; PG8_LDA(At, 1, 0); PG8_STAGE(PG8_SA(0, 1), a2 + hstep, voffA);
            PG8_WAIT_L(8); PG8_BAR; PG8_WAIT_L(0); PG8_MMA(0, 0, At, B0); PG8_BAR; PG8_SCHED;
            PG8_LDB(B1, 1, 1); PG8_STAGE(PG8_SB(1, 0), b3, voffB);
            PG8_BAR; PG8_WAIT_L(0); PG8_MMA(0, 1, At, B1); PG8_BAR;
            PG8_LDA(At, 1, 1); PG8_STAGE(PG8_SA(1, 0), a3, voffA);
            PG8_BAR; PG8_WAIT_L(0); PG8_MMA(1, 0, At, B0); PG8_BAR; PG8_SCHED;
            PG8_STAGE(PG8_SB(1, 1), b3 + hstep, voffB);
            PG8_WAIT_V(6); PG8_BAR; PG8_MMA(1, 1, At, B1); PG8_BAR;
            }
        }
        if constexpr (ALIGN_EPI) { if (wr == 0) PG8_BAR; }
        if constexpr (!Epi::AFTER_DRAIN) { E(acc, cur, wr, wc, fr, fq); S.done(cur); }
        if (!has_next) break;
#pragma unroll
        for (int a = 0; a < 2; ++a)
#pragma unroll
            for (int b = 0; b < 2; ++b)
#pragma unroll
                for (int m = 0; m < 4; ++m)
#pragma unroll
                    for (int n = 0; n < 2; ++n) acc[a][b][m][n] = (f32x4){0.f, 0.f, 0.f, 0.f};
        cur = nxt; cA = nA; cB = nB; ++ui;
        if constexpr (ALIGN_EPI) { if (wr == 1) PG8_BAR; }
    }
    PG8_WAIT_V(0);
    if constexpr (!ALIGN_EPI) { if (wr == 0) PG8_BAR; }
    PG8_BAR;
    if constexpr (Epi::AFTER_DRAIN) { E.fused(acc, cur, wr, wc, fr, fq, lds, wid, lane); S.done(cur); }
#undef PG8_SA
#undef PG8_SB
#undef PG8_STAGE
#undef PG8_LDA
#undef PG8_LDB
#undef PG8_MMA
#undef PG8_WAIT_V
#undef PG8_WAIT_L
#undef PG8_BAR
#undef PG8_SCHED
}
}

template <class Epi>
__device__ __forceinline__ void gemm_naive(const bf16_t* A, int lda, const float* W, int K, int N, unsigned char* lds, Epi epi) {
    float (*As)[132] = (float (*)[132])lds;
    float (*Bs)[128] = (float (*)[128])(lds + 16 * 132 * 4);
    const int tid = threadIdx.x, tx = tid & 31, ty = tid >> 5;
    const int ntm = M / 128, ntn = (N + 127) / 128;
    for (int tile = blockIdx.x; tile < ntm * ntn; tile += gridDim.x) {
        const int tm = tile / ntn, tn = tile % ntn;
        float acc[8][4];
#pragma unroll
        for (int i = 0; i < 8; ++i)
#pragma unroll
            for (int j = 0; j < 4; ++j) acc[i][j] = 0.f;
        for (int k0 = 0; k0 < K; k0 += 16) {
            {   const int r = tid >> 2, kq = (tid & 3) * 4;
                const ushort4 v = *(const ushort4*)(A + (size_t)(tm * 128 + r) * lda + k0 + kq);
                As[kq + 0][r] = bf2f(v.x); As[kq + 1][r] = bf2f(v.y); As[kq + 2][r] = bf2f(v.z); As[kq + 3][r] = bf2f(v.w); }
            {   const int kk = tid >> 5, n4 = (tid & 31) * 4; const int n = tn * 128 + n4;
                const float* wp = W + (size_t)(k0 + kk) * N + n;
                float4 v;
                v.x = (n + 0 < N) ? wp[0] : 0.f; v.y = (n + 1 < N) ? wp[1] : 0.f; v.z = (n + 2 < N) ? wp[2] : 0.f; v.w = (n + 3 < N) ? wp[3] : 0.f;
                *(float4*)&Bs[kk][n4] = v; }
            __syncthreads();
#pragma unroll 2
            for (int kk = 0; kk < 16; ++kk) {
                const float4 a0 = *(const float4*)&As[kk][ty * 8], a1 = *(const float4*)&As[kk][ty * 8 + 4];
                const float4 b = *(const float4*)&Bs[kk][tx * 4];
                const float a[8] = {a0.x, a0.y, a0.z, a0.w, a1.x, a1.y, a1.z, a1.w};
                const float bb[4] = {b.x, b.y, b.z, b.w};
#pragma unroll
                for (int i = 0; i < 8; ++i)
#pragma unroll
                    for (int j = 0; j < 4; ++j) acc[i][j] = fmaf(a[i], bb[j], acc[i][j]);
            }
            __syncthreads();
        }
#pragma unroll
        for (int i = 0; i < 8; ++i)
#pragma unroll
            for (int j = 0; j < 4; ++j) { const int m = tm * 128 + ty * 8 + i, n = tn * 128 + tx * 4 + j; if (n < N) epi(m, n, acc[i][j]); }
    }
}

namespace fa {
typedef short bf16x8 __attribute__((ext_vector_type(8)));
typedef short s16x4 __attribute__((ext_vector_type(4)));
typedef float f32x16 __attribute__((ext_vector_type(16)));
typedef unsigned u32x4 __attribute__((ext_vector_type(4)));
#define FA_SBAR() __builtin_amdgcn_sched_barrier(0)
__device__ __forceinline__ int crow(int r, int hi) { return (r & 3) + 8 * (r >> 2) + 4 * hi; }
__device__ __forceinline__ unsigned cvtpk(float lo, float hi) { unsigned r; asm volatile("v_cvt_pk_bf16_f32 %0, %1, %2" : "=v"(r) : "v"(lo), "v"(hi)); return r; }
template <int NCB> __device__ __forceinline__ int v_st(int k, int c) { const int kk = (k & ~0xC) | ((k & 4) << 1) | ((k & 8) >> 1); return ((kk >> 3) * NCB + (c >> 5)) * 512 + ((kk & 7) * 32 + (c & 31)) * 2; }
__device__ __forceinline__ int v_rd_base(int lane) { return ((lane & 3) << 3) | (((lane >> 2) & 3) << 6) | (((lane >> 4) & 1) << 5) | (((lane >> 5) & 1) << 8); }
__device__ __forceinline__ void mask_tile(f32x16& p0, f32x16& p1, int dq, unsigned W) {
    const float NEG = -__builtin_inff();
#pragma unroll
    for (int r = 0; r < 16; ++r) { const int cc = (r & 3) + 8 * (r >> 2);
        if ((unsigned)(dq - cc) >= W) p0[r] = NEG;
        if ((unsigned)(dq - cc - 32) >= W) p1[r] = NEG; }
}
__device__ __forceinline__ void softmax_tile(f32x16& p0, f32x16& p1, float& m_reg, float& l_reg, float& alpha, bf16x8& pa0, bf16x8& pa1, bf16x8& pa2, bf16x8& pa3) {
    float pmax = p0[0];
#pragma unroll
    for (int r = 1; r < 16; ++r) pmax = fmaxf(pmax, p0[r]);
#pragma unroll
    for (int r = 0; r < 16; ++r) pmax = fmaxf(pmax, p1[r]);
    { auto rr = __builtin_amdgcn_permlane32_swap(__float_as_uint(pmax), __float_as_uint(pmax), false, false); pmax = fmaxf(__uint_as_float(rr[0]), __uint_as_float(rr[1])); }
    const float mn = fmaxf(m_reg, pmax);
    alpha = __builtin_amdgcn_exp2f(m_reg - mn); m_reg = mn;
#pragma unroll
    for (int r = 0; r < 16; ++r) { p0[r] = __builtin_amdgcn_exp2f(p0[r] - mn); p1[r] = __builtin_amdgcn_exp2f(p1[r] - mn); }
    float ps = 0.f;
#pragma unroll
    for (int r = 0; r < 16; ++r) ps += p0[r];
#pragma unroll
    for (int r = 0; r < 16; ++r) ps += p1[r];
    { auto rr = __builtin_amdgcn_permlane32_swap(__float_as_uint(ps), __float_as_uint(ps), false, false); ps = __uint_as_float(rr[0]) + __uint_as_float(rr[1]); }
    l_reg = l_reg * alpha + ps;
#define FA_PK4(P, B_, OUT) do { unsigned a0 = cvtpk(P[B_+0], P[B_+1]), a1 = cvtpk(P[B_+2], P[B_+3]); unsigned b0 = cvtpk(P[B_+4], P[B_+5]), b1 = cvtpk(P[B_+6], P[B_+7]); \
        auto r0 = __builtin_amdgcn_permlane32_swap(a0, b0, false, false); auto r1 = __builtin_amdgcn_permlane32_swap(a1, b1, false, false); \
        u32x4 w = {r0[0], r1[0], r0[1], r1[1]}; OUT = __builtin_bit_cast(bf16x8, w); } while (0)
    FA_PK4(p0, 0, pa0); FA_PK4(p0, 8, pa1); FA_PK4(p1, 0, pa2); FA_PK4(p1, 8, pa3);
#undef FA_PK4
}
__device__ __forceinline__ void pack_p(const f32x16& p0, const f32x16& p1, bf16x8& pa0, bf16x8& pa1, bf16x8& pa2, bf16x8& pa3) {
#define FA_PK4(P, B_, OUT) do { unsigned a0 = cvtpk(P[B_+0], P[B_+1]), a1 = cvtpk(P[B_+2], P[B_+3]); unsigned b0 = cvtpk(P[B_+4], P[B_+5]), b1 = cvtpk(P[B_+6], P[B_+7]); \
        auto r0 = __builtin_amdgcn_permlane32_swap(a0, b0, false, false); auto r1 = __builtin_amdgcn_permlane32_swap(a1, b1, false, false); \
        u32x4 w = {r0[0], r1[0], r0[1], r1[1]}; OUT = __builtin_bit_cast(bf16x8, w); } while (0)
    FA_PK4(p0, 0, pa0); FA_PK4(p0, 8, pa1); FA_PK4(p1, 0, pa2); FA_PK4(p1, 8, pa3);
#undef FA_PK4
}
#define FA_DSR(dst, off) asm volatile("ds_read_b128 %0, %1 offset:%2" : "=&v"(dst) : "v"(kpa), "i"(off) : "memory")
#define FA_LGKM(n) do { asm volatile("s_waitcnt lgkmcnt(" #n ")" ::: "memory"); FA_SBAR(); } while (0)
template <int ND0, int KROW>
__device__ __forceinline__ void qkt(f32x16& p0, f32x16& p1, int kpa, const bf16x8* qr) {
    static_assert(ND0 % 2 == 0, "d0 pairs");
    constexpr int G = ND0 / 2;
    bf16x8 f[2][4];
    p0 = f32x16{}; p1 = f32x16{};
    FA_DSR(f[0][0], 0); FA_DSR(f[0][1], 32 * KROW); FA_DSR(f[0][2], 32); FA_DSR(f[0][3], 32 * KROW + 32);
#pragma unroll
    for (int g = 0; g < G; ++g) {
        if (g + 1 < G) { FA_DSR(f[(g + 1) & 1][0], (g + 1) * 64); FA_DSR(f[(g + 1) & 1][1], 32 * KROW + (g + 1) * 64); FA_DSR(f[(g + 1) & 1][2], (g + 1) * 64 + 32); FA_DSR(f[(g + 1) & 1][3], 32 * KROW + (g + 1) * 64 + 32); FA_LGKM(4); }
        else { FA_LGKM(0); }
        p0 = __builtin_amdgcn_mfma_f32_32x32x16_bf16(f[g & 1][0], qr[2 * g], p0, 0, 0, 0);
        p1 = __builtin_amdgcn_mfma_f32_32x32x16_bf16(f[g & 1][1], qr[2 * g], p1, 0, 0, 0);
        p0 = __builtin_amdgcn_mfma_f32_32x32x16_bf16(f[g & 1][2], qr[2 * g + 1], p0, 0, 0, 0);
        p1 = __builtin_amdgcn_mfma_f32_32x32x16_bf16(f[g & 1][3], qr[2 * g + 1], p1, 0, 0, 0);
    }
}
#undef FA_DSR
#define FA_TRRD(dst, off) asm volatile("ds_read_b64_tr_b16 %0, %1 offset:%2" : "=&v"(dst) : "v"(vb), "i"(off) : "memory")
template <int NCB>
__device__ __forceinline__ void pv_all(f32x16* o, int vb, bf16x8 pa0, bf16x8 pa1, bf16x8 pa2, bf16x8 pa3) {
    constexpr int HS = NCB * 512, KS = 2 * NCB * 512;
    s16x4 v[2][8];
#define FA_PV_ISSUE(S, D0) do { FA_TRRD(v[S][0], (D0) * 512); FA_TRRD(v[S][1], (D0) * 512 + HS); FA_TRRD(v[S][2], (D0) * 512 + KS); FA_TRRD(v[S][3], (D0) * 512 + KS + HS); \
        FA_TRRD(v[S][4], (D0) * 512 + 2 * KS); FA_TRRD(v[S][5], (D0) * 512 + 2 * KS + HS); FA_TRRD(v[S][6], (D0) * 512 + 3 * KS); FA_TRRD(v[S][7], (D0) * 512 + 3 * KS + HS); } while (0)
    FA_PV_ISSUE(0, 0);
#pragma unroll
    for (int d = 0; d < NCB; ++d) {
        if (d + 1 < NCB) { if ((d + 1) & 1) FA_PV_ISSUE(1, d + 1); else FA_PV_ISSUE(0, d + 1); FA_LGKM(8); }
        else { FA_LGKM(0); }
#define FA_VF(S, k) (bf16x8){v[S][2 * (k)][0], v[S][2 * (k)][1], v[S][2 * (k)][2], v[S][2 * (k)][3], v[S][2 * (k) + 1][0], v[S][2 * (k) + 1][1], v[S][2 * (k) + 1][2], v[S][2 * (k) + 1][3]}
        o[d] = __builtin_amdgcn_mfma_f32_32x32x16_bf16(pa0, FA_VF(d & 1, 0), o[d], 0, 0, 0);
        o[d] = __builtin_amdgcn_mfma_f32_32x32x16_bf16(pa1, FA_VF(d & 1, 1), o[d], 0, 0, 0);
        o[d] = __builtin_amdgcn_mfma_f32_32x32x16_bf16(pa2, FA_VF(d & 1, 2), o[d], 0, 0, 0);
        o[d] = __builtin_amdgcn_mfma_f32_32x32x16_bf16(pa3, FA_VF(d & 1, 3), o[d], 0, 0, 0);
#undef FA_VF
    }
#undef FA_PV_ISSUE
}
#undef FA_TRRD
template <int NCB>
__device__ __forceinline__ void rescale_o(f32x16* o, float alpha, LAS float* al, int r32, int hi) {
    if (__any(alpha < 1.f)) {
        if (hi == 0) al[r32] = alpha;
        asm volatile("s_waitcnt lgkmcnt(0)" ::: "memory");
        float f[16]; const LAS float* alh = al + 4 * hi;
#pragma unroll
        for (int r = 0; r < 16; ++r) f[r] = alh[(r & 3) + 8 * (r >> 2)];
#pragma unroll
        for (int d = 0; d < NCB; ++d)
#pragma unroll
            for (int r = 0; r < 16; ++r) o[d][r] *= f[r];
    }
}
}

namespace mla {
constexpr int KROW = 400, KBUF = 64 * KROW, VBUF = 64 * 128 * 2;
constexpr int L_K = 0, L_V = 2 * KBUF, L_AL = L_V + 2 * VBUF, L_END = L_AL + 8 * 64 * 4;
using namespace fa;
__device__ __forceinline__ void unit(const Ctx& c, unsigned char* lds, int b, int h, int qb) {
    int tid_ = threadIdx.x; asm volatile("" : "+v"(tid_));
    const int tid = tid_, lane = tid & 63, r32 = lane & 31, hi = lane >> 5; const int wid = __builtin_amdgcn_readfirstlane(tid >> 6);
    LAS unsigned char* L = (LAS unsigned char*)lds;
    const size_t rowbase = (size_t)b * SEQ; const int q0 = qb * 256;
    bf16x8 qr[12];
    { const bf16_t* qrow = c.Q1 + (rowbase + q0 + wid * 32 + r32) * 1536 + h * 192 + hi * 8;
#pragma unroll
      for (int d0 = 0; d0 < 12; ++d0) qr[d0] = *(const bf16x8*)(qrow + d0 * 16); }
    const bf16_t* kvb = c.KV1 + rowbase * 2048 + h * 256; const bf16_t* kpb = c.KPE + rowbase * 64;
    const unsigned koff = (unsigned)((tid >> 4) * 2048 + (tid & 15) * 8), kpoff = (unsigned)((tid >> 3) * 64 + (tid & 7) * 8);
    const int kw0 = (tid >> 4) * KROW + (tid & 15) * 16, kpw = (tid >> 3) * KROW + 256 + (tid & 7) * 16;
    const int vw0 = v_st<4>(tid >> 4, (tid & 15) * 8), vw1 = v_st<4>(32 + (tid >> 4), (tid & 15) * 8);
    u32x4 sk0, sk1, skp, sv0, sv1;
#define MLA_LOAD(j) do { const bf16_t* kn_ = kvb + (size_t)(j) * 64 * 2048; sk0 = *(const u32x4*)(kn_ + koff); sk1 = *(const u32x4*)(kn_ + koff + 32 * 2048); sv0 = *(const u32x4*)(kn_ + koff + 128); sv1 = *(const u32x4*)(kn_ + koff + 32 * 2048 + 128); \
        skp = *(const u32x4*)(kpb + (size_t)(j) * 64 * 64 + kpoff); } while (0)
#define MLA_WRITE(B) do { *(LAS u32x4*)(L + L_K + (B) * KBUF + kw0) = sk0; *(LAS u32x4*)(L + L_K + (B) * KBUF + kw0 + 32 * KROW) = sk1; *(LAS u32x4*)(L + L_K + (B) * KBUF + kpw) = skp; \
        *(LAS u32x4*)(L + L_V + (B) * VBUF + vw0) = sv0; *(LAS u32x4*)(L + L_V + (B) * VBUF + vw1) = sv1; } while (0)
    const int kp0 = (int)(uintptr_t)lds + L_K + r32 * KROW + hi * 16;
    const int vb0 = (int)(uintptr_t)lds + L_V + v_rd_base(lane);
    LAS float* al = (LAS float*)(L + L_AL) + wid * 64;
    const int NT = 4 * qb + 4;
    const int qm = q0 + wid * 32 + r32 - 4 * hi;
    float m_reg = -1e30f, l_reg = 0.f; f32x16 o[4] = {};
    MLA_LOAD(0); MLA_WRITE(0); __syncthreads();
#define MLA_STEP(t, B) do { \
        if ((t) + 1 < NT) MLA_LOAD((t) + 1); \
        f32x16 p0, p1; qkt<12, KROW>(p0, p1, kp0 + (B) * KBUF, qr); \
        if ((t) >= NT - 4) mask_tile(p0, p1, qm - 64 * (t), 0x7fffffffu); \
        float alpha; bf16x8 pa0, pa1, pa2, pa3; softmax_tile(p0, p1, m_reg, l_reg, alpha, pa0, pa1, pa2, pa3); \
        rescale_o<4>(o, alpha, al, r32, hi); \
        pv_all<4>(o, vb0 + (B) * VBUF, pa0, pa1, pa2, pa3); \
        if ((t) + 1 < NT) MLA_WRITE((B) ^ 1); \
        __syncthreads(); } while (0)
    for (int t = 0; t < NT; t += 2) { MLA_STEP(t, 0); MLA_STEP(t + 1, 1); }
#undef MLA_STEP
#undef MLA_LOAD
#undef MLA_WRITE
    if (hi == 0) al[r32] = l_reg;
    asm volatile("s_waitcnt lgkmcnt(0)" ::: "memory");
    const size_t orow0 = rowbase + q0 + wid * 32;
    const LAS float* alh = al + 4 * hi;
    const bf16_t* gp0 = c.PC + (orow0 + 4 * hi) * PC_LD + PC_G + h * 128 + r32; bf16_t* op0 = c.O1 + (orow0 + 4 * hi) * DM + h * 128 + r32;
#pragma unroll
    for (int dh = 0; dh < 2; ++dh) {
        float gv[2][16];
#pragma unroll
        for (int r = 0; r < 16; ++r) { const int rc = (r & 3) + 8 * (r >> 2); const bf16_t* gp = gp0 + rc * PC_LD + dh * 64; gv[0][r] = bf2f(gp[0]); gv[1][r] = bf2f(gp[32]); }
#pragma unroll
        for (int r = 0; r < 16; ++r) { const int rc = (r & 3) + 8 * (r >> 2); const float rl = 1.f / alh[rc]; bf16_t* op = op0 + rc * DM + dh * 64;
#pragma unroll
            for (int d1 = 0; d1 < 2; ++d1) { const float v = o[dh * 2 + d1][r] * rl * siluf(gv[d1][r]); const float vn = __shfl_xor(v, 1);
                if ((r32 & 1) == 0) *(unsigned*)(op + d1 * 32) = cvtpk(v, vn); } }
    }
    __syncthreads();
}
__device__ __forceinline__ void phase(const Ctx& c, unsigned char* lds) {
    const int G = gridDim.x, bx = blockIdx.x; const int vcu = (G % 8 == 0) ? (bx % 8) * (G / 8) + bx / 8 : bx;
    for (int item = vcu; item < 256; item += G) {
        const int bh = item >> 2, s_ = item & 3;
#pragma unroll 1
        for (int i = 0; i < 4; ++i) { const int qb = (i == 0) ? s_ : (i == 1) ? 7 - s_ : (i == 2) ? 8 + s_ : 15 - s_; unit(c, lds, bh >> 3, bh & 7, qb); }
    }
}
}

namespace nsa {
using namespace fa;
constexpr int KROW = 144, KBUF = 64 * KROW, VBUF = 64 * 64 * 2;
constexpr int L_K = 0, L_V = 4 * KBUF, L_AL = L_V + 4 * VBUF, L_IMP = L_AL + 8 * 64 * 4, L_SEL = L_IMP + 64 * 64 * 4, L_UNI = L_SEL + 64 * 8, L_END = L_UNI + 64;
#define NSA_QK(st) f32x16 p0, p1; qkt<4, KROW>(p0, p1, kp0 + (st) * KBUF, qr)
#define NSA_SM() float alpha; bf16x8 pa0, pa1, pa2, pa3; softmax_tile(p0, p1, m_reg, l_reg, alpha, pa0, pa1, pa2, pa3)
#define NSA_PV(st) do { rescale_o<2>(o, alpha, al, r32, hi); pv_all<2>(o, vb0 + (st) * VBUF, pa0, pa1, pa2, pa3); } while (0)
#define NSA_LOAD(kptr, vptr) do { sk = *(const u32x4*)(kptr); sv = *(const u32x4*)(vptr); } while (0)
#define NSA_WRITE(st) do { *(LAS u32x4*)(L + L_K + (st) * KBUF + kw) = sk; *(LAS u32x4*)(L + L_V + (st) * VBUF + vw) = sv; } while (0)
#define NSA_FOLD(FIRST, fval) do { if (hi == 0) al[r32] = (fval); asm volatile("s_waitcnt lgkmcnt(0)" ::: "memory"); \
        _Pragma("unroll") for (int r = 0; r < 16; ++r) { const float ff = alh[(r & 3) + 8 * (r >> 2)]; \
            if (FIRST) { ot[0][r] = o[0][r] * ff; ot[1][r] = o[1][r] * ff; } else { ot[0][r] += o[0][r] * ff; ot[1][r] += o[1][r] * ff; } } } while (0)

__device__ __forceinline__ void unit(const Ctx& c, unsigned char* lds, int b, int g, int qt) {
    int tid_ = threadIdx.x; asm volatile("" : "+v"(tid_));
    const int tid = tid_, lane = tid & 63, r32 = lane & 31, hi = lane >> 5; const int wid = __builtin_amdgcn_readfirstlane(tid >> 6);
    LAS unsigned char* L = (LAS unsigned char*)lds;
    const size_t rowbase = (size_t)b * SEQ; const int t0 = qt * 64;
    const int hh = r32 >> 3, qi = 8 * wid + (r32 & 7), head = g * 4 + hh; const int tq = t0 + qi;
    const bf16_t* parow = c.PA + (rowbase + tq) * PA_LD;
    bf16x8 qr[4];
#pragma unroll
    for (int d0 = 0; d0 < 4; ++d0) qr[d0] = *(const bf16x8*)(parow + PA_Q + head * 64 + d0 * 16 + hi * 8);
    const float g_c = sigmoidf_(bf2f(parow[PA_GL + head * 3 + 0])), g_s = sigmoidf_(bf2f(parow[PA_GL + head * 3 + 1])), g_w = sigmoidf_(bf2f(parow[PA_GL + head * 3 + 2]));
    const int skey = tid >> 3, sch = tid & 7;
    const int kw = skey * KROW + sch * 16, vw = v_st<2>(skey, sch * 8);
    const unsigned poff = (unsigned)(skey * PA_LD + sch * 8), coff = (unsigned)(skey * 64 + sch * 8);
    const bf16_t* pab = c.PA + rowbase * PA_LD;
    u32x4 sk, sv;
    const int kp0 = (int)(uintptr_t)lds + L_K + r32 * KROW + hi * 16;
    const int vb0 = (int)(uintptr_t)lds + L_V + v_rd_base(lane);
    LAS float* al = (LAS float*)(L + L_AL) + wid * 64; const LAS float* alh = al + 4 * hi;
    LAS float* IMP = (LAS float*)(L + L_IMP); LAS unsigned* SEL = (LAS unsigned*)(L + L_SEL); LAS unsigned* UNI = (LAS unsigned*)(L + L_UNI);
    f32x16 o[2], ot[2];
    float m_reg, l_reg;

    {   const int NTc = (qt >> 4) + 1;
        const bf16_t* kcb = c.KCMP + (size_t)(b * 2 + g) * 256 * 64; const bf16_t* vcb = c.VCMP + (size_t)(b * 2 + g) * 256 * 64;
        const int cl = (tq - 31) >> 4;
#pragma unroll
        for (int jt = 0; jt < 4; ++jt) if (jt < NTc) { NSA_LOAD(kcb + jt * 4096 + coff, vcb + jt * 4096 + coff); NSA_WRITE(jt); }
        __syncthreads();
        float m_c = -1e30f, l_c = 0.f;
#pragma unroll
        for (int jt = 0; jt < 4; ++jt) if (jt < NTc) {
            NSA_QK(jt);
            mask_tile(p0, p1, cl - 64 * jt - 4 * hi, 0x7fffffffu);
            float pmax = p0[0];
#pragma unroll
            for (int r = 1; r < 16; ++r) pmax = fmaxf(pmax, p0[r]);
#pragma unroll
            for (int r = 0; r < 16; ++r) pmax = fmaxf(pmax, p1[r]);
            { auto rr = __builtin_amdgcn_permlane32_swap(__float_as_uint(pmax), __float_as_uint(pmax), false, false); pmax = fmaxf(__uint_as_float(rr[0]), __uint_as_float(rr[1])); }
            const float mn = fmaxf(m_c, pmax);
            float ps = 0.f;
#pragma unroll
            for (int r = 0; r < 16; ++r) ps += __builtin_amdgcn_exp2f(p0[r] - mn) + __builtin_amdgcn_exp2f(p1[r] - mn);
            { auto rr = __builtin_amdgcn_permlane32_swap(__float_as_uint(ps), __float_as_uint(ps), false, false); ps = __uint_as_float(rr[0]) + __uint_as_float(rr[1]); }
            l_c = l_c * __builtin_amdgcn_exp2f(m_c - mn) + ps; m_c = mn;
        }
        const float inv = l_c > 0.f ? 1.f / l_c : 0.f;
        float carry = 0.f;
        o[0] = f32x16{}; o[1] = f32x16{};
#pragma unroll
        for (int jt = 0; jt < 4; ++jt) if (jt < NTc) {
            NSA_QK(jt);
            mask_tile(p0, p1, cl - 64 * jt - 4 * hi, 0x7fffffffu);
#pragma unroll
            for (int r = 0; r < 16; ++r) { p0[r] = __builtin_amdgcn_exp2f(p0[r] - m_c) * inv; p1[r] = __builtin_amdgcn_exp2f(p1[r] - m_c) * inv; }
            float x0[4], x1[4];
#pragma unroll
            for (int j = 0; j < 4; ++j) {
                { const unsigned e = __float_as_uint(p0[4 * j + 3]); auto rr = __builtin_amdgcn_permlane32_swap(e, e, false, false); x0[j] = __uint_as_float(hi ? rr[0] : rr[1]); }
                { const unsigned e = __float_as_uint(p1[4 * j + 3]); auto rr = __builtin_amdgcn_permlane32_swap(e, e, false, false); x1[j] = __uint_as_float(hi ? rr[0] : rr[1]); } }
#pragma unroll
            for (int j = 0; j < 4; ++j) {
                const float g0 = (p0[4 * j] + p0[4 * j + 1]) + (p0[4 * j + 2] + p0[4 * j + 3]);
                const float g1 = (p1[4 * j] + p1[4 * j + 1]) + (p1[4 * j + 2] + p1[4 * j + 3]);
                const float e0 = hi ? x0[j] : (j > 0 ? x0[j > 0 ? j - 1 : 0] : carry);
                const float e1 = hi ? x1[j] : (j > 0 ? x1[j > 0 ? j - 1 : 0] : x0[3]);
                float v0 = g0 + e0, v1 = g1 + e1;
                v0 += __shfl_xor(v0, 8); v0 += __shfl_xor(v0, 16); v1 += __shfl_xor(v1, 8); v1 += __shfl_xor(v1, 16);
                if (r32 < 8) { IMP[qi * 64 + 16 * jt + 2 * j + hi] = v0; IMP[qi * 64 + 16 * jt + 8 + 2 * j + hi] = v1; } }
            carry = x1[3];
            bf16x8 pa0, pa1, pa2, pa3; pack_p(p0, p1, pa0, pa1, pa2, pa3);
            pv_all<2>(o, vb0 + jt * VBUF, pa0, pa1, pa2, pa3);
        }
        NSA_FOLD(true, g_c);
    }
    __syncthreads();
    {   const int q_ = tid >> 3, sub = tid & 7;
        unsigned bits = 0u;
        if (qt < 16) { for (int e = 0; e < 8; ++e) if (sub * 8 + e <= qt) bits |= 1u << e; }
        else {
            float sc[8]; int rank[8];
#pragma unroll
            for (int e = 0; e < 8; ++e) { const int n = sub * 8 + e; const bool forced = (n == 0) || (n == qt) || (n == qt - 1); sc[e] = (n > qt) ? -1.f : (forced ? 1e4f : IMP[q_ * 64 + n]); rank[e] = 0; }
            for (int m2 = 0; m2 <= qt; ++m2) {
                const bool forced = (m2 == 0) || (m2 == qt) || (m2 == qt - 1); const float sm = forced ? 1e4f : IMP[q_ * 64 + m2];
#pragma unroll
                for (int e = 0; e < 8; ++e) rank[e] += (sm > sc[e] || (sm == sc[e] && m2 < sub * 8 + e)) ? 1 : 0;
            }
#pragma unroll
            for (int e = 0; e < 8; ++e) if (sub * 8 + e <= qt && rank[e] < 16) bits |= 1u << e;
        }
        unsigned lo = (sub < 4) ? (bits << (8 * sub)) : 0u, hi32 = (sub >= 4) ? (bits << (8 * (sub - 4))) : 0u;
        lo |= __shfl_xor(lo, 1); hi32 |= __shfl_xor(hi32, 1); lo |= __shfl_xor(lo, 2); hi32 |= __shfl_xor(hi32, 2); lo |= __shfl_xor(lo, 4); hi32 |= __shfl_xor(hi32, 4);
        if (sub == 0) { SEL[q_ * 2] = lo; SEL[q_ * 2 + 1] = hi32; }
        lo |= __shfl_xor(lo, 8); hi32 |= __shfl_xor(hi32, 8); lo |= __shfl_xor(lo, 16); hi32 |= __shfl_xor(hi32, 16); lo |= __shfl_xor(lo, 32); hi32 |= __shfl_xor(hi32, 32);
        if (lane == 0) { UNI[wid * 2] = lo; UNI[wid * 2 + 1] = hi32; }
    }
    __syncthreads();
    unsigned long long uni = 0ull;
#pragma unroll
    for (int w2 = 0; w2 < 8; ++w2) uni |= (unsigned long long)UNI[w2 * 2] | ((unsigned long long)UNI[w2 * 2 + 1] << 32);
    uni = ((unsigned long long)__builtin_amdgcn_readfirstlane((unsigned)(uni >> 32)) << 32) | (unsigned long long)__builtin_amdgcn_readfirstlane((unsigned)uni);
    const unsigned long long selm = (unsigned long long)SEL[qi * 2] | ((unsigned long long)SEL[qi * 2 + 1] << 32);

    {   m_reg = -1e30f; l_reg = 0.f; o[0] = f32x16{}; o[1] = f32x16{};
        unsigned long long rem = uni;
        int cur = __builtin_ctzll(rem); rem &= rem - 1; int st = 0;
        NSA_LOAD(pab + (size_t)cur * 64 * PA_LD + PA_KS + g * 64 + poff, pab + (size_t)cur * 64 * PA_LD + PA_VS + g * 64 + poff); NSA_WRITE(0); __syncthreads();
        for (;;) {
            const bool more = rem != 0ull; int nxt = 0;
            if (more) { nxt = __builtin_ctzll(rem); rem &= rem - 1; NSA_LOAD(pab + (size_t)nxt * 64 * PA_LD + PA_KS + g * 64 + poff, pab + (size_t)nxt * 64 * PA_LD + PA_VS + g * 64 + poff); }
            const bool on = ((selm >> cur) & 1ull) != 0ull;
            {   NSA_QK(st);
                if (cur == qt) mask_tile(p0, p1, qi - 4 * hi, 0x7fffffffu);
                if (!on) { const float NEG = -__builtin_inff();
#pragma unroll
                    for (int r = 0; r < 16; ++r) { p0[r] = NEG; p1[r] = NEG; } }
                NSA_SM();
                NSA_PV(st);
            }
            if (more) NSA_WRITE(st ^ 1);
            __syncthreads();
            if (!more) break;
            cur = nxt; st ^= 1;
        }
        NSA_FOLD(false, g_s / l_reg);
    }
    {   m_reg = -1e30f; l_reg = 0.f; o[0] = f32x16{}; o[1] = f32x16{};
        const int j0 = qt >= 8 ? 0 : 8 - qt;
        const bf16_t* wb = pab + (ptrdiff_t)(t0 - 512) * PA_LD;
        int st = 0;
        NSA_LOAD(wb + (ptrdiff_t)j0 * 64 * PA_LD + PA_KW + g * 64 + poff, wb + (ptrdiff_t)j0 * 64 * PA_LD + PA_VW + g * 64 + poff); NSA_WRITE(0); __syncthreads();
        for (int j = j0; j < 9; ++j) {
            if (j + 1 < 9) NSA_LOAD(wb + (ptrdiff_t)(j + 1) * 64 * PA_LD + PA_KW + g * 64 + poff, wb + (ptrdiff_t)(j + 1) * 64 * PA_LD + PA_VW + g * 64 + poff);
            {   NSA_QK(st);
                if (j == 0 || j == 8) mask_tile(p0, p1, qi + 512 - 64 * j - 4 * hi, 512u);
                NSA_SM();
                NSA_PV(st);
            }
            if (j + 1 < 9) NSA_WRITE(st ^ 1);
            __syncthreads();
            st ^= 1;
        }
        NSA_FOLD(false, g_w / l_reg);
    }
    {
        float gv[2][16];
#pragma unroll
        for (int r = 0; r < 16; ++r) { const int row = (r & 3) + 8 * (r >> 2) + 4 * hi; const int hd = g * 4 + (row >> 3); const size_t m = rowbase + t0 + 8 * wid + (row & 7);
            const bf16_t* gp = c.PA + m * PA_LD + PA_GA + hd * 64 + r32; gv[0][r] = bf2f(gp[0]); gv[1][r] = bf2f(gp[32]); }
#pragma unroll
        for (int r = 0; r < 16; ++r) { const int row = (r & 3) + 8 * (r >> 2) + 4 * hi; const int hd = g * 4 + (row >> 3); const size_t m = rowbase + t0 + 8 * wid + (row & 7);
            bf16_t* op = c.MIX + m * DM + hd * 64 + r32;
#pragma unroll
            for (int d0 = 0; d0 < 2; ++d0) { const float v = ot[d0][r] * siluf(gv[d0][r]); const float vn = __shfl_xor(v, 1);
                if ((r32 & 1) == 0) *(unsigned*)(op + d0 * 32) = cvtpk(v, vn); } }
    }
    __syncthreads();
}
#undef NSA_QK
#undef NSA_SM
#undef NSA_PV
#undef NSA_LOAD
#undef NSA_WRITE
#undef NSA_FOLD
__device__ __forceinline__ void phase(const Ctx& c, unsigned char* lds) {
    const int G = gridDim.x, bx = blockIdx.x; const int vcu = (G % 8 == 0) ? (bx % 8) * (G / 8) + bx / 8 : bx;
    for (int item = vcu; item < 256; item += G) {
        const int bg = item >> 4, s_ = item & 15;
#pragma unroll 1
        for (int i = 0; i < 4; ++i) { const int qt = (i == 0) ? s_ : (i == 1) ? 63 - s_ : (i == 2) ? 16 + s_ : 47 - s_; unit(c, lds, bg >> 1, bg & 1, qt); }
    }
}
}

__device__ __forceinline__ int natA(int p) {
    if (p < 768) { const int T = p >> 8, q = p & 255, half = q >> 7, hh = (q & 127) >> 5, i = q & 31;
        const int base = (T == 0) ? 64 * hh : (T == 1) ? 256 + 64 * hh : (hh < 2 ? 768 + 64 * hh : 1024 + 64 * (hh - 2));
        return base + 32 * half + i; }
    if (p < 1024) return 512 + (p - 768);
    if (p < 1152) return 896 + (p - 1024);
    if (p < 1280) return p;
    if (p < 3840) return p + 24;
    if (p < 3864) return 1280 + (p - 3840);
    return -1;
}
__device__ __forceinline__ int natC(int p) {
    if (p < 512) return p;
    if (p < 1536) return p + 64;
    const int q = p - 1536;
    if (q < 32) return 512 + q;
    if (q >= 128 && q < 160) return 512 + 32 + (q - 128);
    return -1;
}
__device__ __forceinline__ int natUQ(int p) {
    if (p < 1024) return (p >> 7) * 192 + (p & 127);
    const int q = p - 1024, T = q >> 8, r = q & 255, half = r >> 7, hh = (r & 127) >> 5, i = r & 31;
    return (T * 4 + hh) * 192 + 128 + 32 * half + i;
}
__device__ __forceinline__ unsigned pk2(float lo, float hi) { return (unsigned)f2bf(lo) | ((unsigned)f2bf(hi) << 16); }
template <int MAP>
__device__ __forceinline__ void transpose_item(const float* W, int K, int Nsrc, int Ndst, bf16_t* WT, float* scr, int item, int lane) {
    const int nblk = Ndst / 32, kb = item / nblk, nb = item % nblk, k0 = 64 * kb, p0 = 32 * nb;
    const int p = p0 + (lane & 31);
    const int sc = (MAP == 0) ? natA(p) : (MAP == 1) ? natC(p) : (MAP == 3) ? natUQ(p) : p;
#pragma unroll 8
    for (int i = 0; i < 32; ++i) { const int kk = 2 * i + (lane >> 5); scr[kk * 33 + (lane & 31)] = (sc >= 0) ? W[(size_t)(k0 + kk) * Nsrc + sc] : 0.f; }
    WSYNC();
    const int c = lane & 7;
#pragma unroll
    for (int j = 0; j < 4; ++j) { const int n = (lane >> 3) + 8 * j; const float* sp = scr + (8 * c) * 33 + n;
        uint4 o; o.x = pk2(sp[0 * 33], sp[1 * 33]); o.y = pk2(sp[2 * 33], sp[3 * 33]); o.z = pk2(sp[4 * 33], sp[5 * 33]); o.w = pk2(sp[6 * 33], sp[7 * 33]);
        *(uint4*)(WT + (size_t)(p0 + n) * K + k0 + 8 * c) = o; }
    WSYNC();
}
__device__ __forceinline__ void ph0_weights(const Ctx& c, unsigned char* lds) {
    const int lane = threadIdx.x & 63, wave = threadIdx.x >> 6;
    float* scr = (float*)(lds + wave * 16384);
    const int gw = blockIdx.x * NWV + wave, NGW = gridDim.x * NWV;
    constexpr int I_A = 16 * 128, I_OA = 16 * 32, I_C = 16 * 56, I_UQ = 4 * 48, I_UKV = 4 * 64, I_OC = 16 * 32;
    constexpr int NITEMS = I_A + I_OA + I_C + I_UQ + I_UKV + I_OC;
    for (int it = gw; it < NITEMS; it += NGW) {
        int r = it;
        if (r < I_A) { transpose_item<0>(c.a_w_in, 1024, NIN_A, 4096, (bf16_t*)(c.ws + WS_WTA), scr, r, lane); continue; } r -= I_A;
        if (r < I_OA) { transpose_item<2>(c.a_w_out, 1024, 1024, 1024, (bf16_t*)(c.ws + WS_WTOA), scr, r, lane); continue; } r -= I_OA;
        if (r < I_C) { transpose_item<1>(c.c_w_in, 1024, NIN_C, 1792, (bf16_t*)(c.ws + WS_WTC), scr, r, lane); continue; } r -= I_C;
        if (r < I_UQ) { transpose_item<3>(c.w_uq, 256, 1536, 1536, (bf16_t*)(c.ws + WS_WTUQ), scr, r, lane); continue; } r -= I_UQ;
        if (r < I_UKV) { transpose_item<2>(c.w_ukv, 256, 2048, 2048, (bf16_t*)(c.ws + WS_WTUKV), scr, r, lane); continue; } r -= I_UKV;
        transpose_item<2>(c.c_w_out, 1024, 1024, 1024, (bf16_t*)(c.ws + WS_WTOC), scr, r, lane);
    }
}

__device__ __forceinline__ void ph0_prologue(const Ctx& c) {
    for (int idx = blockIdx.x * NTHR + threadIdx.x; idx < M * 32; idx += gridDim.x * NTHR) {
        const int m = idx >> 5, i = idx & 31;
        const float invf = (float)exp2(-(double)i * (13.287712379549449 / 32.0));
        const float ang = (float)c.pos[m] * invf;
        float s, co; sincos_acc(ang, s, co);
        c.CS[idx] = make_float2(co, s);
    }
    const int lane = threadIdx.x & 63, gw = blockIdx.x * NWV + (threadIdx.x >> 6), NGW = gridDim.x * NWV;
    for (int m = gw; m < M; m += NGW) rms_row_f32(c.x + (size_t)m * DM, c.a_norm, c.XN + (size_t)m * DM, lane);
}
__device__ __forceinline__ int pa_col(int n) { return n < 1280 ? n : (n < 1304 ? PA_GL + (n - 1280) : n - 24); }
__device__ __forceinline__ int pc_col(int n) { return n < 512 ? n : (n < 576 ? PC_KR + (n - 512) : n - 64); }

__device__ __forceinline__ void ph2_rope_a(const Ctx& c) {
    for (size_t idx = (size_t)blockIdx.x * NTHR + threadIdx.x; idx < (size_t)M * 12 * 32; idx += (size_t)gridDim.x * NTHR) {
        const int i = (int)(idx & 31); const size_t r = idx >> 5; const int slot = (int)(r % 12); const int m = (int)(r / 12);
        const int base = slot < 8 ? PA_Q + slot * 64 : (slot < 10 ? PA_KS + (slot - 8) * 64 : PA_KW + (slot - 10) * 64);
        const float sc = slot < 8 ? QSCALE_A : 1.f;
        bf16_t* p = c.PA + (size_t)m * PA_LD + base + i;
        const float x1 = bf2f(p[0]), x2 = bf2f(p[32]);
        const float2 cs = c.CS[(size_t)m * 32 + i];
        p[0] = f2bf((x1 * cs.x - x2 * cs.y) * sc); p[32] = f2bf((x2 * cs.x + x1 * cs.y) * sc);
    }
}

__device__ __forceinline__ void ph3_compress(const Ctx& c, unsigned char* lds) {
    float* blk = (float*)lds;
    float* part = blk + 8 * 2048;
    float* hid = part + 4 * 8 * 128;
    float* outp = hid + 8 * 128;
    float* outs = outp + 8 * 8 * 64;
    const int tid = threadIdx.x;
    for (int item = blockIdx.x; item < 2 * BATCH * 2 * 32; item += gridDim.x) {
        const int ct = item & 31, g = (item >> 5) & 1, b = (item >> 6) & 7, kv = item >> 9;
        const float* pe = kv ? c.pe_v : c.pe_k; const float* w1 = kv ? c.w_cv1 : c.w_ck1; const float* w2 = kv ? c.w_cv2 : c.w_ck2;
        const int col0 = (kv ? PA_VC : PA_KC) + g * 64;
        __syncthreads();
        for (int e = tid; e < 8 * 2048; e += NTHR) {
            const int ci = e >> 11, k = e & 2047, l = k >> 6, d = k & 63; const int cidx = ct * 8 + ci;
            float v = 0.f;
            if (cidx < 255) v = bf2f(c.PA[(size_t)(b * SEQ + 16 * cidx + l) * PA_LD + col0 + d]) + pe[l * 64 + d];
            blk[e] = v;
        }
        __syncthreads();
        {   const int j = tid & 127, pt = tid >> 7;
            float acc[8];
#pragma unroll
            for (int ci = 0; ci < 8; ++ci) acc[ci] = 0.f;
            for (int k = pt * 512; k < pt * 512 + 512; ++k) {
                const float w = w1[(size_t)k * 128 + j];
#pragma unroll
                for (int ci = 0; ci < 8; ++ci) acc[ci] = fmaf(blk[ci * 2048 + k], w, acc[ci]);
            }
#pragma unroll
            for (int ci = 0; ci < 8; ++ci) part[(pt * 8 + ci) * 128 + j] = acc[ci];
        }
        __syncthreads();
        for (int e = tid; e < 8 * 128; e += NTHR) { const int ci = e >> 7, j = e & 127; const float s = (part[(0 * 8 + ci) * 128 + j] + part[(1 * 8 + ci) * 128 + j]) + (part[(2 * 8 + ci) * 128 + j] + part[(3 * 8 + ci) * 128 + j]); hid[e] = siluf(s); }
        __syncthreads();
        {   const int d = tid & 63, pt = tid >> 6;
            float acc[8];
#pragma unroll
            for (int ci = 0; ci < 8; ++ci) acc[ci] = 0.f;
            for (int j = pt * 16; j < pt * 16 + 16; ++j) {
                const float w = w2[j * 64 + d];
#pragma unroll
                for (int ci = 0; ci < 8; ++ci) acc[ci] = fmaf(hid[ci * 128 + j], w, acc[ci]);
            }
#pragma unroll
            for (int ci = 0; ci < 8; ++ci) outp[(pt * 8 + ci) * 64 + d] = acc[ci];
        }
        __syncthreads();
        {   const int ci = tid >> 6, d = tid & 63; float s = 0.f;
#pragma unroll
            for (int pt = 0; pt < 8; ++pt) s += outp[(pt * 8 + ci) * 64 + d];
            outs[ci * 64 + d] = s; }
        __syncthreads();
        {   const int ci = tid >> 6, d = tid & 63; const int cidx = ct * 8 + ci;
            float v = outs[ci * 64 + d];
            if (kv == 0 && cidx < 255) {
                const int i = d & 31; const float2 cs = c.CS[(size_t)(b * SEQ + 16 * cidx + 31) * 32 + i];
                const float x1 = outs[ci * 64 + i], x2 = outs[ci * 64 + i + 32];
                v = (d < 32) ? (x1 * cs.x - x2 * cs.y) : (x2 * cs.x + x1 * cs.y);
            }
            if (cidx >= 255) v = 0.f;
            bf16_t* dst = (kv ? c.VCMP : c.KCMP) + ((size_t)(b * 2 + g) * 256 + cidx) * 64 + d;
            *dst = f2bf(v);
        }
    }
    __syncthreads();
}

__device__ __forceinline__ float dot64(const bf16_t* krow, const float* q) {
    float s = 0.f;
#pragma unroll
    for (int ch = 0; ch < 8; ++ch) {
        const uint4 v = *(const uint4*)(krow + ch * 8);
        const unsigned w[4] = {v.x, v.y, v.z, v.w};
#pragma unroll
        for (int e = 0; e < 4; ++e) { s = fmaf(__uint_as_float(w[e] << 16), q[ch * 8 + 2 * e], s); s = fmaf(__uint_as_float(w[e] & 0xffff0000u), q[ch * 8 + 2 * e + 1], s); }
    }
    return s;
}

__device__ __forceinline__ void ph4_nsa(const Ctx& c, unsigned char* lds) {
    const int lane = threadIdx.x & 63, wave = threadIdx.x >> 6;
    float* wq = (float*)(lds + wave * 12288);
    float* wp = wq + 64;
    float* wpc = wp + 1024;
    float* wres = wpc + 1024;
    const int gw = blockIdx.x * NWV + wave, NGW = gridDim.x * NWV;
    for (int item = gw; item < M * 2; item += NGW) {
        const int g = item & 1, m = item >> 1; const int b = m / SEQ, t = m % SEQ;
        const bf16_t* parow = c.PA + (size_t)m * PA_LD;
        const bf16_t* pab = c.PA + (size_t)b * SEQ * PA_LD;
        const bf16_t* kc = c.KCMP + (size_t)(b * 2 + g) * 256 * 64; const bf16_t* vc = c.VCMP + (size_t)(b * 2 + g) * 256 * 64;
        const int nvalid = t >= 31 ? min((t - 31) / 16 + 1, 255) : 0;
        for (int hh = 0; hh < 4; ++hh) {
            const int head = g * 4 + hh;
            WSYNC(); wq[lane] = bf2f(parow[PA_Q + head * 64 + lane]); WSYNC();
            float s[4]; float mx = -INFINITY;
#pragma unroll
            for (int jj = 0; jj < 4; ++jj) { const int ci = lane + 64 * jj; s[jj] = (ci < nvalid) ? dot64(kc + (size_t)ci * 64, wq) : -INFINITY; mx = fmaxf(mx, s[jj]); }
            mx = wave_max(mx);
            float sum = 0.f;
#pragma unroll
            for (int jj = 0; jj < 4; ++jj) { s[jj] = (nvalid > 0) ? exp2f(s[jj] - mx) : 0.f; sum += s[jj]; }
            sum = wave_sum(sum);
            const float inv = nvalid > 0 ? 1.f / sum : 0.f;
#pragma unroll
            for (int jj = 0; jj < 4; ++jj) wpc[hh * 256 + lane + 64 * jj] = s[jj] * inv;
            WSYNC();
            float o = 0.f;
            for (int ci = 0; ci < nvalid; ++ci) o = fmaf(wpc[hh * 256 + ci], bf2f(vc[(size_t)ci * 64 + lane]), o);
            wres[(hh * 3 + 0) * 64 + lane] = o;
        }
        unsigned long long selmask;
        {   const int n = lane; float imp = 0.f;
            const int c_lo = max(4 * n - 1, 0), c_hi = min(4 * n + 3, 254);
            for (int hh = 0; hh < 4; ++hh) for (int ci = c_lo; ci <= c_hi; ++ci) imp += wpc[hh * 256 + ci];
            const bool bv = (64 * n <= t); const int cur = t >> 6;
            const bool forced = (n == 0) || (n == cur) || (n == cur - 1);
            const float sc = bv ? (forced ? 1e4f : imp) : -1.f;
            int rank = 0;
            for (int mm = 0; mm < 64; ++mm) { const float o = __shfl(sc, mm); rank += (o > sc || (o == sc && mm < n)) ? 1 : 0; }
            selmask = __ballot(rank < 16 && bv);
        }
        for (int hh = 0; hh < 4; ++hh) {
            const int head = g * 4 + hh;
            WSYNC(); wq[lane] = bf2f(parow[PA_Q + head * 64 + lane]); WSYNC();
            {   unsigned long long sm = selmask; int slot = 0; float mx = -INFINITY;
                while (sm) { const int n = __builtin_ctzll(sm); sm &= sm - 1; const int tok = n * 64 + lane;
                    const float s = (tok <= t) ? dot64(pab + (size_t)tok * PA_LD + PA_KS + g * 64, wq) : -INFINITY;
                    wp[slot * 64 + lane] = s; mx = fmaxf(mx, s); ++slot; }
                mx = wave_max(mx);
                float sum = 0.f;
                for (int sl = 0; sl < slot; ++sl) { const float p = exp2f(wp[sl * 64 + lane] - mx); wp[sl * 64 + lane] = p; sum += p; }
                sum = wave_sum(sum); WSYNC();
                float o = 0.f; sm = selmask; slot = 0;
                while (sm) { const int n = __builtin_ctzll(sm); sm &= sm - 1;
                    const int kmax = min(63, t - n * 64);
                    for (int kk = 0; kk <= kmax; ++kk) o = fmaf(wp[slot * 64 + kk], bf2f(pab[(size_t)(n * 64 + kk) * PA_LD + PA_VS + g * 64 + lane]), o);
                    ++slot; }
                wres[(hh * 3 + 1) * 64 + lane] = o / sum; }
            WSYNC();
            {   float mx = -INFINITY;
                for (int j = 0; j < 8; ++j) { const int kp = t - 511 + 64 * j + lane;
                    const float s = (kp >= 0) ? dot64(pab + (size_t)kp * PA_LD + PA_KW + g * 64, wq) : -INFINITY;
                    wp[j * 64 + lane] = s; mx = fmaxf(mx, s); }
                mx = wave_max(mx);
                float sum = 0.f;
                for (int j = 0; j < 8; ++j) { const float p = exp2f(wp[j * 64 + lane] - mx); wp[j * 64 + lane] = p; sum += p; }
                sum = wave_sum(sum); WSYNC();
                float o = 0.f;
                const int k_lo = max(0, 511 - t);
                for (int kk = k_lo; kk < 512; ++kk) o = fmaf(wp[kk], bf2f(pab[(size_t)(t - 511 + kk) * PA_LD + PA_VW + g * 64 + lane]), o);
                wres[(hh * 3 + 2) * 64 + lane] = o / sum; }
        }
        for (int hh = 0; hh < 4; ++hh) {
            const int head = g * 4 + hh;
            const float g0 = sigmoidf_(bf2f(parow[PA_GL + head * 3 + 0])), g1 = sigmoidf_(bf2f(parow[PA_GL + head * 3 + 1])), g2 = sigmoidf_(bf2f(parow[PA_GL + head * 3 + 2]));
            const float o = g0 * wres[(hh * 3 + 0) * 64 + lane] + g1 * wres[(hh * 3 + 1) * 64 + lane] + g2 * wres[(hh * 3 + 2) * 64 + lane];
            const float ga = bf2f(parow[PA_GA + head * 64 + lane]);
            c.MIX[(size_t)m * DM + head * 64 + lane] = f2bf(siluf(ga) * o);
        }
    }
}

__device__ __forceinline__ void ph5_conv(const Ctx& c) {
    for (size_t idx = (size_t)blockIdx.x * NTHR + threadIdx.x; idx < (size_t)M * 512; idx += (size_t)gridDim.x * NTHR) {
        const int ch = (int)(idx & 511); const int m = (int)(idx >> 9); const int t = m % SEQ;
        const bf16_t* r0 = c.PA + (size_t)m * PA_LD;
        float y = c.conv_w[2 * 512 + ch] * bf2f(r0[PA_CC + ch]) * bf2f(r0[PA_CH + ch]);
        if (t >= 1) { const bf16_t* r1 = r0 - PA_LD; y += c.conv_w[1 * 512 + ch] * bf2f(r1[PA_CC + ch]) * bf2f(r1[PA_CH + ch]); }
        if (t >= 2) { const bf16_t* r2 = r0 - 2 * PA_LD; y += c.conv_w[0 * 512 + ch] * bf2f(r2[PA_CC + ch]) * bf2f(r2[PA_CH + ch]); }
        c.MIX[(size_t)m * DM + 512 + ch] = f2bf(siluf(bf2f(r0[PA_GB + ch])) * bf2f(r0[PA_CB + ch]) * y);
    }
}

__device__ __forceinline__ void ph7_norm1(const Ctx& c) {
    const int lane = threadIdx.x & 63, gw = blockIdx.x * NWV + (threadIdx.x >> 6), NGW = gridDim.x * NWV;
    for (int m = gw; m < M; m += NGW) rms_row_f32(c.out + (size_t)m * DM, c.c_norm, c.XN + (size_t)m * DM, lane);
}
__device__ __forceinline__ void ph_final(const Ctx& c) {
    const int lane = threadIdx.x & 63, gw = blockIdx.x * NWV + (threadIdx.x >> 6), NGW = gridDim.x * NWV;
    for (int m = gw; m < M; m += NGW) {
        float* xr = c.out + (size_t)m * DM;
        float4 v[4]; float s = 0.f;
#pragma unroll
        for (int j = 0; j < 4; ++j) { v[j] = *(const float4*)(xr + 4 * lane + 256 * j); s += (v[j].x * v[j].x + v[j].y * v[j].y) + (v[j].z * v[j].z + v[j].w * v[j].w); }
        const float rstd = 1.f / sqrtf(wave_sum(s) * (1.f / DM) + RMS_EPS);
#pragma unroll
        for (int j = 0; j < 4; ++j) { const float4 gg = *(const float4*)(c.final_norm + 4 * lane + 256 * j);
            float4 o; o.x = v[j].x * rstd * gg.x; o.y = v[j].y * rstd * gg.y; o.z = v[j].z * rstd * gg.z; o.w = v[j].w * rstd * gg.w;
            *(float4*)(xr + 4 * lane + 256 * j) = o; }
    }
}

__device__ __forceinline__ void ph9_lat_norm(const Ctx& c) {
    const int lane = threadIdx.x & 63, gw = blockIdx.x * NWV + (threadIdx.x >> 6), NGW = gridDim.x * NWV;
    for (int m = gw; m < M; m += NGW) {
        const bf16_t* r = c.PC + (size_t)m * PC_LD;
#pragma unroll
        for (int w = 0; w < 2; ++w) {
            const ushort4 v = *(const ushort4*)(r + (w ? PC_CKV : PC_CQ) + 4 * lane);
            const float a0 = bf2f(v.x), a1 = bf2f(v.y), a2 = bf2f(v.z), a3 = bf2f(v.w);
            const float rstd = 1.f / sqrtf(wave_sum(a0 * a0 + a1 * a1 + a2 * a2 + a3 * a3) * (1.f / 256.f) + RMS_EPS);
            const float4 gg = *(const float4*)((w ? c.kv_norm : c.q_norm) + 4 * lane);
            ushort4 o; o.x = f2bf(a0 * rstd * gg.x); o.y = f2bf(a1 * rstd * gg.y); o.z = f2bf(a2 * rstd * gg.z); o.w = f2bf(a3 * rstd * gg.w);
            *(ushort4*)((w ? c.CKVN : c.CQN) + (size_t)m * 256 + 4 * lane) = o;
        }
        if (lane < 32) {
            const float x1 = bf2f(r[PC_KR + lane]), x2 = bf2f(r[PC_KR + lane + 32]); const float2 cs = c.CS[(size_t)m * 32 + lane];
            c.KPE[(size_t)m * 64 + lane] = f2bf(x1 * cs.x - x2 * cs.y); c.KPE[(size_t)m * 64 + lane + 32] = f2bf(x2 * cs.x + x1 * cs.y);
        }
    }
}
__device__ __forceinline__ void ph11_rope_q1(const Ctx& c) {
    for (size_t idx = (size_t)blockIdx.x * NTHR + threadIdx.x; idx < (size_t)M * 8 * 96; idx += (size_t)gridDim.x * NTHR) {
        const int e = (int)(idx % 96); const size_t r = idx / 96; const int h = (int)(r & 7); const int m = (int)(r >> 3);
        bf16_t* q = c.Q1 + (size_t)m * 1536 + h * 192;
        if (e < 64) { q[e] = f2bf(bf2f(q[e]) * QSCALE_C); q[e + 64] = f2bf(bf2f(q[e + 64]) * QSCALE_C); }
        else { const int i = e - 64; const float2 cs = c.CS[(size_t)m * 32 + i];
            const float x1 = bf2f(q[128 + i]), x2 = bf2f(q[160 + i]);
            q[128 + i] = f2bf((x1 * cs.x - x2 * cs.y) * QSCALE_C); q[160 + i] = f2bf((x2 * cs.x + x1 * cs.y) * QSCALE_C); }
    }
}
__device__ __forceinline__ void ph12_mla(const Ctx& c, unsigned char* lds) {
    const int lane = threadIdx.x & 63, wave = threadIdx.x >> 6;
    float* wq = (float*)(lds + wave * 2048);
    float* wp = wq + 192;
    const int gw = blockIdx.x * NWV + wave, NGW = gridDim.x * NWV;
    for (int item = gw; item < M * 8; item += NGW) {
        const int h = item & 7, m = item >> 3; const int b = m / SEQ, t = m % SEQ;
        WSYNC();
        const bf16_t* qrow = c.Q1 + (size_t)m * 1536 + h * 192;
        wq[lane] = bf2f(qrow[lane]); wq[64 + lane] = bf2f(qrow[64 + lane]); wq[128 + lane] = bf2f(qrow[128 + lane]);
        WSYNC();
        float mrun = -1e30f, l = 0.f, o0 = 0.f, o1 = 0.f;
        const bf16_t* kvb = c.KV1 + (size_t)b * SEQ * 2048 + h * 256; const bf16_t* kpb = c.KPE + (size_t)b * SEQ * 64;
        for (int k0 = 0; k0 <= t; k0 += 64) {
            const int key = k0 + lane;
            float s = -INFINITY;
            if (key <= t) { const bf16_t* kr = kvb + (size_t)key * 2048; s = dot64(kr, wq) + dot64(kr + 64, wq + 64) + dot64(kpb + (size_t)key * 64, wq + 128); }
            const float cm = wave_max(s);
            const float mn = fmaxf(mrun, cm); const float alpha = exp2f(mrun - mn); mrun = mn;
            const float p = exp2f(s - mn);
            l = l * alpha + wave_sum(p); o0 *= alpha; o1 *= alpha;
            WSYNC(); wp[lane] = p; WSYNC();
            const int kmax = min(63, t - k0);
            for (int kk = 0; kk <= kmax; ++kk) { const bf16_t* vr = kvb + (size_t)(k0 + kk) * 2048 + 128; const float pp = wp[kk]; o0 = fmaf(pp, bf2f(vr[lane]), o0); o1 = fmaf(pp, bf2f(vr[64 + lane]), o1); }
        }
        const float inv = 1.f / l;
        const bf16_t* gr = c.PC + (size_t)m * PC_LD + PC_G + h * 128;
        c.O1[(size_t)m * DM + h * 128 + lane] = f2bf(siluf(bf2f(gr[lane])) * o0 * inv);
        c.O1[(size_t)m * DM + h * 128 + 64 + lane] = f2bf(siluf(bf2f(gr[64 + lane])) * o1 * inv);
    }
}

constexpr int NPHASE = 15;
__global__ void __launch_bounds__(NTHR, 2) mk_fwd(Args a) {
    extern __shared__ __attribute__((aligned(16))) unsigned char lds[];
    Ctx c;
    c.x = (const float*)a.in[0]; c.pos = (const int*)a.in[1]; c.a_norm = (const float*)a.in[2]; c.a_w_in = (const float*)a.in[3]; c.pe_k = (const float*)a.in[4]; c.pe_v = (const float*)a.in[5];
    c.w_ck1 = (const float*)a.in[6]; c.w_ck2 = (const float*)a.in[7]; c.w_cv1 = (const float*)a.in[8]; c.w_cv2 = (const float*)a.in[9]; c.conv_w = (const float*)a.in[10]; c.a_w_out = (const float*)a.in[11];
    c.c_norm = (const float*)a.in[12]; c.c_w_in = (const float*)a.in[13]; c.q_norm = (const float*)a.in[14]; c.kv_norm = (const float*)a.in[15]; c.w_uq = (const float*)a.in[16]; c.w_ukv = (const float*)a.in[17];
    c.c_w_out = (const float*)a.in[18]; c.final_norm = (const float*)a.in[19];
    c.out = a.out; c.ws = a.ws;
    c.CS = (float2*)(a.ws + WS_CS); c.KCMP = (bf16_t*)(a.ws + WS_KCMP); c.VCMP = (bf16_t*)(a.ws + WS_VCMP); c.XN = (bf16_t*)(a.ws + WS_XN); c.PA = (bf16_t*)(a.ws + WS_PA);
    c.MIX = (bf16_t*)(a.ws + WS_MIX); c.PC = (bf16_t*)(a.ws + WS_PC); c.Q1 = (bf16_t*)(a.ws + WS_Q1); c.KV1 = (bf16_t*)(a.ws + WS_KV1); c.CQN = (bf16_t*)(a.ws + WS_CQN);
    c.CKVN = (bf16_t*)(a.ws + WS_CKVN); c.KPE = (bf16_t*)(a.ws + WS_KPE); c.O1 = (bf16_t*)(a.ws + WS_O1);

    volatile LAS unsigned* misc = (volatile LAS unsigned*)((LAS unsigned char*)lds + (LDS_BYTES - 64));
    if (threadIdx.x < 16) misc[threadIdx.x] = 0u;
    __syncthreads();
    XcdBarrier bar; bar.bar = (unsigned*)(a.ws + WS_CTL) + 4096; bar.x = 0; bar.st = misc;
    const bool multi = (a.hi - a.lo) > 1;
    if (multi) bar = xcd_barrier_post((unsigned*)(a.ws + WS_CTL) + 4096, misc);

#ifndef PROBE_DUP
#define PROBE_DUP -1
#endif
#define PHASE(k, ...) if (a.lo <= (k) && (k) < a.hi) { __VA_ARGS__; if ((k) == PROBE_DUP) { xcd_barrier(bar); __VA_ARGS__; } if ((k) + 1 < a.hi) xcd_barrier(bar); }
    LAS unsigned char* ldsl = (LAS unsigned char*)lds;
    PHASE(0, { ph0_weights(c, lds); ph0_prologue(c); })
    PHASE(1, { pg8::Gemm g{c.XN, (const bf16_t*)(c.ws + WS_WTA), M, 4096, 1024}; pg8::StaticOrder S; S.init(M, 4096, gridDim.x, blockIdx.x);
               pg8::EpiPA E{c.PA, c.CS}; pg8::gemm_phase<pg8::EpiPA, pg8::StaticOrder, true, true>(ldsl, g, S, E); })
    PHASE(3, ph3_compress(c, lds))
    PHASE(4, nsa::phase(c, lds))
    PHASE(5, ph5_conv(c))
    PHASE(6, { pg8::Gemm g{c.MIX, (const bf16_t*)(c.ws + WS_WTOA), M, 1024, 1024}; pg8::StaticOrder S; S.init(M, 1024, gridDim.x, blockIdx.x);
               pg8::EpiRes2 E{c.x, c.out, c.XN, c.c_norm, (float*)(c.ws + WS_STAT1)}; pg8::gemm_phase<pg8::EpiRes2, pg8::StaticOrder, true, true>(ldsl, g, S, E); })
    PHASE(8, { pg8::Gemm g{c.XN, (const bf16_t*)(c.ws + WS_WTC), M, 1792, 1024}; pg8::StaticOrder S; S.init(M, 1792, gridDim.x, blockIdx.x);
               pg8::EpiPC2 E{c.PC, c.CQN, c.CKVN, c.KPE, c.q_norm, c.kv_norm, (const float*)(c.ws + WS_STAT1), (float*)(c.ws + WS_STAT2), c.CS};
               pg8::gemm_phase<pg8::EpiPC2, pg8::StaticOrder, true, true>(ldsl, g, S, E); })
    PHASE(10, { { pg8::Gemm g{c.CQN, (const bf16_t*)(c.ws + WS_WTUQ), M, 1536, 256}; pg8::StaticOrder S; S.init(M, 1536, gridDim.x, blockIdx.x);
                  pg8::EpiQ1 E{c.Q1, (const float*)(c.ws + WS_STAT2), c.CS}; pg8::gemm_phase<pg8::EpiQ1, pg8::StaticOrder, true, true>(ldsl, g, S, E); }
                __syncthreads();
                { pg8::Gemm g{c.CKVN, (const bf16_t*)(c.ws + WS_WTUKV), M, 2048, 256}; pg8::StaticOrder S; S.init(M, 2048, gridDim.x, blockIdx.x);
                  pg8::EpiKV1 E{c.KV1, (const float*)(c.ws + WS_STAT2)}; pg8::gemm_phase<pg8::EpiKV1, pg8::StaticOrder, true, true>(ldsl, g, S, E); } })
    PHASE(12, mla::phase(c, lds))
    PHASE(13, { pg8::Gemm g{c.O1, (const bf16_t*)(c.ws + WS_WTOC), M, 1024, 1024}; pg8::StaticOrder S; S.init(M, 1024, gridDim.x, blockIdx.x);
               pg8::EpiRes E{c.out, c.out}; pg8::gemm_phase<pg8::EpiRes, pg8::StaticOrder, true, true>(ldsl, g, S, E); })
    PHASE(14, ph_final(c))
#undef PHASE
}

extern "C" void kernel_launch(void* const* d_in, const int* in_sizes, int n_in, void* d_out, int out_size, void* d_ws, size_t ws_size, hipStream_t stream) {
    static int grid = 0;
    if (grid == 0) {
        if (n_in != 20 || in_sizes[0] != M * DM || out_size != M * DM || ws_size < WS_END) {
            fprintf(stderr, "kernel_launch: unexpected shapes (n_in %d, in0 %d, out %d, ws %zu)\n", n_in, n_in > 0 ? in_sizes[0] : -1, out_size, ws_size); grid = -1; return; }
        int dev = 0, cus = 0;
        if (hipGetDevice(&dev) != hipSuccess || hipDeviceGetAttribute(&cus, hipDeviceAttributeMultiprocessorCount, dev) != hipSuccess || cus <= 0) { grid = -1; return; }
        if (hipFuncSetAttribute((const void*)mk_fwd, hipFuncAttributeMaxDynamicSharedMemorySize, LDS_BYTES) != hipSuccess) { fprintf(stderr, "kernel_launch: hipFuncSetAttribute failed\n"); grid = -1; return; }
        (void)hipGetLastError();
        grid = cus;
    }
    if (grid < 0) return;
    (void)hipMemsetAsync((char*)d_ws + WS_CTL, 0, CTL_BYTES, stream);
    Args a{};
    for (int i = 0; i < 20; ++i) a.in[i] = d_in[i];
    a.out = (float*)d_out; a.ws = (unsigned char*)d_ws;
#if MK_ONE_LAUNCH
    a.lo = 0; a.hi = NPHASE;
    hipLaunchKernelGGL(mk_fwd, dim3(grid), dim3(NTHR), LDS_BYTES, stream, a);
#else
    for (int ph = 0; ph < NPHASE; ++ph) { a.lo = ph; a.hi = ph + 1; hipLaunchKernelGGL(mk_fwd, dim3(grid), dim3(NTHR), LDS_BYTES, stream, a); }
#endif
}
```

```cpp
#include <hip/hip_runtime.h>
#include <cstdio>
#include <cstdint>
#include <cmath>

#ifndef MK_ONE_LAUNCH
#define MK_ONE_LAUNCH 1
#endif

constexpr int BATCH = 8, SEQ = 4096, DM = 1024, M = BATCH * SEQ;
constexpr int NIN_A = 3864, NIN_C = 1600;
constexpr int PA_LD = 4096;
constexpr int PC_LD = 1792;
constexpr int PA_Q = 0, PA_KC = 512, PA_VC = 640, PA_KS = 768, PA_VS = 896, PA_KW = 1024, PA_VW = 1152,
              PA_GA = 1280, PA_CB = 1792, PA_CC = 2304, PA_CH = 2816, PA_GB = 3328, PA_GL = 3840;
constexpr int PC_CQ = 0, PC_CKV = 256, PC_G = 512, PC_KR = 1536;
constexpr float LOG2E = 1.4426950408889634f;
constexpr float QSCALE_A = 0.125f * LOG2E;
constexpr float QSCALE_C = 0.07216878364870323f * LOG2E;
constexpr float RMS_EPS = 1e-6f;

constexpr size_t MiB = 1u << 20;
constexpr size_t WS_CTL = 0, CTL_BYTES = 1 * MiB;
constexpr size_t WS_CS = 1 * MiB;
constexpr size_t WS_KCMP = 9 * MiB;
constexpr size_t WS_VCMP = 9 * MiB + 512 * 1024;
constexpr size_t WS_STAT1 = 10 * MiB;
constexpr size_t WS_STAT2 = 12 * MiB;
constexpr size_t WS_WTA = 16 * MiB;
constexpr size_t WS_WTOA = 24 * MiB;
constexpr size_t WS_WTC = 26 * MiB;
constexpr size_t WS_WTUQ = 30 * MiB;
constexpr size_t WS_WTUKV = 31 * MiB;
constexpr size_t WS_WTOC = 32 * MiB;
constexpr size_t WS_W1T = 34 * MiB;
constexpr size_t WS_W2T = 35 * MiB;
constexpr size_t WS_XN = 48 * MiB;
constexpr size_t WS_PA = 112 * MiB;
constexpr size_t WS_MIX = 368 * MiB;
constexpr size_t WS_PC = 112 * MiB;
constexpr size_t WS_Q1 = 224 * MiB;
constexpr size_t WS_KV1 = 320 * MiB;
constexpr size_t WS_CQN = 448 * MiB;
constexpr size_t WS_CKVN = 464 * MiB;
constexpr size_t WS_KPE = 480 * MiB;
constexpr size_t WS_O1 = 48 * MiB;
constexpr size_t WS_END = 484 * MiB;

constexpr int LDS_BYTES = 147456;
constexpr int NTHR = 512, NWV = 8;

typedef unsigned short bf16_t;
#define LAS __attribute__((address_space(3)))

__device__ __forceinline__ float bf2f(bf16_t v) { return __uint_as_float(((unsigned)v) << 16); }
__device__ __forceinline__ bf16_t f2bf(float f) { unsigned u = __float_as_uint(f); return (bf16_t)((u + 0x7fffu + ((u >> 16) & 1u)) >> 16); }
__device__ __forceinline__ float wave_sum(float v) {
#pragma unroll
    for (int o = 1; o < 64; o <<= 1) v += __shfl_xor(v, o);
    return v;
}
__device__ __forceinline__ float wave_max(float v) {
#pragma unroll
    for (int o = 1; o < 64; o <<= 1) v = fmaxf(v, __shfl_xor(v, o));
    return v;
}
#define WSYNC() asm volatile("s_waitcnt lgkmcnt(0)" ::: "memory")
__device__ __forceinline__ float siluf(float x) { return x / (1.f + __expf(-x)); }
__device__ __forceinline__ float sigmoidf_(float x) { return 1.f / (1.f + __expf(-x)); }

#define XB_TMO      128
#define XB_XCNT(j)  (256  + 64 * (j))
#define XB_XSUB(j)  (1280 + 64 * (j))
#define XB_XGEN(j)  (2304 + 64 * (j))
#define XB_TOP      3328
#define XB_TOPGEN   3392
#define XCD_BAR_WORDS 3456
#define XB_SPIN_CAP (1u << 24)
__device__ __forceinline__ unsigned xb_ld(unsigned* p)              { return __hip_atomic_load(p, __ATOMIC_RELAXED, __HIP_MEMORY_SCOPE_AGENT); }
__device__ __forceinline__ unsigned xb_add(unsigned* p, unsigned v) { return __hip_atomic_fetch_add(p, v, __ATOMIC_RELAXED, __HIP_MEMORY_SCOPE_AGENT); }
__device__ __forceinline__ unsigned xb_xcc_id() { return (unsigned)__builtin_amdgcn_s_getreg((3 << 11) | 20) & 0xFu; }
#define XB_SPIN(cond, bar) do { unsigned _sp = 0; while (cond) { __builtin_amdgcn_s_sleep(1); \
    if ((++_sp & 255u) == 0u) { if (xb_ld(&(bar)[XB_TMO])) break; if (_sp > XB_SPIN_CAP) { atomicAdd(&(bar)[XB_TMO], 1u); break; } } } } while (0)
struct XcdBarrier { unsigned* bar; unsigned x; volatile LAS unsigned* st; };
__device__ __forceinline__ XcdBarrier xcd_barrier_post(unsigned* bar, volatile LAS unsigned* st) {
    XcdBarrier b; b.bar = bar; b.x = xb_xcc_id(); b.st = st;
    if (threadIdx.x == 0) (void)xb_add(&bar[XB_XCNT(b.x)], 1u);
    return b;
}
__device__ __forceinline__ void xcd_barrier_complete(unsigned* bar, unsigned x, unsigned& nloc, unsigned& nx) {
    const unsigned G = gridDim.x * gridDim.y * gridDim.z;
    unsigned sum, cnt, mine, sp = 0u;
    for (;;) {
        sum = 0u; cnt = 0u; mine = 0u;
#pragma unroll
        for (unsigned j = 0; j < 16; ++j) { const unsigned c = xb_ld(&bar[XB_XCNT(j)]); sum += c; cnt += (c > 0u) ? 1u : 0u; mine = (j == x) ? c : mine; }
        if (sum == G) break;
        __builtin_amdgcn_s_sleep(1);
        if ((++sp & 255u) == 0u) { if (xb_ld(&bar[XB_TMO])) break; if (sp > XB_SPIN_CAP) { atomicAdd(&bar[XB_TMO], 1u); break; } }
    }
    nloc = mine > 0u ? mine : 1u; nx = cnt > 0u ? cnt : 1u;
}
__device__ __forceinline__ void xcd_barrier(const XcdBarrier& b) {
    asm volatile("s_waitcnt vmcnt(0)" ::: "memory");
    __syncthreads();
    if (threadIdx.x == 0) {
        unsigned* bar = b.bar;
        __builtin_amdgcn_s_waitcnt(0);
        unsigned nloc = b.st[0], nx = b.st[1];
        if (nloc == 0u) { xcd_barrier_complete(bar, b.x, nloc, nx); b.st[0] = nloc; b.st[1] = nx; }
        const unsigned old = xb_add(&bar[XB_XSUB(b.x)], 1u);
        const unsigned gen = old / nloc;
        if (old + 1u == (gen + 1u) * nloc) {
            __builtin_amdgcn_fence(__ATOMIC_RELEASE, "agent");
            asm volatile("s_waitcnt vmcnt(0)" ::: "memory");
            const unsigned og = xb_add(&bar[XB_TOP], 1u);
            const unsigned tg = og / nx;
            if (og + 1u == (tg + 1u) * nx) xb_add(&bar[XB_TOPGEN], 1u);
            else XB_SPIN(xb_ld(&bar[XB_TOPGEN]) == tg, bar);
            __builtin_amdgcn_fence(__ATOMIC_ACQUIRE, "agent");
            xb_add(&bar[XB_XGEN(b.x)], 1u);
            asm volatile("s_waitcnt vmcnt(0)" ::: "memory");
        } else {
            XB_SPIN(xb_ld(&bar[XB_XGEN(b.x)]) == gen, bar);
            __builtin_amdgcn_fence(__ATOMIC_ACQUIRE, "agent");
            asm volatile("s_waitcnt vmcnt(0)" ::: "memory");
        }
    }
    __syncthreads();
}

struct Args { const void* in[20]; float* out; unsigned char* ws; int lo, hi; };
struct Ctx {
    const float* x; const int* pos; const float* a_norm; const float* a_w_in; const float* pe_k; const float* pe_v;
    const float* w_ck1; const float* w_ck2; const float* w_cv1; const float* w_cv2; const float* conv_w; const float* a_w_out;
    const float* c_norm; const float* c_w_in; const float* q_norm; const float* kv_norm; const float* w_uq; const float* w_ukv; const float* c_w_out; const float* final_norm;
    float* out; unsigned char* ws;
    float2* CS; bf16_t* KCMP; bf16_t* VCMP; bf16_t* XN; bf16_t* PA; bf16_t* MIX; bf16_t* PC; bf16_t* Q1; bf16_t* KV1; bf16_t* CQN; bf16_t* CKVN; bf16_t* KPE; bf16_t* O1;
};

__device__ __forceinline__ void sincos_acc(float angf, float& s, float& c) {
    const double x = (double)angf;
    const double k = rint(x * 0.6366197723675814);
    double r = fma(-k, 1.5707963267948966, x);
    r = fma(-k, 6.123233995736766e-17, r);
    const double r2 = r * r;
    double sp = -1.0 / 1307674368000.0;
    sp = fma(sp, r2, 1.0 / 6227020800.0);
    sp = fma(sp, r2, -1.0 / 39916800.0);
    sp = fma(sp, r2, 1.0 / 362880.0);
    sp = fma(sp, r2, -1.0 / 5040.0);
    sp = fma(sp, r2, 1.0 / 120.0);
    sp = fma(sp, r2, -1.0 / 6.0);
    const double sn = fma(sp * r2, r, r);
    double cp = 1.0 / 20922789888000.0;
    cp = fma(cp, r2, -1.0 / 87178291200.0);
    cp = fma(cp, r2, 1.0 / 479001600.0);
    cp = fma(cp, r2, -1.0 / 3628800.0);
    cp = fma(cp, r2, 1.0 / 40320.0);
    cp = fma(cp, r2, -1.0 / 720.0);
    cp = fma(cp, r2, 1.0 / 24.0);
    cp = fma(cp, r2, -0.5);
    const double cs = fma(cp, r2, 1.0);
    const int q = ((int)(long long)k) & 3;
    const double ss = (q == 0) ? sn : (q == 1) ? cs : (q == 2) ? -sn : -cs;
    const double cc = (q == 0) ? cs : (q == 1) ? -sn : (q == 2) ? -cs : sn;
    s = (float)ss; c = (float)cc;
}

__device__ __forceinline__ void rms_row_f32(const float* xr, const float* g, bf16_t* orow, int lane) {
    float4 v[4]; float s = 0.f;
#pragma unroll
    for (int j = 0; j < 4; ++j) { v[j] = *(const float4*)(xr + 4 * lane + 256 * j); s += (v[j].x * v[j].x + v[j].y * v[j].y) + (v[j].z * v[j].z + v[j].w * v[j].w); }
    const float rstd = 1.f / sqrtf(wave_sum(s) * (1.f / DM) + RMS_EPS);
#pragma unroll
    for (int j = 0; j < 4; ++j) {
        const float4 gg = *(const float4*)(g + 4 * lane + 256 * j);
        ushort4 o; o.x = f2bf(v[j].x * rstd * gg.x); o.y = f2bf(v[j].y * rstd * gg.y); o.z = f2bf(v[j].z * rstd * gg.z); o.w = f2bf(v[j].w * rstd * gg.w);
        *(ushort4*)(orow + 4 * lane + 256 * j) = o;
    }
}

namespace pg8 {
#define PG8_LAS __attribute__((address_space(3)))
typedef unsigned short bf16_t;
typedef short bf16x8 __attribute__((ext_vector_type(8)));
typedef float f32x4 __attribute__((ext_vector_type(4)));
typedef unsigned u32x4 __attribute__((ext_vector_type(4)));
constexpr int BM = 256, BK = 64, HALF = 128, HTB = HALF * BK * 2  , STAGE_BYTES = 8 * HTB, NXCD = 8, WGM = 8;

__host__ __device__ __forceinline__ int lds_byte(int r, int c) { const int st = (r >> 4) * 2 + (c >> 5), rr = r & 15, cc = c & 31, ob = rr * 64 + cc * 2; return st * 1024 + (ob ^ (((ob >> 9) & 1) << 5)); }
__host__ __device__ __forceinline__ void stage_rc(int b, int& R, int& C) { const int st = b / 1024, sb = b % 1024, swz = sb ^ (((sb >> 9) & 1) << 5); R = (st >> 1) * 16 + swz / 64; C = (st & 1) * 32 + (swz % 64) / 2; }
__host__ __device__ __forceinline__ int perm32(int rho) { const int n = rho >> 4, i = rho & 15; return 8 * (i >> 2) + 4 * n + (i & 3); }

struct Unit { int pm, pn; };
struct Gemm { const bf16_t* A; const bf16_t* Bt; int M, N, K; };

struct StaticOrder {
    int nM, nN, nwg, G, c;
    __host__ __device__ void init(int M, int N, int G_, int c_) { nM = M / BM; nN = N / BM; nwg = nM * nN; G = G_; c = c_; }
    __host__ __device__ bool next(int i, Unit& u) const {
        const long L = (long)i * G + c; if (L >= nwg) return false;
        int wgid = (int)L; { const int q = nwg / NXCD, r = nwg % NXCD, xcd = wgid % NXCD, off = wgid / NXCD; wgid = (xcd < r ? xcd * (q + 1) : r * (q + 1) + (xcd - r) * q) + off; }
        const int nig = WGM * nN, gid = wgid / nig, fm = gid * WGM, gsz = (nM - fm) < WGM ? (nM - fm) : WGM;
        u.pm = fm + ((wgid % nig) % gsz); u.pn = (wgid % nig) / gsz; return true;
    }
    __device__ __forceinline__ void a_ready(const Unit&) const {}
    __device__ __forceinline__ void done(const Unit&) const {}
};

__device__ __forceinline__ unsigned cvt_pk_bf16(float lo, float hi) { unsigned r; asm volatile("v_cvt_pk_bf16_f32 %0, %1, %2" : "=v"(r) : "v"(lo), "v"(hi)); return r; }

struct EpiPA {
    static constexpr bool PERM = true, AFTER_DRAIN = false;
    bf16_t* PA; const float2* CS;
    __device__ __forceinline__ void operator()(const f32x4 (&acc)[2][2][4][2], const Unit& u, int wr, int wc, int fr, int fq) const {
        const int row0 = u.pm * BM + wr * 64 + fr;
        if (u.pn < 3) {
            const int base = (u.pn == 0) ? 64 * wc : (u.pn == 1) ? 256 + 64 * wc : (wc < 2 ? 768 + 64 * wc : 1024 + 64 * (wc - 2));
            const float sc = u.pn < 2 ? QSCALE_A : 1.f;
#pragma unroll
            for (int ai = 0; ai < 2; ++ai)
#pragma unroll
                for (int m = 0; m < 4; ++m) {
                    const int row = row0 + ai * HALF + m * 16;
                    const f32x4* csp = (const f32x4*)(CS + (size_t)row * 32 + 8 * fq);
                    const f32x4 t0 = csp[0], t1 = csp[1], t2 = csp[2], t3 = csp[3];
                    const f32x4 a0 = acc[ai][0][m][0], a1 = acc[ai][0][m][1], b0 = acc[ai][1][m][0], b1 = acc[ai][1][m][1];
                    u32x4 w1, w2;
                    w1.x = cvt_pk_bf16((a0[0] * t0[0] - b0[0] * t0[1]) * sc, (a0[1] * t0[2] - b0[1] * t0[3]) * sc);
                    w1.y = cvt_pk_bf16((a0[2] * t1[0] - b0[2] * t1[1]) * sc, (a0[3] * t1[2] - b0[3] * t1[3]) * sc);
                    w1.z = cvt_pk_bf16((a1[0] * t2[0] - b1[0] * t2[1]) * sc, (a1[1] * t2[2] - b1[1] * t2[3]) * sc);
                    w1.w = cvt_pk_bf16((a1[2] * t3[0] - b1[2] * t3[1]) * sc, (a1[3] * t3[2] - b1[3] * t3[3]) * sc);
                    w2.x = cvt_pk_bf16((b0[0] * t0[0] + a0[0] * t0[1]) * sc, (b0[1] * t0[2] + a0[1] * t0[3]) * sc);
                    w2.y = cvt_pk_bf16((b0[2] * t1[0] + a0[2] * t1[1]) * sc, (b0[3] * t1[2] + a0[3] * t1[3]) * sc);
                    w2.z = cvt_pk_bf16((b1[0] * t2[0] + a1[0] * t2[1]) * sc, (b1[1] * t2[2] + a1[1] * t2[3]) * sc);
                    w2.w = cvt_pk_bf16((b1[2] * t3[0] + a1[2] * t3[1]) * sc, (b1[3] * t3[2] + a1[3] * t3[3]) * sc);
                    bf16_t* rp = PA + (size_t)row * PA_LD + base + 8 * fq;
                    *(u32x4*)rp = w1; *(u32x4*)(rp + 32) = w2;
                }
        } else {
            const int cb0 = (u.pn == 3) ? 512 : (u.pn == 4) ? 896 : 256 * u.pn;
            const int cb1 = (u.pn == 3) ? 640 : (u.pn == 4) ? 1152 : 256 * u.pn + 128;
#pragma unroll
            for (int ai = 0; ai < 2; ++ai)
#pragma unroll
                for (int m = 0; m < 4; ++m) {
                    bf16_t* rp = PA + (size_t)(row0 + ai * HALF + m * 16) * PA_LD + 32 * wc + 8 * fq;
#pragma unroll
                    for (int bj = 0; bj < 2; ++bj) { const f32x4 v0 = acc[ai][bj][m][0], v1 = acc[ai][bj][m][1];
                        u32x4 w; w.x = cvt_pk_bf16(v0[0], v0[1]); w.y = cvt_pk_bf16(v0[2], v0[3]); w.z = cvt_pk_bf16(v1[0], v1[1]); w.w = cvt_pk_bf16(v1[2], v1[3]);
                        *(u32x4*)(rp + (bj ? cb1 : cb0)) = w; }
                }
        }
    }
};
struct EpiPlain {
    static constexpr bool PERM = true, AFTER_DRAIN = false;
    bf16_t* O; int ldc;
    __device__ __forceinline__ void operator()(const f32x4 (&acc)[2][2][4][2], const Unit& u, int wr, int wc, int fr, int fq) const {
        const int row0 = u.pm * BM + wr * 64 + fr; const int col0 = u.pn * BM + wc * 32 + 8 * fq;
#pragma unroll
        for (int ai = 0; ai < 2; ++ai)
#pragma unroll
            for (int m = 0; m < 4; ++m) { bf16_t* rp = O + (size_t)(row0 + ai * HALF + m * 16) * ldc + col0;
#pragma unroll
                for (int bj = 0; bj < 2; ++bj) { const f32x4 v0 = acc[ai][bj][m][0], v1 = acc[ai][bj][m][1];
                    u32x4 w; w.x = cvt_pk_bf16(v0[0], v0[1]); w.y = cvt_pk_bf16(v0[2], v0[3]); w.z = cvt_pk_bf16(v1[0], v1[1]); w.w = cvt_pk_bf16(v1[2], v1[3]);
                    *(u32x4*)(rp + bj * HALF) = w; } }
    }
};
struct EpiRes {
    static constexpr bool PERM = false, AFTER_DRAIN = false;
    const float* base; float* out;
    __device__ __forceinline__ void operator()(const f32x4 (&acc)[2][2][4][2], const Unit& u, int wr, int wc, int fr, int fq) const {
        const int row0 = u.pm * BM + wr * 64 + fr; const int col0 = u.pn * BM + wc * 32 + 4 * fq;
#pragma unroll
        for (int ai = 0; ai < 2; ++ai)
#pragma unroll
            for (int m = 0; m < 4; ++m) { const size_t off = (size_t)(row0 + ai * HALF + m * 16) * 1024 + col0;
#pragma unroll
                for (int bj = 0; bj < 2; ++bj)
#pragma unroll
                    for (int n = 0; n < 2; ++n) { const f32x4 b = *(const f32x4*)(base + off + bj * HALF + n * 16); *(f32x4*)(out + off + bj * HALF + n * 16) = b + acc[ai][bj][m][n]; } }
    }
};
struct EpiRes2 {
    static constexpr bool PERM = false, AFTER_DRAIN = false;
    const float* base; float* out; bf16_t* xn; const float* g; float* stat;
    __device__ __forceinline__ void operator()(const f32x4 (&acc)[2][2][4][2], const Unit& u, int wr, int wc, int fr, int fq) const {
        asm volatile("" : "+v"(fr), "+v"(fq));
        const int row0 = u.pm * BM + wr * 64 + fr; const int col0 = u.pn * BM + wc * 32 + 4 * fq;
        f32x4 gv[2][2];
#pragma unroll
        for (int bj = 0; bj < 2; ++bj)
#pragma unroll
            for (int n = 0; n < 2; ++n) gv[bj][n] = *(const f32x4*)(g + col0 + bj * HALF + n * 16);
#pragma unroll
        for (int ai = 0; ai < 2; ++ai)
#pragma unroll
            for (int m = 0; m < 4; ++m) { const int row = row0 + ai * HALF + m * 16; const size_t off = (size_t)row * 1024 + col0; float ss = 0.f;
#pragma unroll
                for (int bj = 0; bj < 2; ++bj)
#pragma unroll
                    for (int n = 0; n < 2; ++n) { const f32x4 x = *(const f32x4*)(base + off + bj * HALF + n * 16) + acc[ai][bj][m][n]; *(f32x4*)(out + off + bj * HALF + n * 16) = x;
                        ss += (x[0] * x[0] + x[1] * x[1]) + (x[2] * x[2] + x[3] * x[3]); const f32x4 y = x * gv[bj][n];
                        typedef unsigned u32x2_t __attribute__((ext_vector_type(2))); u32x2_t w; w.x = cvt_pk_bf16(y[0], y[1]); w.y = cvt_pk_bf16(y[2], y[3]); *(u32x2_t*)(xn + off + bj * HALF + n * 16) = w; }
                ss += __shfl_xor(ss, 16); ss += __shfl_xor(ss, 32);
                if (fq == 0) stat[(size_t)row * 16 + u.pn * 4 + wc] = ss; }
    }
};
template <int NS> __device__ __forceinline__ float row_rstd(const float* st, float invn) {
    float s = 0.f;
#pragma unroll
    for (int i = 0; i < NS; i += 4) { const f32x4 v = *(const f32x4*)(st + i); s += (v[0] + v[1]) + (v[2] + v[3]); }
    asm volatile("" ::: "memory");
    return 1.f / sqrtf(s * invn + RMS_EPS);
}
struct EpiPC2 {
    static constexpr bool PERM = true, AFTER_DRAIN = false;
    bf16_t* PC; bf16_t* CQN; bf16_t* CKVN; bf16_t* KPE; const float* qn; const float* kvn; const float* stat1; float* stat2; const float2* CS;
    __device__ __forceinline__ void operator()(const f32x4 (&acc)[2][2][4][2], const Unit& u, int wr, int wc, int fr, int fq) const {
        asm volatile("" : "+v"(fr), "+v"(fq));
        const int row0 = u.pm * BM + wr * 64 + fr; const int cl0 = wc * 32 + 8 * fq;
        if (u.pn == 6 && wc != 0) return;
        f32x4 gv[2][2];
        if (u.pn < 2) { const float* gsrc = u.pn ? kvn : qn;
#pragma unroll
            for (int bj = 0; bj < 2; ++bj) { gv[bj][0] = *(const f32x4*)(gsrc + cl0 + bj * HALF); gv[bj][1] = *(const f32x4*)(gsrc + cl0 + bj * HALF + 4); } }
#pragma unroll
        for (int ai = 0; ai < 2; ++ai)
#pragma unroll
            for (int m = 0; m < 4; ++m) { const int row = row0 + ai * HALF + m * 16; const float rs = row_rstd<16>(stat1 + (size_t)row * 16, 1.f / 1024.f);
                if (u.pn < 2) { bf16_t* dst = (u.pn ? CKVN : CQN) + (size_t)row * 256 + cl0; float ss = 0.f;
#pragma unroll
                    for (int bj = 0; bj < 2; ++bj) { const f32x4 v0 = acc[ai][bj][m][0] * rs, v1 = acc[ai][bj][m][1] * rs;
                        ss += ((v0[0] * v0[0] + v0[1] * v0[1]) + (v0[2] * v0[2] + v0[3] * v0[3])) + ((v1[0] * v1[0] + v1[1] * v1[1]) + (v1[2] * v1[2] + v1[3] * v1[3]));
                        const f32x4 y0 = v0 * gv[bj][0], y1 = v1 * gv[bj][1];
                        u32x4 w; w.x = cvt_pk_bf16(y0[0], y0[1]); w.y = cvt_pk_bf16(y0[2], y0[3]); w.z = cvt_pk_bf16(y1[0], y1[1]); w.w = cvt_pk_bf16(y1[2], y1[3]); *(u32x4*)(dst + bj * HALF) = w; }
                    ss += __shfl_xor(ss, 16); ss += __shfl_xor(ss, 32);
                    if (fq == 0) stat2[(size_t)row * 8 + u.pn * 4 + wc] = ss;
                } else if (u.pn < 6) { bf16_t* dst = PC + (size_t)row * PC_LD + u.pn * BM + cl0;
#pragma unroll
                    for (int bj = 0; bj < 2; ++bj) { const f32x4 v0 = acc[ai][bj][m][0] * rs, v1 = acc[ai][bj][m][1] * rs;
                        u32x4 w; w.x = cvt_pk_bf16(v0[0], v0[1]); w.y = cvt_pk_bf16(v0[2], v0[3]); w.z = cvt_pk_bf16(v1[0], v1[1]); w.w = cvt_pk_bf16(v1[2], v1[3]); *(u32x4*)(dst + bj * HALF) = w; }
                } else {
                    const f32x4* csp = (const f32x4*)(CS + (size_t)row * 32 + 8 * fq);
                    const f32x4 t0 = csp[0], t1 = csp[1], t2 = csp[2], t3 = csp[3];
                    const f32x4 a0 = acc[ai][0][m][0] * rs, a1 = acc[ai][0][m][1] * rs, b0 = acc[ai][1][m][0] * rs, b1 = acc[ai][1][m][1] * rs;
                    u32x4 w1, w2;
                    w1.x = cvt_pk_bf16(a0[0] * t0[0] - b0[0] * t0[1], a0[1] * t0[2] - b0[1] * t0[3]); w1.y = cvt_pk_bf16(a0[2] * t1[0] - b0[2] * t1[1], a0[3] * t1[2] - b0[3] * t1[3]);
                    w1.z = cvt_pk_bf16(a1[0] * t2[0] - b1[0] * t2[1], a1[1] * t2[2] - b1[1] * t2[3]); w1.w = cvt_pk_bf16(a1[2] * t3[0] - b1[2] * t3[1], a1[3] * t3[2] - b1[3] * t3[3]);
                    w2.x = cvt_pk_bf16(b0[0] * t0[0] + a0[0] * t0[1], b0[1] * t0[2] + a0[1] * t0[3]); w2.y = cvt_pk_bf16(b0[2] * t1[0] + a0[2] * t1[1], b0[3] * t1[2] + a0[3] * t1[3]);
                    w2.z = cvt_pk_bf16(b1[0] * t2[0] + a1[0] * t2[1], b1[1] * t2[2] + a1[1] * t2[3]); w2.w = cvt_pk_bf16(b1[2] * t3[0] + a1[2] * t3[1], b1[3] * t3[2] + a1[3] * t3[3]);
                    bf16_t* rp = KPE + (size_t)row * 64 + 8 * fq; *(u32x4*)rp = w1; *(u32x4*)(rp + 32) = w2;
                } }
    }
};
struct EpiQ1 {
    static constexpr bool PERM = true, AFTER_DRAIN = false;
    bf16_t* Q1; const float* stat2; const float2* CS;
    __device__ __forceinline__ void operator()(const f32x4 (&acc)[2][2][4][2], const Unit& u, int wr, int wc, int fr, int fq) const {
        asm volatile("" : "+v"(fr), "+v"(fq));
        const int row0 = u.pm * BM + wr * 64 + fr;
#pragma unroll
        for (int ai = 0; ai < 2; ++ai)
#pragma unroll
            for (int m = 0; m < 4; ++m) { const int row = row0 + ai * HALF + m * 16; const float rs = row_rstd<4>(stat2 + (size_t)row * 8, 1.f / 256.f) * QSCALE_C;
                if (u.pn < 4) {
#pragma unroll
                    for (int bj = 0; bj < 2; ++bj) { const f32x4 v0 = acc[ai][bj][m][0] * rs, v1 = acc[ai][bj][m][1] * rs;
                        u32x4 w; w.x = cvt_pk_bf16(v0[0], v0[1]); w.y = cvt_pk_bf16(v0[2], v0[3]); w.z = cvt_pk_bf16(v1[0], v1[1]); w.w = cvt_pk_bf16(v1[2], v1[3]);
                        *(u32x4*)(Q1 + (size_t)row * 1536 + (2 * u.pn + bj) * 192 + wc * 32 + 8 * fq) = w; }
                } else { const int head = (u.pn - 4) * 4 + wc;
                    const f32x4* csp = (const f32x4*)(CS + (size_t)row * 32 + 8 * fq);
                    const f32x4 t0 = csp[0], t1 = csp[1], t2 = csp[2], t3 = csp[3];
                    const f32x4 a0 = acc[ai][0][m][0] * rs, a1 = acc[ai][0][m][1] * rs, b0 = acc[ai][1][m][0] * rs, b1 = acc[ai][1][m][1] * rs;
                    u32x4 w1, w2;
                    w1.x = cvt_pk_bf16(a0[0] * t0[0] - b0[0] * t0[1], a0[1] * t0[2] - b0[1] * t0[3]); w1.y = cvt_pk_bf16(a0[2] * t1[0] - b0[2] * t1[1], a0[3] * t1[2] - b0[3] * t1[3]);
                    w1.z = cvt_pk_bf16(a1[0] * t2[0] - b1[0] * t2[1], a1[1] * t2[2] - b1[1] * t2[3]); w1.w = cvt_pk_bf16(a1[2] * t3[0] - b1[2] * t3[1], a1[3] * t3[2] - b1[3] * t3[3]);
                    w2.x = cvt_pk_bf16(b0[0] * t0[0] + a0[0] * t0[1], b0[1] * t0[2] + a0[1] * t0[3]); w2.y = cvt_pk_bf16(b0[2] * t1[0] + a0[2] * t1[1], b0[3] * t1[2] + a0[3] * t1[3]);
                    w2.z = cvt_pk_bf16(b1[0] * t2[0] + a1[0] * t2[1], b1[1] * t2[2] + a1[1] * t2[3]); w2.w = cvt_pk_bf16(b1[2] * t3[0] + a1[2] * t3[1], b1[3] * t3[2] + a1[3] * t3[3]);
                    bf16_t* rp = Q1 + (size_t)row * 1536 + head * 192 + 128 + 8 * fq; *(u32x4*)rp = w1; *(u32x4*)(rp + 32) = w2;
                }
                asm volatile("" ::: "memory"); }
    }
};
struct EpiKV1 {
    static constexpr bool PERM = true, AFTER_DRAIN = false;
    bf16_t* O; const float* stat2;
    __device__ __forceinline__ void operator()(const f32x4 (&acc)[2][2][4][2], const Unit& u, int wr, int wc, int fr, int fq) const {
        asm volatile("" : "+v"(fr), "+v"(fq));
        const int row0 = u.pm * BM + wr * 64 + fr; const int col0 = u.pn * BM + wc * 32 + 8 * fq;
#pragma unroll
        for (int ai = 0; ai < 2; ++ai)
#pragma unroll
            for (int m = 0; m < 4; ++m) { const int row = row0 + ai * HALF + m * 16; const float rs = row_rstd<4>(stat2 + (size_t)row * 8 + 4, 1.f / 256.f);
                bf16_t* rp = O + (size_t)row * 2048 + col0;
#pragma unroll
                for (int bj = 0; bj < 2; ++bj) { const f32x4 v0 = acc[ai][bj][m][0] * rs, v1 = acc[ai][bj][m][1] * rs;
                    u32x4 w; w.x = cvt_pk_bf16(v0[0], v0[1]); w.y = cvt_pk_bf16(v0[2], v0[3]); w.z = cvt_pk_bf16(v1[0], v1[1]); w.w = cvt_pk_bf16(v1[2], v1[3]);
                    *(u32x4*)(rp + bj * HALF) = w; } }
    }
};
template <class Epi, class Sched, bool ALIGN_EPI = false, bool SP2 = false>
__device__ __forceinline__ void gemm_phase(PG8_LAS unsigned char* lds, const Gemm g, const Sched& S, const Epi& E) {
    int tid_ = threadIdx.x; asm volatile("" : "+v"(tid_));
    const int tid = tid_, wid = __builtin_amdgcn_readfirstlane(tid >> 6), lane = tid & 63, wr = wid >> 2, wc = wid & 3, fr = lane & 15, fq = lane >> 4;
    const int K = g.K, nt = K / BK;
    unsigned voffA[2], voffB[2];
#pragma unroll
    for (int i = 0; i < 2; ++i) { int R, C; stage_rc(tid * 16 + i * 8192, R, C); const int Rb = Epi::PERM ? ((R & ~31) + perm32(R & 31)) : R;
        voffA[i] = (unsigned)(R * K + C) * 2u; voffB[i] = (unsigned)(Rb * K + C) * 2u; }
    const size_t kstep = (size_t)(BK * 2);
    const size_t hstep = (size_t)HALF * K * 2;
    const size_t tstep = 2 * hstep;
    const unsigned ldsw = (unsigned)wid * 1024u;
    const int aoff = lds_byte(wr * 64 + fr, fq * 8), boff = lds_byte(wc * 32 + fr, fq * 8);
#define PG8_SA(b, h) (((b) * 2 + (h)) * HTB)
#define PG8_SB(b, h) ((4 + (b) * 2 + (h)) * HTB)
#define PG8_STAGE(bufoff, gbase, voff) do { _Pragma("unroll") for (int _i = 0; _i < 2; ++_i) \
        __builtin_amdgcn_global_load_lds((const unsigned*)((const char*)(gbase) + (voff)[_i]), (PG8_LAS unsigned*)(lds + (bufoff) + ldsw + _i * 8192), 16, 0, 0); } while (0)
#define PG8_LDA(dst, b, h) do { _Pragma("unroll") for (int m = 0; m < 4; ++m) _Pragma("unroll") for (int k = 0; k < 2; ++k) dst[m][k] = *(const PG8_LAS bf16x8*)(lds + PG8_SA(b, h) + aoff + m * 2048 + k * 1024); } while (0)
#define PG8_LDB(dst, b, h) do { _Pragma("unroll") for (int n = 0; n < 2; ++n) _Pragma("unroll") for (int k = 0; k < 2; ++k) dst[n][k] = *(const PG8_LAS bf16x8*)(lds + PG8_SB(b, h) + boff + n * 2048 + k * 1024); } while (0)
#define PG8_MMA(ai, bj, At, Bt) do { __builtin_amdgcn_s_setprio(1); _Pragma("unroll") for (int m = 0; m < 4; ++m) _Pragma("unroll") for (int n = 0; n < 2; ++n) _Pragma("unroll") for (int k = 0; k < 2; ++k) \
        acc[ai][bj][m][n] = __builtin_amdgcn_mfma_f32_16x16x32_bf16(Bt[n][k], At[m][k], acc[ai][bj][m][n], 0, 0, 0); __builtin_amdgcn_s_setprio(0); } while (0)
#define PG8_WAIT_V(n) asm volatile("s_waitcnt vmcnt(" #n ")" ::: "memory")
#define PG8_WAIT_L(n) asm volatile("s_waitcnt lgkmcnt(" #n ")" ::: "memory")
#define PG8_BAR __builtin_amdgcn_s_barrier()
#define PG8_SCHED __builtin_amdgcn_sched_barrier(0)
    Unit cur, nxt; int ui = 0;
    if (!S.next(0, cur)) return;
    f32x4 acc[2][2][4][2];
#pragma unroll
    for (int a = 0; a < 2; ++a)
#pragma unroll
        for (int b = 0; b < 2; ++b)
#pragma unroll
            for (int m = 0; m < 4; ++m)
#pragma unroll
                for (int n = 0; n < 2; ++n) acc[a][b][m][n] = (f32x4){0.f, 0.f, 0.f, 0.f};
    bf16x8 At[4][2], B0[2][2], B1[2][2];
    const char* cA = (const char*)g.A + (size_t)cur.pm * tstep; const char* cB = (const char*)g.Bt + (size_t)cur.pn * tstep;
    S.a_ready(cur);
    if constexpr (SP2) {
        PG8_STAGE(PG8_SB(0, 0), cB, voffB); PG8_STAGE(PG8_SB(0, 1), cB + hstep, voffB); PG8_STAGE(PG8_SA(0, 0), cA, voffA); PG8_STAGE(PG8_SA(0, 1), cA + hstep, voffA);
        if (wr == 1) PG8_BAR;
        PG8_WAIT_V(2); PG8_BAR;
        PG8_STAGE(PG8_SB(1, 0), cB + kstep, voffB); PG8_STAGE(PG8_SA(1, 0), cA + kstep, voffA); PG8_STAGE(PG8_SB(1, 1), cB + hstep + kstep, voffB);
        PG8_WAIT_V(6); PG8_BAR;
    } else {
        PG8_STAGE(PG8_SB(0, 0), cB, voffB); PG8_STAGE(PG8_SA(0, 0), cA, voffA); PG8_STAGE(PG8_SB(0, 1), cB + hstep, voffB); PG8_STAGE(PG8_SA(0, 1), cA + hstep, voffA);
        if (wr == 1) PG8_BAR;
        PG8_WAIT_V(4); PG8_BAR;
        PG8_STAGE(PG8_SB(1, 0), cB + kstep, voffB); PG8_STAGE(PG8_SA(1, 0), cA + kstep, voffA); PG8_STAGE(PG8_SB(1, 1), cB + hstep + kstep, voffB);
        PG8_WAIT_V(6); PG8_BAR;
    }
    for (;;) {
        const bool has_next = S.next(ui + 1, nxt);
        const char* nA = has_next ? (const char*)g.A + (size_t)nxt.pm * tstep : cA; const char* nB = has_next ? (const char*)g.Bt + (size_t)nxt.pn * tstep : cB;
        for (int t = 0; t < nt; t += 2) {
            const bool last = (t == nt - 2);
            const char* a1 = cA + (size_t)(t + 1) * kstep;
            const char* a2 = last ? nA : cA + (size_t)(t + 2) * kstep; const char* b2 = last ? nB : cB + (size_t)(t + 2) * kstep;
            const char* a3 = a2 + kstep; const char* b3 = b2 + kstep;
            if (last && has_next) S.a_ready(nxt);
            if constexpr (SP2) {
            PG8_LDB(B0, 0, 0); PG8_LDB(B1, 0, 1); PG8_SCHED; PG8_LDA(At, 0, 0); PG8_STAGE(PG8_SA(1, 1), a1 + hstep, voffA);
            PG8_WAIT_V(8); PG8_WAIT_L(0); PG8_BAR; PG8_MMA(0, 0, At, B0); PG8_MMA(0, 1, At, B1); PG8_BAR; PG8_SCHED;
            PG8_LDA(At, 0, 1); PG8_STAGE(PG8_SB(0, 0), b2, voffB); PG8_STAGE(PG8_SB(0, 1), b2 + hstep, voffB); PG8_STAGE(PG8_SA(0, 0), a2, voffA);
            PG8_WAIT_V(8); PG8_WAIT_L(0); PG8_BAR; PG8_MMA(1, 0, At, B0); PG8_MMA(1, 1, At, B1); PG8_BAR; PG8_SCHED;
            PG8_LDB(B0, 1, 0); PG8_LDB(B1, 1, 1); PG8_SCHED; PG8_LDA(At, 1, 0); PG8_STAGE(PG8_SA(0, 1), a2 + hstep, voffA);
            PG8_WAIT_V(8); PG8_WAIT_L(0); PG8_BAR; PG8_MMA(0, 0, At, B0); PG8_MMA(0, 1, At, B1); PG8_BAR; PG8_SCHED;
            PG8_LDA(At, 1, 1); PG8_STAGE(PG8_SB(1, 0), b3, voffB); PG8_STAGE(PG8_SB(1, 1), b3 + hstep, voffB); PG8_STAGE(PG8_SA(1, 0), a3, voffA);
            PG8_WAIT_V(8); PG8_WAIT_L(0); PG8_BAR; PG8_MMA(1, 0, At, B0); PG8_MMA(1, 1, At, B1); PG8_BAR; PG8_SCHED;
            } else {
            PG8_LDB(B0, 0, 0); PG8_SCHED; PG8_LDA(At, 0, 0); PG8_STAGE(PG8_SA(1, 1), a1 + hstep, voffA);
            PG8_WAIT_L(8); PG8_BAR; PG8_WAIT_L(0); PG8_MMA(0, 0, At, B0); PG8_BAR; PG8_SCHED;
            PG8_LDB(B1, 0, 1); PG8_STAGE(PG8_SB(0, 0), b2, voffB);
            PG8_BAR; PG8_WAIT_L(0); PG8_MMA(0, 1, At, B1); PG8_BAR;
            PG8_LDA(At, 0, 1); PG8_STAGE(PG8_SA(0, 0), a2, voffA);
            PG8_BAR; PG8_WAIT_L(0); PG8_MMA(1, 0, At, B0); PG8_BAR; PG8_SCHED;
            PG8_STAGE(PG8_SB(0, 1), b2 + hstep, voffB);
            PG8_WAIT_V(6); PG8_BAR; PG8_MMA(1, 1, At, B1); PG8_BAR;
            PG8_LDB(B0, 1, 0); PG8_SCHED; PG8_LDA(At, 1, 0); PG8_STAGE(PG8_SA(0, 1), a2 + hstep, voffA);
            PG8_WAIT_L(8); PG8_BAR; PG8_WAIT_L(0); PG8_MMA(0, 0, At, B0); PG8_BAR; PG8_SCHED;
            PG8_LDB(B1, 1, 1); PG8_STAGE(PG8_SB(1, 0), b3, voffB);
            PG8_BAR; PG8_WAIT_L(0); PG8_MMA(0, 1, At, B1); PG8_BAR;
            PG8_LDA(At, 1, 1); PG8_STAGE(PG8_SA(1, 0), a3, voffA);
            PG8_BAR; PG8_WAIT_L(0); PG8_MMA(1, 0, At, B0); PG8_BAR; PG8_SCHED;
            PG8_STAGE(PG8_SB(1, 1), b3 + hstep, voffB);
            PG8_WAIT_V(6); PG8_BAR; PG8_MMA(1, 1, At, B1); PG8_BAR;
            }
        }
        if constexpr (ALIGN_EPI) { if (wr == 0) PG8_BAR; }
        if constexpr (!Epi::AFTER_DRAIN) { E(acc, cur, wr, wc, fr, fq); S.done(cur); }
        if (!has_next) break;
#pragma unroll
        for (int a = 0; a < 2; ++a)
#pragma unroll
            for (int b = 0; b < 2; ++b)
#pragma unroll
                for (int m = 0; m < 4; ++m)
#pragma unroll
                    for (int n = 0; n < 2; ++n) acc[a][b][m][n] = (f32x4){0.f, 0.f, 0.f, 0.f};
        cur = nxt; cA = nA; cB = nB; ++ui;
        if constexpr (ALIGN_EPI) { if (wr == 1) PG8_BAR; }
    }
    PG8_WAIT_V(0);
    if constexpr (!ALIGN_EPI) { if (wr == 0) PG8_BAR; }
    PG8_BAR;
    if constexpr (Epi::AFTER_DRAIN) { E.fused(acc, cur, wr, wc, fr, fq, lds, wid, lane); S.done(cur); }
#undef PG8_SA
#undef PG8_SB
#undef PG8_STAGE
#undef PG8_LDA
#undef PG8_LDB
#undef PG8_MMA
#undef PG8_WAIT_V
#undef PG8_WAIT_L
#undef PG8_BAR
#undef PG8_SCHED
}
}

template <class Epi>
__device__ __forceinline__ void gemm_naive(const bf16_t* A, int lda, const float* W, int K, int N, unsigned char* lds, Epi epi) {
    float (*As)[132] = (float (*)[132])lds;
    float (*Bs)[128] = (float (*)[128])(lds + 16 * 132 * 4);
    const int tid = threadIdx.x, tx = tid & 31, ty = tid >> 5;
    const int ntm = M / 128, ntn = (N + 127) / 128;
    for (int tile = blockIdx.x; tile < ntm * ntn; tile += gridDim.x) {
        const int tm = tile / ntn, tn = tile % ntn;
        float acc[8][4];
#pragma unroll
        for (int i = 0; i < 8; ++i)
#pragma unroll
            for (int j = 0; j < 4; ++j) acc[i][j] = 0.f;
        for (int k0 = 0; k0 < K; k0 += 16) {
            {   const int r = tid >> 2, kq = (tid & 3) * 4;
                const ushort4 v = *(const ushort4*)(A + (size_t)(tm * 128 + r) * lda + k0 + kq);
                As[kq + 0][r] = bf2f(v.x); As[kq + 1][r] = bf2f(v.y); As[kq + 2][r] = bf2f(v.z); As[kq + 3][r] = bf2f(v.w); }
            {   const int kk = tid >> 5, n4 = (tid & 31) * 4; const int n = tn * 128 + n4;
                const float* wp = W + (size_t)(k0 + kk) * N + n;
                float4 v;
                v.x = (n + 0 < N) ? wp[0] : 0.f; v.y = (n + 1 < N) ? wp[1] : 0.f; v.z = (n + 2 < N) ? wp[2] : 0.f; v.w = (n + 3 < N) ? wp[3] : 0.f;
                *(float4*)&Bs[kk][n4] = v; }
            __syncthreads();
#pragma unroll 2
            for (int kk = 0; kk < 16; ++kk) {
                const float4 a0 = *(const float4*)&As[kk][ty * 8], a1 = *(const float4*)&As[kk][ty * 8 + 4];
                const float4 b = *(const float4*)&Bs[kk][tx * 4];
                const float a[8] = {a0.x, a0.y, a0.z, a0.w, a1.x, a1.y, a1.z, a1.w};
                const float bb[4] = {b.x, b.y, b.z, b.w};
#pragma unroll
                for (int i = 0; i < 8; ++i)
#pragma unroll
                    for (int j = 0; j < 4; ++j) acc[i][j] = fmaf(a[i], bb[j], acc[i][j]);
            }
            __syncthreads();
        }
#pragma unroll
        for (int i = 0; i < 8; ++i)
#pragma unroll
            for (int j = 0; j < 4; ++j) { const int m = tm * 128 + ty * 8 + i, n = tn * 128 + tx * 4 + j; if (n < N) epi(m, n, acc[i][j]); }
    }
}

namespace fa {
typedef short bf16x8 __attribute__((ext_vector_type(8)));
typedef short s16x4 __attribute__((ext_vector_type(4)));
typedef float f32x16 __attribute__((ext_vector_type(16)));
typedef unsigned u32x4 __attribute__((ext_vector_type(4)));
#define FA_SBAR() __builtin_amdgcn_sched_barrier(0)
__device__ __forceinline__ int crow(int r, int hi) { return (r & 3) + 8 * (r >> 2) + 4 * hi; }
__device__ __forceinline__ unsigned cvtpk(float lo, float hi) { unsigned r; asm volatile("v_cvt_pk_bf16_f32 %0, %1, %2" : "=v"(r) : "v"(lo), "v"(hi)); return r; }
template <int NCB> __device__ __forceinline__ int v_st(int k, int c) { const int kk = (k & ~0xC) | ((k & 4) << 1) | ((k & 8) >> 1); return ((kk >> 3) * NCB + (c >> 5)) * 512 + ((kk & 7) * 32 + (c & 31)) * 2; }
__device__ __forceinline__ int v_rd_base(int lane) { return ((lane & 3) << 3) | (((lane >> 2) & 3) << 6) | (((lane >> 4) & 1) << 5) | (((lane >> 5) & 1) << 8); }
__device__ __forceinline__ void mask_tile(f32x16& p0, f32x16& p1, int dq, unsigned W) {
    const float NEG = -__builtin_inff();
#pragma unroll
    for (int r = 0; r < 16; ++r) { const int cc = (r & 3) + 8 * (r >> 2);
        if ((unsigned)(dq - cc) >= W) p0[r] = NEG;
        if ((unsigned)(dq - cc - 32) >= W) p1[r] = NEG; }
}
__device__ __forceinline__ void softmax_tile(f32x16& p0, f32x16& p1, float& m_reg, float& l_reg, float& alpha, bf16x8& pa0, bf16x8& pa1, bf16x8& pa2, bf16x8& pa3) {
    float pmax = p0[0];
#pragma unroll
    for (int r = 1; r < 16; ++r) pmax = fmaxf(pmax, p0[r]);
#pragma unroll
    for (int r = 0; r < 16; ++r) pmax = fmaxf(pmax, p1[r]);
    { auto rr = __builtin_amdgcn_permlane32_swap(__float_as_uint(pmax), __float_as_uint(pmax), false, false); pmax = fmaxf(__uint_as_float(rr[0]), __uint_as_float(rr[1])); }
    const float mn = fmaxf(m_reg, pmax);
    alpha = __builtin_amdgcn_exp2f(m_reg - mn); m_reg = mn;
#pragma unroll
    for (int r = 0; r < 16; ++r) { p0[r] = __builtin_amdgcn_exp2f(p0[r] - mn); p1[r] = __builtin_amdgcn_exp2f(p1[r] - mn); }
    float ps = 0.f;
#pragma unroll
    for (int r = 0; r < 16; ++r) ps += p0[r];
#pragma unroll
    for (int r = 0; r < 16; ++r) ps += p1[r];
    { auto rr = __builtin_amdgcn_permlane32_swap(__float_as_uint(ps), __float_as_uint(ps), false, false); ps = __uint_as_float(rr[0]) + __uint_as_float(rr[1]); }
    l_reg = l_reg * alpha + ps;
#define FA_PK4(P, B_, OUT) do { unsigned a0 = cvtpk(P[B_+0], P[B_+1]), a1 = cvtpk(P[B_+2], P[B_+3]); unsigned b0 = cvtpk(P[B_+4], P[B_+5]), b1 = cvtpk(P[B_+6], P[B_+7]); \
        auto r0 = __builtin_amdgcn_permlane32_swap(a0, b0, false, false); auto r1 = __builtin_amdgcn_permlane32_swap(a1, b1, false, false); \
        u32x4 w = {r0[0], r1[0], r0[1], r1[1]}; OUT = __builtin_bit_cast(bf16x8, w); } while (0)
    FA_PK4(p0, 0, pa0); FA_PK4(p0, 8, pa1); FA_PK4(p1, 0, pa2); FA_PK4(p1, 8, pa3);
#undef FA_PK4
}
__device__ __forceinline__ void pack_p(const f32x16& p0, const f32x16& p1, bf16x8& pa0, bf16x8& pa1, bf16x8& pa2, bf16x8& pa3) {
#define FA_PK4(P, B_, OUT) do { unsigned a0 = cvtpk(P[B_+0], P[B_+1]), a1 = cvtpk(P[B_+2], P[B_+3]); unsigned b0 = cvtpk(P[B_+4], P[B_+5]), b1 = cvtpk(P[B_+6], P[B_+7]); \
        auto r0 = __builtin_amdgcn_permlane32_swap(a0, b0, false, false); auto r1 = __builtin_amdgcn_permlane32_swap(a1, b1, false, false); \
        u32x4 w = {r0[0], r1[0], r0[1], r1[1]}; OUT = __builtin_bit_cast(bf16x8, w); } while (0)
    FA_PK4(p0, 0, pa0); FA_PK4(p0, 8, pa1); FA_PK4(p1, 0, pa2); FA_PK4(p1, 8, pa3);
#undef FA_PK4
}
#define FA_DSR(dst, off) asm volatile("ds_read_b128 %0, %1 offset:%2" : "=&v"(dst) : "v"(kpa), "i"(off) : "memory")
#define FA_LGKM(n) do { asm volatile("s_waitcnt lgkmcnt(" #n ")" ::: "memory"); FA_SBAR(); } while (0)
template <int ND0, int KROW>
__device__ __forceinline__ void qkt(f32x16& p0, f32x16& p1, int kpa, const bf16x8* qr) {
    static_assert(ND0 % 2 == 0, "d0 pairs");
    constexpr int G = ND0 / 2;
    bf16x8 f[2][4];
    p0 = f32x16{}; p1 = f32x16{};
    FA_DSR(f[0][0], 0); FA_DSR(f[0][1], 32 * KROW); FA_DSR(f[0][2], 32); FA_DSR(f[0][3], 32 * KROW + 32);
#pragma unroll
    for (int g = 0; g < G; ++g) {
        if (g + 1 < G) { FA_DSR(f[(g + 1) & 1][0], (g + 1) * 64); FA_DSR(f[(g + 1) & 1][1], 32 * KROW + (g + 1) * 64); FA_DSR(f[(g + 1) & 1][2], (g + 1) * 64 + 32); FA_DSR(f[(g + 1) & 1][3], 32 * KROW + (g + 1) * 64 + 32); FA_LGKM(4); }
        else { FA_LGKM(0); }
        p0 = __builtin_amdgcn_mfma_f32_32x32x16_bf16(f[g & 1][0], qr[2 * g], p0, 0, 0, 0);
        p1 = __builtin_amdgcn_mfma_f32_32x32x16_bf16(f[g & 1][1], qr[2 * g], p1, 0, 0, 0);
        p0 = __builtin_amdgcn_mfma_f32_32x32x16_bf16(f[g & 1][2], qr[2 * g + 1], p0, 0, 0, 0);
        p1 = __builtin_amdgcn_mfma_f32_32x32x16_bf16(f[g & 1][3], qr[2 * g + 1], p1, 0, 0, 0);
    }
}
#undef FA_DSR
#define FA_TRRD(dst, off) asm volatile("ds_read_b64_tr_b16 %0, %1 offset:%2" : "=&v"(dst) : "v"(vb), "i"(off) : "memory")
template <int NCB>
__device__ __forceinline__ void pv_all(f32x16* o, int vb, bf16x8 pa0, bf16x8 pa1, bf16x8 pa2, bf16x8 pa3) {
    constexpr int HS = NCB * 512, KS = 2 * NCB * 512;
    s16x4 v[2][8];
#define FA_PV_ISSUE(S, D0) do { FA_TRRD(v[S][0], (D0) * 512); FA_TRRD(v[S][1], (D0) * 512 + HS); FA_TRRD(v[S][2], (D0) * 512 + KS); FA_TRRD(v[S][3], (D0) * 512 + KS + HS); \
        FA_TRRD(v[S][4], (D0) * 512 + 2 * KS); FA_TRRD(v[S][5], (D0) * 512 + 2 * KS + HS); FA_TRRD(v[S][6], (D0) * 512 + 3 * KS); FA_TRRD(v[S][7], (D0) * 512 + 3 * KS + HS); } while (0)
    FA_PV_ISSUE(0, 0);
#pragma unroll
    for (int d = 0; d < NCB; ++d) {
        if (d + 1 < NCB) { if ((d + 1) & 1) FA_PV_ISSUE(1, d + 1); else FA_PV_ISSUE(0, d + 1); FA_LGKM(8); }
        else { FA_LGKM(0); }
#define FA_VF(S, k) (bf16x8){v[S][2 * (k)][0], v[S][2 * (k)][1], v[S][2 * (k)][2], v[S][2 * (k)][3], v[S][2 * (k) + 1][0], v[S][2 * (k) + 1][1], v[S][2 * (k) + 1][2], v[S][2 * (k) + 1][3]}
        o[d] = __builtin_amdgcn_mfma_f32_32x32x16_bf16(pa0, FA_VF(d & 1, 0), o[d], 0, 0, 0);
        o[d] = __builtin_amdgcn_mfma_f32_32x32x16_bf16(pa1, FA_VF(d & 1, 1), o[d], 0, 0, 0);
        o[d] = __builtin_amdgcn_mfma_f32_32x32x16_bf16(pa2, FA_VF(d & 1, 2), o[d], 0, 0, 0);
        o[d] = __builtin_amdgcn_mfma_f32_32x32x16_bf16(pa3, FA_VF(d & 1, 3), o[d], 0, 0, 0);
#undef FA_VF
    }
#undef FA_PV_ISSUE
}
#undef FA_TRRD
template <int NCB>
__device__ __forceinline__ void rescale_o(f32x16* o, float alpha, LAS float* al, int r32, int hi) {
    if (__any(alpha < 1.f)) {
        if (hi == 0) al[r32] = alpha;
        asm volatile("s_waitcnt lgkmcnt(0)" ::: "memory");
        float f[16]; const LAS float* alh = al + 4 * hi;
#pragma unroll
        for (int r = 0; r < 16; ++r) f[r] = alh[(r & 3) + 8 * (r >> 2)];
#pragma unroll
        for (int d = 0; d < NCB; ++d)
#pragma unroll
            for (int r = 0; r < 16; ++r) o[d][r] *= f[r];
    }
}
}

namespace mla {
constexpr int KROW = 400, KBUF = 64 * KROW, VBUF = 64 * 128 * 2;
constexpr int L_K = 0, L_V = 2 * KBUF, L_AL = L_V + 2 * VBUF, L_END = L_AL + 8 * 64 * 4;
using namespace fa;
__device__ __forceinline__ void unit(const Ctx& c, unsigned char* lds, int b, int h, int qb) {
    int tid_ = threadIdx.x; asm volatile("" : "+v"(tid_));
    const int tid = tid_, lane = tid & 63, r32 = lane & 31, hi = lane >> 5; const int wid = __builtin_amdgcn_readfirstlane(tid >> 6);
    LAS unsigned char* L = (LAS unsigned char*)lds;
    const size_t rowbase = (size_t)b * SEQ; const int q0 = qb * 256;
    bf16x8 qr[12];
    { const bf16_t* qrow = c.Q1 + (rowbase + q0 + wid * 32 + r32) * 1536 + h * 192 + hi * 8;
#pragma unroll
      for (int d0 = 0; d0 < 12; ++d0) qr[d0] = *(const bf16x8*)(qrow + d0 * 16); }
    const bf16_t* kvb = c.KV1 + rowbase * 2048 + h * 256; const bf16_t* kpb = c.KPE + rowbase * 64;
    const unsigned koff = (unsigned)((tid >> 4) * 2048 + (tid & 15) * 8), kpoff = (unsigned)((tid >> 3) * 64 + (tid & 7) * 8);
    const int kw0 = (tid >> 4) * KROW + (tid & 15) * 16, kpw = (tid >> 3) * KROW + 256 + (tid & 7) * 16;
    const int vw0 = v_st<4>(tid >> 4, (tid & 15) * 8), vw1 = v_st<4>(32 + (tid >> 4), (tid & 15) * 8);
    u32x4 sk0, sk1, skp, sv0, sv1;
#define MLA_LOAD(j) do { const bf16_t* kn_ = kvb + (size_t)(j) * 64 * 2048; sk0 = *(const u32x4*)(kn_ + koff); sk1 = *(const u32x4*)(kn_ + koff + 32 * 2048); sv0 = *(const u32x4*)(kn_ + koff + 128); sv1 = *(const u32x4*)(kn_ + koff + 32 * 2048 + 128); \
        skp = *(const u32x4*)(kpb + (size_t)(j) * 64 * 64 + kpoff); } while (0)
#define MLA_WRITE(B) do { *(LAS u32x4*)(L + L_K + (B) * KBUF + kw0) = sk0; *(LAS u32x4*)(L + L_K + (B) * KBUF + kw0 + 32 * KROW) = sk1; *(LAS u32x4*)(L + L_K + (B) * KBUF + kpw) = skp; \
        *(LAS u32x4*)(L + L_V + (B) * VBUF + vw0) = sv0; *(LAS u32x4*)(L + L_V + (B) * VBUF + vw1) = sv1; } while (0)
    const int kp0 = (int)(uintptr_t)lds + L_K + r32 * KROW + hi * 16;
    const int vb0 = (int)(uintptr_t)lds + L_V + v_rd_base(lane);
    LAS float* al = (LAS float*)(L + L_AL) + wid * 64;
    const int NT = 4 * qb + 4;
    const int qm = q0 + wid * 32 + r32 - 4 * hi;
    float m_reg = -1e30f, l_reg = 0.f; f32x16 o[4] = {};
    MLA_LOAD(0); MLA_WRITE(0); __syncthreads();
#define MLA_STEP(t, B) do { \
        if ((t) + 1 < NT) MLA_LOAD((t) + 1); \
        f32x16 p0, p1; qkt<12, KROW>(p0, p1, kp0 + (B) * KBUF, qr); \
        if ((t) >= NT - 4) mask_tile(p0, p1, qm - 64 * (t), 0x7fffffffu); \
        float alpha; bf16x8 pa0, pa1, pa2, pa3; softmax_tile(p0, p1, m_reg, l_reg, alpha, pa0, pa1, pa2, pa3); \
        rescale_o<4>(o, alpha, al, r32, hi); \
        pv_all<4>(o, vb0 + (B) * VBUF, pa0, pa1, pa2, pa3); \
        if ((t) + 1 < NT) MLA_WRITE((B) ^ 1); \
        __syncthreads(); } while (0)
    for (int t = 0; t < NT; t += 2) { MLA_STEP(t, 0); MLA_STEP(t + 1, 1); }
#undef MLA_STEP
#undef MLA_LOAD
#undef MLA_WRITE
    if (hi == 0) al[r32] = l_reg;
    asm volatile("s_waitcnt lgkmcnt(0)" ::: "memory");
    const size_t orow0 = rowbase + q0 + wid * 32;
    const LAS float* alh = al + 4 * hi;
    const bf16_t* gp0 = c.PC + (orow0 + 4 * hi) * PC_LD + PC_G + h * 128 + r32; bf16_t* op0 = c.O1 + (orow0 + 4 * hi) * DM + h * 128 + r32;
#pragma unroll
    for (int dh = 0; dh < 2; ++dh) {
        float gv[2][16];
#pragma unroll
        for (int r = 0; r < 16; ++r) { const int rc = (r & 3) + 8 * (r >> 2); const bf16_t* gp = gp0 + rc * PC_LD + dh * 64; gv[0][r] = bf2f(gp[0]); gv[1][r] = bf2f(gp[32]); }
#pragma unroll
        for (int r = 0; r < 16; ++r) { const int rc = (r & 3) + 8 * (r >> 2); const float rl = 1.f / alh[rc]; bf16_t* op = op0 + rc * DM + dh * 64;
#pragma unroll
            for (int d1 = 0; d1 < 2; ++d1) { const float v = o[dh * 2 + d1][r] * rl * siluf(gv[d1][r]); const float vn = __shfl_xor(v, 1);
                if ((r32 & 1) == 0) *(unsigned*)(op + d1 * 32) = cvtpk(v, vn); } }
    }
    __syncthreads();
}
__device__ __forceinline__ void phase(const Ctx& c, unsigned char* lds) {
    const int G = gridDim.x, bx = blockIdx.x; const int vcu = (G % 8 == 0) ? (bx % 8) * (G / 8) + bx / 8 : bx;
    for (int item = vcu; item < 256; item += G) {
        const int bh = item >> 2, s_ = item & 3;
#pragma unroll 1
        for (int i = 0; i < 4; ++i) { const int qb = (i == 0) ? s_ : (i == 1) ? 7 - s_ : (i == 2) ? 8 + s_ : 15 - s_; unit(c, lds, bh >> 3, bh & 7, qb); }
    }
}
}

namespace nsa {
using namespace fa;
constexpr int KROW = 144, KBUF = 64 * KROW, VBUF = 64 * 64 * 2;
constexpr int L_K = 0, L_V = 4 * KBUF, L_AL = L_V + 4 * VBUF, L_IMP = L_AL + 8 * 64 * 4, L_SEL = L_IMP + 64 * 64 * 4, L_UNI = L_SEL + 64 * 8, L_END = L_UNI + 64;
#define NSA_QK(st) f32x16 p0, p1; qkt<4, KROW>(p0, p1, kp0 + (st) * KBUF, qr)
#define NSA_SM() float alpha; bf16x8 pa0, pa1, pa2, pa3; softmax_tile(p0, p1, m_reg, l_reg, alpha, pa0, pa1, pa2, pa3)
#define NSA_PV(st) do { rescale_o<2>(o, alpha, al, r32, hi); pv_all<2>(o, vb0 + (st) * VBUF, pa0, pa1, pa2, pa3); } while (0)
#define NSA_LOAD(kptr, vptr) do { sk = *(const u32x4*)(kptr); sv = *(const u32x4*)(vptr); } while (0)
#define NSA_WRITE(st) do { *(LAS u32x4*)(L + L_K + (st) * KBUF + kw) = sk; *(LAS u32x4*)(L + L_V + (st) * VBUF + vw) = sv; } while (0)
#define NSA_FOLD(FIRST, fval) do { if (hi == 0) al[r32] = (fval); asm volatile("s_waitcnt lgkmcnt(0)" ::: "memory"); \
        _Pragma("unroll") for (int r = 0; r < 16; ++r) { const float ff = alh[(r & 3) + 8 * (r >> 2)]; \
            if (FIRST) { ot[0][r] = o[0][r] * ff; ot[1][r] = o[1][r] * ff; } else { ot[0][r] += o[0][r] * ff; ot[1][r] += o[1][r] * ff; } } } while (0)

__device__ __forceinline__ void unit(const Ctx& c, unsigned char* lds, int b, int g, int qt) {
    int tid_ = threadIdx.x; asm volatile("" : "+v"(tid_));
    const int tid = tid_, lane = tid & 63, r32 = lane & 31, hi = lane >> 5; const int wid = __builtin_amdgcn_readfirstlane(tid >> 6);
    LAS unsigned char* L = (LAS unsigned char*)lds;
    const size_t rowbase = (size_t)b * SEQ; const int t0 = qt * 64;
    const int hh = r32 >> 3, qi = 8 * wid + (r32 & 7), head = g * 4 + hh; const int tq = t0 + qi;
    const bf16_t* parow = c.PA + (rowbase + tq) * PA_LD;
    bf16x8 qr[4];
#pragma unroll
    for (int d0 = 0; d0 < 4; ++d0) qr[d0] = *(const bf16x8*)(parow + PA_Q + head * 64 + d0 * 16 + hi * 8);
    const float g_c = sigmoidf_(bf2f(parow[PA_GL + head * 3 + 0])), g_s = sigmoidf_(bf2f(parow[PA_GL + head * 3 + 1])), g_w = sigmoidf_(bf2f(parow[PA_GL + head * 3 + 2]));
    const int skey = tid >> 3, sch = tid & 7;
    const int kw = skey * KROW + sch * 16, vw = v_st<2>(skey, sch * 8);
    const unsigned poff = (unsigned)(skey * PA_LD + sch * 8), coff = (unsigned)(skey * 64 + sch * 8);
    const bf16_t* pab = c.PA + rowbase * PA_LD;
    u32x4 sk, sv;
    const int kp0 = (int)(uintptr_t)lds + L_K + r32 * KROW + hi * 16;
    const int vb0 = (int)(uintptr_t)lds + L_V + v_rd_base(lane);
    LAS float* al = (LAS float*)(L + L_AL) + wid * 64; const LAS float* alh = al + 4 * hi;
    LAS float* IMP = (LAS float*)(L + L_IMP); LAS unsigned* SEL = (LAS unsigned*)(L + L_SEL); LAS unsigned* UNI = (LAS unsigned*)(L + L_UNI);
    f32x16 o[2], ot[2];
    float m_reg, l_reg;

    {   const int NTc = (qt >> 4) + 1;
        const bf16_t* kcb = c.KCMP + (size_t)(b * 2 + g) * 256 * 64; const bf16_t* vcb = c.VCMP + (size_t)(b * 2 + g) * 256 * 64;
        const int cl = (tq - 31) >> 4;
#pragma unroll
        for (int jt = 0; jt < 4; ++jt) if (jt < NTc) { NSA_LOAD(kcb + jt * 4096 + coff, vcb + jt * 4096 + coff); NSA_WRITE(jt); }
        __syncthreads();
        float m_c = -1e30f, l_c = 0.f;
#pragma unroll
        for (int jt = 0; jt < 4; ++jt) if (jt < NTc) {
            NSA_QK(jt);
            mask_tile(p0, p1, cl - 64 * jt - 4 * hi, 0x7fffffffu);
            float pmax = p0[0];
#pragma unroll
            for (int r = 1; r < 16; ++r) pmax = fmaxf(pmax, p0[r]);
#pragma unroll
            for (int r = 0; r < 16; ++r) pmax = fmaxf(pmax, p1[r]);
            { auto rr = __builtin_amdgcn_permlane32_swap(__float_as_uint(pmax), __float_as_uint(pmax), false, false); pmax = fmaxf(__uint_as_float(rr[0]), __uint_as_float(rr[1])); }
            const float mn = fmaxf(m_c, pmax);
            float ps = 0.f;
#pragma unroll
            for (int r = 0; r < 16; ++r) ps += __builtin_amdgcn_exp2f(p0[r] - mn) + __builtin_amdgcn_exp2f(p1[r] - mn);
            { auto rr = __builtin_amdgcn_permlane32_swap(__float_as_uint(ps), __float_as_uint(ps), false, false); ps = __uint_as_float(rr[0]) + __uint_as_float(rr[1]); }
            l_c = l_c * __builtin_amdgcn_exp2f(m_c - mn) + ps; m_c = mn;
        }
        const float inv = l_c > 0.f ? 1.f / l_c : 0.f;
        float carry = 0.f;
        o[0] = f32x16{}; o[1] = f32x16{};
#pragma unroll
        for (int jt = 0; jt < 4; ++jt) if (jt < NTc) {
            NSA_QK(jt);
            mask_tile(p0, p1, cl - 64 * jt - 4 * hi, 0x7fffffffu);
#pragma unroll
            for (int r = 0; r < 16; ++r) { p0[r] = __builtin_amdgcn_exp2f(p0[r] - m_c) * inv; p1[r] = __builtin_amdgcn_exp2f(p1[r] - m_c) * inv; }
            float x0[4], x1[4];
#pragma unroll
            for (int j = 0; j < 4; ++j) {
                { const unsigned e = __float_as_uint(p0[4 * j + 3]); auto rr = __builtin_amdgcn_permlane32_swap(e, e, false, false); x0[j] = __uint_as_float(hi ? rr[0] : rr[1]); }
                { const unsigned e = __float_as_uint(p1[4 * j + 3]); auto rr = __builtin_amdgcn_permlane32_swap(e, e, false, false); x1[j] = __uint_as_float(hi ? rr[0] : rr[1]); } }
#pragma unroll
            for (int j = 0; j < 4; ++j) {
                const float g0 = (p0[4 * j] + p0[4 * j + 1]) + (p0[4 * j + 2] + p0[4 * j + 3]);
                const float g1 = (p1[4 * j] + p1[4 * j + 1]) + (p1[4 * j + 2] + p1[4 * j + 3]);
                const float e0 = hi ? x0[j] : (j > 0 ? x0[j > 0 ? j - 1 : 0] : carry);
                const float e1 = hi ? x1[j] : (j > 0 ? x1[j > 0 ? j - 1 : 0] : x0[3]);
                float v0 = g0 + e0, v1 = g1 + e1;
                v0 += __shfl_xor(v0, 8); v0 += __shfl_xor(v0, 16); v1 += __shfl_xor(v1, 8); v1 += __shfl_xor(v1, 16);
                if (r32 < 8) { IMP[qi * 64 + 16 * jt + 2 * j + hi] = v0; IMP[qi * 64 + 16 * jt + 8 + 2 * j + hi] = v1; } }
            carry = x1[3];
            bf16x8 pa0, pa1, pa2, pa3; pack_p(p0, p1, pa0, pa1, pa2, pa3);
            pv_all<2>(o, vb0 + jt * VBUF, pa0, pa1, pa2, pa3);
        }
        NSA_FOLD(true, g_c);
    }
    __syncthreads();
    {   const int q_ = tid >> 3, sub = tid & 7;
        unsigned bits = 0u;
        if (qt < 16) { for (int e = 0; e < 8; ++e) if (sub * 8 + e <= qt) bits |= 1u << e; }
        else {
            float sc[8]; int rank[8];
#pragma unroll
            for (int e = 0; e < 8; ++e) { const int n = sub * 8 + e; const bool forced = (n == 0) || (n == qt) || (n == qt - 1); sc[e] = (n > qt) ? -1.f : (forced ? 1e4f : IMP[q_ * 64 + n]); rank[e] = 0; }
            for (int m2 = 0; m2 <= qt; ++m2) {
                const bool forced = (m2 == 0) || (m2 == qt) || (m2 == qt - 1); const float sm = forced ? 1e4f : IMP[q_ * 64 + m2];
#pragma unroll
                for (int e = 0; e < 8; ++e) rank[e] += (sm > sc[e] || (sm == sc[e] && m2 < sub * 8 + e)) ? 1 : 0;
            }
#pragma unroll
            for (int e = 0; e < 8; ++e) if (sub * 8 + e <= qt && rank[e] < 16) bits |= 1u << e;
        }
        unsigned lo = (sub < 4) ? (bits << (8 * sub)) : 0u, hi32 = (sub >= 4) ? (bits << (8 * (sub - 4))) : 0u;
        lo |= __shfl_xor(lo, 1); hi32 |= __shfl_xor(hi32, 1); lo |= __shfl_xor(lo, 2); hi32 |= __shfl_xor(hi32, 2); lo |= __shfl_xor(lo, 4); hi32 |= __shfl_xor(hi32, 4);
        if (sub == 0) { SEL[q_ * 2] = lo; SEL[q_ * 2 + 1] = hi32; }
        lo |= __shfl_xor(lo, 8); hi32 |= __shfl_xor(hi32, 8); lo |= __shfl_xor(lo, 16); hi32 |= __shfl_xor(hi32, 16); lo |= __shfl_xor(lo, 32); hi32 |= __shfl_xor(hi32, 32);
        if (lane == 0) { UNI[wid * 2] = lo; UNI[wid * 2 + 1] = hi32; }
    }
    __syncthreads();
    unsigned long long uni = 0ull;
#pragma unroll
    for (int w2 = 0; w2 < 8; ++w2) uni |= (unsigned long long)UNI[w2 * 2] | ((unsigned long long)UNI[w2 * 2 + 1] << 32);
    uni = ((unsigned long long)__builtin_amdgcn_readfirstlane((unsigned)(uni >> 32)) << 32) | (unsigned long long)__builtin_amdgcn_readfirstlane((unsigned)uni);
    const unsigned long long selm = (unsigned long long)SEL[qi * 2] | ((unsigned long long)SEL[qi * 2 + 1] << 32);

    {   m_reg = -1e30f; l_reg = 0.f; o[0] = f32x16{}; o[1] = f32x16{};
        unsigned long long rem = uni;
        int cur = __builtin_ctzll(rem); rem &= rem - 1; int st = 0;
        NSA_LOAD(pab + (size_t)cur * 64 * PA_LD + PA_KS + g * 64 + poff, pab + (size_t)cur * 64 * PA_LD + PA_VS + g * 64 + poff); NSA_WRITE(0); __syncthreads();
        for (;;) {
            const bool more = rem != 0ull; int nxt = 0;
            if (more) { nxt = __builtin_ctzll(rem); rem &= rem - 1; NSA_LOAD(pab + (size_t)nxt * 64 * PA_LD + PA_KS + g * 64 + poff, pab + (size_t)nxt * 64 * PA_LD + PA_VS + g * 64 + poff); }
            const bool on = ((selm >> cur) & 1ull) != 0ull;
            {   NSA_QK(st);
                if (cur == qt) mask_tile(p0, p1, qi - 4 * hi, 0x7fffffffu);
                if (!on) { const float NEG = -__builtin_inff();
#pragma unroll
                    for (int r = 0; r < 16; ++r) { p0[r] = NEG; p1[r] = NEG; } }
                NSA_SM();
                NSA_PV(st);
            }
            if (more) NSA_WRITE(st ^ 1);
            __syncthreads();
            if (!more) break;
            cur = nxt; st ^= 1;
        }
        NSA_FOLD(false, g_s / l_reg);
    }
    {   m_reg = -1e30f; l_reg = 0.f; o[0] = f32x16{}; o[1] = f32x16{};
        const int j0 = qt >= 8 ? 0 : 8 - qt;
        const bf16_t* wb = pab + (ptrdiff_t)(t0 - 512) * PA_LD;
        int st = 0;
        NSA_LOAD(wb + (ptrdiff_t)j0 * 64 * PA_LD + PA_KW + g * 64 + poff, wb + (ptrdiff_t)j0 * 64 * PA_LD + PA_VW + g * 64 + poff); NSA_WRITE(0); __syncthreads();
        for (int j = j0; j < 9; ++j) {
            if (j + 1 < 9) NSA_LOAD(wb + (ptrdiff_t)(j + 1) * 64 * PA_LD + PA_KW + g * 64 + poff, wb + (ptrdiff_t)(j + 1) * 64 * PA_LD + PA_VW + g * 64 + poff);
            {   NSA_QK(st);
                if (j == 0 || j == 8) mask_tile(p0, p1, qi + 512 - 64 * j - 4 * hi, 512u);
                NSA_SM();
                NSA_PV(st);
            }
            if (j + 1 < 9) NSA_WRITE(st ^ 1);
            __syncthreads();
            st ^= 1;
        }
        NSA_FOLD(false, g_w / l_reg);
    }
    {
        float gv[2][16];
#pragma unroll
        for (int r = 0; r < 16; ++r) { const int row = (r & 3) + 8 * (r >> 2) + 4 * hi; const int hd = g * 4 + (row >> 3); const size_t m = rowbase + t0 + 8 * wid + (row & 7);
            const bf16_t* gp = c.PA + m * PA_LD + PA_GA + hd * 64 + r32; gv[0][r] = bf2f(gp[0]); gv[1][r] = bf2f(gp[32]); }
#pragma unroll
        for (int r = 0; r < 16; ++r) { const int row = (r & 3) + 8 * (r >> 2) + 4 * hi; const int hd = g * 4 + (row >> 3); const size_t m = rowbase + t0 + 8 * wid + (row & 7);
            bf16_t* op = c.MIX + m * DM + hd * 64 + r32;
#pragma unroll
            for (int d0 = 0; d0 < 2; ++d0) { const float v = ot[d0][r] * siluf(gv[d0][r]); const float vn = __shfl_xor(v, 1);
                if ((r32 & 1) == 0) *(unsigned*)(op + d0 * 32) = cvtpk(v, vn); } }
    }
    __syncthreads();
}
#undef NSA_QK
#undef NSA_SM
#undef NSA_PV
#undef NSA_LOAD
#undef NSA_WRITE
#undef NSA_FOLD
__device__ __forceinline__ void phase(const Ctx& c, unsigned char* lds) {
    const int G = gridDim.x, bx = blockIdx.x; const int vcu = (G % 8 == 0) ? (bx % 8) * (G / 8) + bx / 8 : bx;
    for (int item = vcu; item < 256; item += G) {
        const int bg = item >> 4, s_ = item & 15;
#pragma unroll 1
        for (int i = 0; i < 4; ++i) { const int qt = (i == 0) ? s_ : (i == 1) ? 63 - s_ : (i == 2) ? 16 + s_ : 47 - s_; unit(c, lds, bg >> 1, bg & 1, qt); }
    }
}
}

namespace cmpr {
using namespace fa;
typedef float f32x4 __attribute__((ext_vector_type(4)));
__device__ __forceinline__ void unit(const Ctx& c, unsigned char* lds, int kv, int b, int g, int ct) {
    int tid_ = threadIdx.x; asm volatile("" : "+v"(tid_));
    const int tid = tid_, lane = tid & 63, r32 = lane & 31, hi = lane >> 5; const int wid = __builtin_amdgcn_readfirstlane(tid >> 6);
    const int nb = wid & 3, kh = wid >> 2;
    const float* pe = kv ? c.pe_v : c.pe_k;
    const bf16_t* w1t = (const bf16_t*)(c.ws + WS_W1T) + (size_t)kv * 128 * 2048 + (size_t)(nb * 32 + r32) * 2048 + 8 * hi;
    const int cidx = ct * 32 + r32;
    const int tokb = min(16 * cidx, SEQ - 32);
    const bf16_t* raw = c.PA + ((size_t)b * SEQ + tokb) * PA_LD + (kv ? PA_VC : PA_KC) + g * 64 + 8 * hi;
    LAS float* part = (LAS float*)lds;
    f32x16 acc = {};
#pragma unroll 2
    for (int l = kh * 16; l < kh * 16 + 16; ++l) {
        u32x4 rw[4], wv[4]; f32x4 pv[4][2];
#pragma unroll
        for (int q = 0; q < 4; ++q) { rw[q] = *(const u32x4*)(raw + (size_t)l * PA_LD + q * 16); wv[q] = *(const u32x4*)(w1t + l * 64 + q * 16);
            pv[q][0] = *(const f32x4*)(pe + l * 64 + q * 16 + 8 * hi); pv[q][1] = *(const f32x4*)(pe + l * 64 + q * 16 + 8 * hi + 4); }
#pragma unroll
        for (int q = 0; q < 4; ++q) {
            u32x4 bw;
#pragma unroll
            for (int e = 0; e < 4; ++e) { const float lo = __uint_as_float(rw[q][e] << 16) + pv[q][e >> 1][(e & 1) * 2], hi_ = __uint_as_float(rw[q][e] & 0xffff0000u) + pv[q][e >> 1][(e & 1) * 2 + 1]; bw[e] = cvtpk(lo, hi_); }
            acc = __builtin_amdgcn_mfma_f32_32x32x16_bf16(__builtin_bit_cast(bf16x8, wv[q]), __builtin_bit_cast(bf16x8, bw), acc, 0, 0, 0);
        }
    }
#pragma unroll
    for (int q = 0; q < 4; ++q) { f32x4 v = {acc[4 * q], acc[4 * q + 1], acc[4 * q + 2], acc[4 * q + 3]}; *(LAS f32x4*)(part + (size_t)(kh * 32 + r32) * 128 + nb * 32 + 8 * q + 4 * hi) = v; }
    __syncthreads();
    if (wid == 0) {
        const bf16_t* w2t = (const bf16_t*)(c.ws + WS_W2T) + (size_t)kv * 64 * 128 + (size_t)r32 * 128 + 8 * hi;
        f32x16 a0 = {}, a1 = {};
#pragma unroll
        for (int ks = 0; ks < 8; ++ks) {
            const LAS float* h0 = part + (size_t)r32 * 128 + ks * 16 + 8 * hi; const LAS float* h1 = h0 + 32 * 128;
            const f32x4 x0 = *(const LAS f32x4*)h0 + *(const LAS f32x4*)h1, x1 = *(const LAS f32x4*)(h0 + 4) + *(const LAS f32x4*)(h1 + 4);
            u32x4 hw; hw[0] = cvtpk(siluf(x0[0]), siluf(x0[1])); hw[1] = cvtpk(siluf(x0[2]), siluf(x0[3])); hw[2] = cvtpk(siluf(x1[0]), siluf(x1[1])); hw[3] = cvtpk(siluf(x1[2]), siluf(x1[3]));
            const bf16x8 hf = __builtin_bit_cast(bf16x8, hw);
            const bf16x8 wa = *(const bf16x8*)(w2t + ks * 16), wb = *(const bf16x8*)(w2t + 32 * 128 + ks * 16);
            a0 = __builtin_amdgcn_mfma_f32_32x32x16_bf16(wa, hf, a0, 0, 0, 0);
            a1 = __builtin_amdgcn_mfma_f32_32x32x16_bf16(wb, hf, a1, 0, 0, 0);
        }
        bf16_t* dst = (kv ? c.VCMP : c.KCMP) + ((size_t)(b * 2 + g) * 256 + cidx) * 64;
        const float2* csr = c.CS + ((size_t)b * SEQ + min(16 * cidx + 31, SEQ - 1)) * 32;
#pragma unroll
        for (int r = 0; r < 16; ++r) { const int i = (r & 3) + 8 * (r >> 2) + 4 * hi; float y0 = a0[r], y1 = a1[r];
            if (kv == 0) { const float2 cs = csr[i]; const float t0 = y0 * cs.x - y1 * cs.y, t1 = y1 * cs.x + y0 * cs.y; y0 = t0; y1 = t1; }
            if (cidx >= 255) { y0 = 0.f; y1 = 0.f; }
            dst[i] = f2bf(y0); dst[32 + i] = f2bf(y1); }
    }
    __syncthreads();
}
__device__ __forceinline__ void conv_phase(const Ctx& c) {
    const int NTH = gridDim.x * NTHR;
    for (int id = blockIdx.x * NTHR + threadIdx.x; id < 64 * (M / 16); id += NTH) {
        const int cg = id & 63, chunk = id >> 6; const int m0 = chunk * 16; const int t0 = m0 % SEQ; const int ch0 = cg * 8;
        float w0[8], w1[8], w2[8];
#pragma unroll
        for (int e = 0; e < 8; e += 4) { const float4 a = *(const float4*)(c.conv_w + ch0 + e), b_ = *(const float4*)(c.conv_w + 512 + ch0 + e), d = *(const float4*)(c.conv_w + 1024 + ch0 + e);
            w0[e] = a.x; w0[e + 1] = a.y; w0[e + 2] = a.z; w0[e + 3] = a.w; w1[e] = b_.x; w1[e + 1] = b_.y; w1[e + 2] = b_.z; w1[e + 3] = b_.w; w2[e] = d.x; w2[e + 1] = d.y; w2[e + 2] = d.z; w2[e + 3] = d.w; }
        float um2[8], um1[8];
#pragma unroll
        for (int e = 0; e < 8; ++e) { um2[e] = 0.f; um1[e] = 0.f; }
        const bf16_t* base = c.PA + (size_t)m0 * PA_LD + ch0;
        if (t0 >= 2) {
            const u32x4 c2 = *(const u32x4*)(base - 2 * PA_LD + PA_CC), h2 = *(const u32x4*)(base - 2 * PA_LD + PA_CH), c1 = *(const u32x4*)(base - PA_LD + PA_CC), h1 = *(const u32x4*)(base - PA_LD + PA_CH);
#pragma unroll
            for (int e = 0; e < 4; ++e) { um2[2 * e] = __uint_as_float(c2[e] << 16) * __uint_as_float(h2[e] << 16); um2[2 * e + 1] = __uint_as_float(c2[e] & 0xffff0000u) * __uint_as_float(h2[e] & 0xffff0000u);
                um1[2 * e] = __uint_as_float(c1[e] << 16) * __uint_as_float(h1[e] << 16); um1[2 * e + 1] = __uint_as_float(c1[e] & 0xffff0000u) * __uint_as_float(h1[e] & 0xffff0000u); }
        }
#pragma unroll 4
        for (int j = 0; j < 16; ++j) {
            const bf16_t* rp = base + (size_t)j * PA_LD;
            const u32x4 cc = *(const u32x4*)(rp + PA_CC), chh = *(const u32x4*)(rp + PA_CH), cb = *(const u32x4*)(rp + PA_CB), gb = *(const u32x4*)(rp + PA_GB);
            u32x4 ow;
#pragma unroll
            for (int e = 0; e < 4; ++e) {
                const float u0 = __uint_as_float(cc[e] << 16) * __uint_as_float(chh[e] << 16), u1 = __uint_as_float(cc[e] & 0xffff0000u) * __uint_as_float(chh[e] & 0xffff0000u);
                const float y0 = w0[2 * e] * um2[2 * e] + w1[2 * e] * um1[2 * e] + w2[2 * e] * u0, y1 = w0[2 * e + 1] * um2[2 * e + 1] + w1[2 * e + 1] * um1[2 * e + 1] + w2[2 * e + 1] * u1;
                um2[2 * e] = um1[2 * e]; um2[2 * e + 1] = um1[2 * e + 1]; um1[2 * e] = u0; um1[2 * e + 1] = u1;
                ow[e] = cvtpk(siluf(__uint_as_float(gb[e] << 16)) * __uint_as_float(cb[e] << 16) * y0, siluf(__uint_as_float(gb[e] & 0xffff0000u)) * __uint_as_float(cb[e] & 0xffff0000u) * y1);
            }
            *(u32x4*)(c.MIX + (size_t)(m0 + j) * DM + 512 + ch0) = ow;
        }
    }
}
__device__ __forceinline__ void phase(const Ctx& c, unsigned char* lds) {
    for (int item = blockIdx.x; item < 2 * BATCH * 2 * 8; item += gridDim.x) unit(c, lds, item >> 7, (item >> 4) & 7, (item >> 3) & 1, item & 7);
    conv_phase(c);
}
}

__device__ __forceinline__ int natA(int p) {
    if (p < 768) { const int T = p >> 8, q = p & 255, half = q >> 7, hh = (q & 127) >> 5, i = q & 31;
        const int base = (T == 0) ? 64 * hh : (T == 1) ? 256 + 64 * hh : (hh < 2 ? 768 + 64 * hh : 1024 + 64 * (hh - 2));
        return base + 32 * half + i; }
    if (p < 1024) return 512 + (p - 768);
    if (p < 1152) return 896 + (p - 1024);
    if (p < 1280) return p;
    if (p < 3840) return p + 24;
    if (p < 3864) return 1280 + (p - 3840);
    return -1;
}
__device__ __forceinline__ int natC(int p) {
    if (p < 512) return p;
    if (p < 1536) return p + 64;
    const int q = p - 1536;
    if (q < 32) return 512 + q;
    if (q >= 128 && q < 160) return 512 + 32 + (q - 128);
    return -1;
}
__device__ __forceinline__ int natUQ(int p) {
    if (p < 1024) return (p >> 7) * 192 + (p & 127);
    const int q = p - 1024, T = q >> 8, r = q & 255, half = r >> 7, hh = (r & 127) >> 5, i = r & 31;
    return (T * 4 + hh) * 192 + 128 + 32 * half + i;
}
__device__ __forceinline__ unsigned pk2(float lo, float hi) { return (unsigned)f2bf(lo) | ((unsigned)f2bf(hi) << 16); }
template <int MAP>
__device__ __forceinline__ void transpose_item(const float* W, int K, int Nsrc, int Ndst, bf16_t* WT, float* scr, int item, int lane) {
    const int nblk = Ndst / 32, kb = item / nblk, nb = item % nblk, k0 = 64 * kb, p0 = 32 * nb;
    const int p = p0 + (lane & 31);
    const int sc = (MAP == 0) ? natA(p) : (MAP == 1) ? natC(p) : (MAP == 3) ? natUQ(p) : p;
#pragma unroll 8
    for (int i = 0; i < 32; ++i) { const int kk = 2 * i + (lane >> 5); scr[kk * 33 + (lane & 31)] = (sc >= 0) ? W[(size_t)(k0 + kk) * Nsrc + sc] : 0.f; }
    WSYNC();
    const int c = lane & 7;
#pragma unroll
    for (int j = 0; j < 4; ++j) { const int n = (lane >> 3) + 8 * j; const float* sp = scr + (8 * c) * 33 + n;
        uint4 o; o.x = pk2(sp[0 * 33], sp[1 * 33]); o.y = pk2(sp[2 * 33], sp[3 * 33]); o.z = pk2(sp[4 * 33], sp[5 * 33]); o.w = pk2(sp[6 * 33], sp[7 * 33]);
        *(uint4*)(WT + (size_t)(p0 + n) * K + k0 + 8 * c) = o; }
    WSYNC();
}
__device__ __forceinline__ void ph0_weights(const Ctx& c, unsigned char* lds) {
    const int lane = threadIdx.x & 63, wave = threadIdx.x >> 6;
    float* scr = (float*)(lds + wave * 16384);
    const int gw = blockIdx.x * NWV + wave, NGW = gridDim.x * NWV;
    constexpr int I_A = 16 * 128, I_OA = 16 * 32, I_C = 16 * 56, I_UQ = 4 * 48, I_UKV = 4 * 64, I_OC = 16 * 32, I_W1 = 32 * 4, I_W2 = 2 * 2;
    constexpr int NITEMS = I_A + I_OA + I_C + I_UQ + I_UKV + I_OC + 2 * I_W1 + 2 * I_W2;
    for (int it = gw; it < NITEMS; it += NGW) {
        int r = it;
        if (r < I_A) { transpose_item<0>(c.a_w_in, 1024, NIN_A, 4096, (bf16_t*)(c.ws + WS_WTA), scr, r, lane); continue; } r -= I_A;
        if (r < I_OA) { transpose_item<2>(c.a_w_out, 1024, 1024, 1024, (bf16_t*)(c.ws + WS_WTOA), scr, r, lane); continue; } r -= I_OA;
        if (r < I_C) { transpose_item<1>(c.c_w_in, 1024, NIN_C, 1792, (bf16_t*)(c.ws + WS_WTC), scr, r, lane); continue; } r -= I_C;
        if (r < I_UQ) { transpose_item<3>(c.w_uq, 256, 1536, 1536, (bf16_t*)(c.ws + WS_WTUQ), scr, r, lane); continue; } r -= I_UQ;
        if (r < I_UKV) { transpose_item<2>(c.w_ukv, 256, 2048, 2048, (bf16_t*)(c.ws + WS_WTUKV), scr, r, lane); continue; } r -= I_UKV;
        if (r < I_OC) { transpose_item<2>(c.c_w_out, 1024, 1024, 1024, (bf16_t*)(c.ws + WS_WTOC), scr, r, lane); continue; } r -= I_OC;
        if (r < I_W1) { transpose_item<2>(c.w_ck1, 2048, 128, 128, (bf16_t*)(c.ws + WS_W1T), scr, r, lane); continue; } r -= I_W1;
        if (r < I_W1) { transpose_item<2>(c.w_cv1, 2048, 128, 128, (bf16_t*)(c.ws + WS_W1T) + 128 * 2048, scr, r, lane); continue; } r -= I_W1;
        if (r < I_W2) { transpose_item<2>(c.w_ck2, 128, 64, 64, (bf16_t*)(c.ws + WS_W2T), scr, r, lane); continue; } r -= I_W2;
        transpose_item<2>(c.w_cv2, 128, 64, 64, (bf16_t*)(c.ws + WS_W2T) + 64 * 128, scr, r, lane);
    }
}

__device__ __forceinline__ void ph0_prologue(const Ctx& c) {
    for (int idx = blockIdx.x * NTHR + threadIdx.x; idx < M * 32; idx += gridDim.x * NTHR) {
        const int m = idx >> 5, i = idx & 31;
        const float invf = (float)exp2(-(double)i * (13.287712379549449 / 32.0));
        const float ang = (float)c.pos[m] * invf;
        float s, co; sincos_acc(ang, s, co);
        c.CS[idx] = make_float2(co, s);
    }
    const int lane = threadIdx.x & 63, gw = blockIdx.x * NWV + (threadIdx.x >> 6), NGW = gridDim.x * NWV;
    for (int m = gw; m < M; m += NGW) rms_row_f32(c.x + (size_t)m * DM, c.a_norm, c.XN + (size_t)m * DM, lane);
}
__device__ __forceinline__ int pa_col(int n) { return n < 1280 ? n : (n < 1304 ? PA_GL + (n - 1280) : n - 24); }
__device__ __forceinline__ int pc_col(int n) { return n < 512 ? n : (n < 576 ? PC_KR + (n - 512) : n - 64); }

__device__ __forceinline__ void ph2_rope_a(const Ctx& c) {
    for (size_t idx = (size_t)blockIdx.x * NTHR + threadIdx.x; idx < (size_t)M * 12 * 32; idx += (size_t)gridDim.x * NTHR) {
        const int i = (int)(idx & 31); const size_t r = idx >> 5; const int slot = (int)(r % 12); const int m = (int)(r / 12);
        const int base = slot < 8 ? PA_Q + slot * 64 : (slot < 10 ? PA_KS + (slot - 8) * 64 : PA_KW + (slot - 10) * 64);
        const float sc = slot < 8 ? QSCALE_A : 1.f;
        bf16_t* p = c.PA + (size_t)m * PA_LD + base + i;
        const float x1 = bf2f(p[0]), x2 = bf2f(p[32]);
        const float2 cs = c.CS[(size_t)m * 32 + i];
        p[0] = f2bf((x1 * cs.x - x2 * cs.y) * sc); p[32] = f2bf((x2 * cs.x + x1 * cs.y) * sc);
    }
}

__device__ __forceinline__ void ph3_compress(const Ctx& c, unsigned char* lds) {
    float* blk = (float*)lds;
    float* part = blk + 8 * 2048;
    float* hid = part + 4 * 8 * 128;
    float* outp = hid + 8 * 128;
    float* outs = outp + 8 * 8 * 64;
    const int tid = threadIdx.x;
    for (int item = blockIdx.x; item < 2 * BATCH * 2 * 32; item += gridDim.x) {
        const int ct = item & 31, g = (item >> 5) & 1, b = (item >> 6) & 7, kv = item >> 9;
        const float* pe = kv ? c.pe_v : c.pe_k; const float* w1 = kv ? c.w_cv1 : c.w_ck1; const float* w2 = kv ? c.w_cv2 : c.w_ck2;
        const int col0 = (kv ? PA_VC : PA_KC) + g * 64;
        __syncthreads();
        for (int e = tid; e < 8 * 2048; e += NTHR) {
            const int ci = e >> 11, k = e & 2047, l = k >> 6, d = k & 63; const int cidx = ct * 8 + ci;
            float v = 0.f;
            if (cidx < 255) v = bf2f(c.PA[(size_t)(b * SEQ + 16 * cidx + l) * PA_LD + col0 + d]) + pe[l * 64 + d];
            blk[e] = v;
        }
        __syncthreads();
        {   const int j = tid & 127, pt = tid >> 7;
            float acc[8];
#pragma unroll
            for (int ci = 0; ci < 8; ++ci) acc[ci] = 0.f;
            for (int k = pt * 512; k < pt * 512 + 512; ++k) {
                const float w = w1[(size_t)k * 128 + j];
#pragma unroll
                for (int ci = 0; ci < 8; ++ci) acc[ci] = fmaf(blk[ci * 2048 + k], w, acc[ci]);
            }
#pragma unroll
            for (int ci = 0; ci < 8; ++ci) part[(pt * 8 + ci) * 128 + j] = acc[ci];
        }
        __syncthreads();
        for (int e = tid; e < 8 * 128; e += NTHR) { const int ci = e >> 7, j = e & 127; const float s = (part[(0 * 8 + ci) * 128 + j] + part[(1 * 8 + ci) * 128 + j]) + (part[(2 * 8 + ci) * 128 + j] + part[(3 * 8 + ci) * 128 + j]); hid[e] = siluf(s); }
        __syncthreads();
        {   const int d = tid & 63, pt = tid >> 6;
            float acc[8];
#pragma unroll
            for (int ci = 0; ci < 8; ++ci) acc[ci] = 0.f;
            for (int j = pt * 16; j < pt * 16 + 16; ++j) {
                const float w = w2[j * 64 + d];
#pragma unroll
                for (int ci = 0; ci < 8; ++ci) acc[ci] = fmaf(hid[ci * 128 + j], w, acc[ci]);
            }
#pragma unroll
            for (int ci = 0; ci < 8; ++ci) outp[(pt * 8 + ci) * 64 + d] = acc[ci];
        }
        __syncthreads();
        {   const int ci = tid >> 6, d = tid & 63; float s = 0.f;
#pragma unroll
            for (int pt = 0; pt < 8; ++pt) s += outp[(pt * 8 + ci) * 64 + d];
            outs[ci * 64 + d] = s; }
        __syncthreads();
        {   const int ci = tid >> 6, d = tid & 63; const int cidx = ct * 8 + ci;
            float v = outs[ci * 64 + d];
            if (kv == 0 && cidx < 255) {
                const int i = d & 31; const float2 cs = c.CS[(size_t)(b * SEQ + 16 * cidx + 31) * 32 + i];
                const float x1 = outs[ci * 64 + i], x2 = outs[ci * 64 + i + 32];
                v = (d < 32) ? (x1 * cs.x - x2 * cs.y) : (x2 * cs.x + x1 * cs.y);
            }
            if (cidx >= 255) v = 0.f;
            bf16_t* dst = (kv ? c.VCMP : c.KCMP) + ((size_t)(b * 2 + g) * 256 + cidx) * 64 + d;
            *dst = f2bf(v);
        }
    }
    __syncthreads();
}

__device__ __forceinline__ float dot64(const bf16_t* krow, const float* q) {
    float s = 0.f;
#pragma unroll
    for (int ch = 0; ch < 8; ++ch) {
        const uint4 v = *(const uint4*)(krow + ch * 8);
        const unsigned w[4] = {v.x, v.y, v.z, v.w};
#pragma unroll
        for (int e = 0; e < 4; ++e) { s = fmaf(__uint_as_float(w[e] << 16), q[ch * 8 + 2 * e], s); s = fmaf(__uint_as_float(w[e] & 0xffff0000u), q[ch * 8 + 2 * e + 1], s); }
    }
    return s;
}

__device__ __forceinline__ void ph4_nsa(const Ctx& c, unsigned char* lds) {
    const int lane = threadIdx.x & 63, wave = threadIdx.x >> 6;
    float* wq = (float*)(lds + wave * 12288);
    float* wp = wq + 64;
    float* wpc = wp + 1024;
    float* wres = wpc + 1024;
    const int gw = blockIdx.x * NWV + wave, NGW = gridDim.x * NWV;
    for (int item = gw; item < M * 2; item += NGW) {
        const int g = item & 1, m = item >> 1; const int b = m / SEQ, t = m % SEQ;
        const bf16_t* parow = c.PA + (size_t)m * PA_LD;
        const bf16_t* pab = c.PA + (size_t)b * SEQ * PA_LD;
        const bf16_t* kc = c.KCMP + (size_t)(b * 2 + g) * 256 * 64; const bf16_t* vc = c.VCMP + (size_t)(b * 2 + g) * 256 * 64;
        const int nvalid = t >= 31 ? min((t - 31) / 16 + 1, 255) : 0;
        for (int hh = 0; hh < 4; ++hh) {
            const int head = g * 4 + hh;
            WSYNC(); wq[lane] = bf2f(parow[PA_Q + head * 64 + lane]); WSYNC();
            float s[4]; float mx = -INFINITY;
#pragma unroll
            for (int jj = 0; jj < 4; ++jj) { const int ci = lane + 64 * jj; s[jj] = (ci < nvalid) ? dot64(kc + (size_t)ci * 64, wq) : -INFINITY; mx = fmaxf(mx, s[jj]); }
            mx = wave_max(mx);
            float sum = 0.f;
#pragma unroll
            for (int jj = 0; jj < 4; ++jj) { s[jj] = (nvalid > 0) ? exp2f(s[jj] - mx) : 0.f; sum += s[jj]; }
            sum = wave_sum(sum);
            const float inv = nvalid > 0 ? 1.f / sum : 0.f;
#pragma unroll
            for (int jj = 0; jj < 4; ++jj) wpc[hh * 256 + lane + 64 * jj] = s[jj] * inv;
            WSYNC();
            float o = 0.f;
            for (int ci = 0; ci < nvalid; ++ci) o = fmaf(wpc[hh * 256 + ci], bf2f(vc[(size_t)ci * 64 + lane]), o);
            wres[(hh * 3 + 0) * 64 + lane] = o;
        }
        unsigned long long selmask;
        {   const int n = lane; float imp = 0.f;
            const int c_lo = max(4 * n - 1, 0), c_hi = min(4 * n + 3, 254);
            for (int hh = 0; hh < 4; ++hh) for (int ci = c_lo; ci <= c_hi; ++ci) imp += wpc[hh * 256 + ci];
            const bool bv = (64 * n <= t); const int cur = t >> 6;
            const bool forced = (n == 0) || (n == cur) || (n == cur - 1);
            const float sc = bv ? (forced ? 1e4f : imp) : -1.f;
            int rank = 0;
            for (int mm = 0; mm < 64; ++mm) { const float o = __shfl(sc, mm); rank += (o > sc || (o == sc && mm < n)) ? 1 : 0; }
            selmask = __ballot(rank < 16 && bv);
        }
        for (int hh = 0; hh < 4; ++hh) {
            const int head = g * 4 + hh;
            WSYNC(); wq[lane] = bf2f(parow[PA_Q + head * 64 + lane]); WSYNC();
            {   unsigned long long sm = selmask; int slot = 0; float mx = -INFINITY;
                while (sm) { const int n = __builtin_ctzll(sm); sm &= sm - 1; const int tok = n * 64 + lane;
                    const float s = (tok <= t) ? dot64(pab + (size_t)tok * PA_LD + PA_KS + g * 64, wq) : -INFINITY;
                    wp[slot * 64 + lane] = s; mx = fmaxf(mx, s); ++slot; }
                mx = wave_max(mx);
                float sum = 0.f;
                for (int sl = 0; sl < slot; ++sl) { const float p = exp2f(wp[sl * 64 + lane] - mx); wp[sl * 64 + lane] = p; sum += p; }
                sum = wave_sum(sum); WSYNC();
                float o = 0.f; sm = selmask; slot = 0;
                while (sm) { const int n = __builtin_ctzll(sm); sm &= sm - 1;
                    const int kmax = min(63, t - n * 64);
                    for (int kk = 0; kk <= kmax; ++kk) o = fmaf(wp[slot * 64 + kk], bf2f(pab[(size_t)(n * 64 + kk) * PA_LD + PA_VS + g * 64 + lane]), o);
                    ++slot; }
                wres[(hh * 3 + 1) * 64 + lane] = o / sum; }
            WSYNC();
            {   float mx = -INFINITY;
                for (int j = 0; j < 8; ++j) { const int kp = t - 511 + 64 * j + lane;
                    const float s = (kp >= 0) ? dot64(pab + (size_t)kp * PA_LD + PA_KW + g * 64, wq) : -INFINITY;
                    wp[j * 64 + lane] = s; mx = fmaxf(mx, s); }
                mx = wave_max(mx);
                float sum = 0.f;
                for (int j = 0; j < 8; ++j) { const float p = exp2f(wp[j * 64 + lane] - mx); wp[j * 64 + lane] = p; sum += p; }
                sum = wave_sum(sum); WSYNC();
                float o = 0.f;
                const int k_lo = max(0, 511 - t);
                for (int kk = k_lo; kk < 512; ++kk) o = fmaf(wp[kk], bf2f(pab[(size_t)(t - 511 + kk) * PA_LD + PA_VW + g * 64 + lane]), o);
                wres[(hh * 3 + 2) * 64 + lane] = o / sum; }
        }
        for (int hh = 0; hh < 4; ++hh) {
            const int head = g * 4 + hh;
            const float g0 = sigmoidf_(bf2f(parow[PA_GL + head * 3 + 0])), g1 = sigmoidf_(bf2f(parow[PA_GL + head * 3 + 1])), g2 = sigmoidf_(bf2f(parow[PA_GL + head * 3 + 2]));
            const float o = g0 * wres[(hh * 3 + 0) * 64 + lane] + g1 * wres[(hh * 3 + 1) * 64 + lane] + g2 * wres[(hh * 3 + 2) * 64 + lane];
            const float ga = bf2f(parow[PA_GA + head * 64 + lane]);
            c.MIX[(size_t)m * DM + head * 64 + lane] = f2bf(siluf(ga) * o);
        }
    }
}

__device__ __forceinline__ void ph5_conv(const Ctx& c) {
    for (size_t idx = (size_t)blockIdx.x * NTHR + threadIdx.x; idx < (size_t)M * 512; idx += (size_t)gridDim.x * NTHR) {
        const int ch = (int)(idx & 511); const int m = (int)(idx >> 9); const int t = m % SEQ;
        const bf16_t* r0 = c.PA + (size_t)m * PA_LD;
        float y = c.conv_w[2 * 512 + ch] * bf2f(r0[PA_CC + ch]) * bf2f(r0[PA_CH + ch]);
        if (t >= 1) { const bf16_t* r1 = r0 - PA_LD; y += c.conv_w[1 * 512 + ch] * bf2f(r1[PA_CC + ch]) * bf2f(r1[PA_CH + ch]); }
        if (t >= 2) { const bf16_t* r2 = r0 - 2 * PA_LD; y += c.conv_w[0 * 512 + ch] * bf2f(r2[PA_CC + ch]) * bf2f(r2[PA_CH + ch]); }
        c.MIX[(size_t)m * DM + 512 + ch] = f2bf(siluf(bf2f(r0[PA_GB + ch])) * bf2f(r0[PA_CB + ch]) * y);
    }
}

__device__ __forceinline__ void ph7_norm1(const Ctx& c) {
    const int lane = threadIdx.x & 63, gw = blockIdx.x * NWV + (threadIdx.x >> 6), NGW = gridDim.x * NWV;
    for (int m = gw; m < M; m += NGW) rms_row_f32(c.out + (size_t)m * DM, c.c_norm, c.XN + (size_t)m * DM, lane);
}
__device__ __forceinline__ void ph_final(const Ctx& c) {
    const int lane = threadIdx.x & 63, gw = blockIdx.x * NWV + (threadIdx.x >> 6), NGW = gridDim.x * NWV;
    for (int m = gw; m < M; m += NGW) {
        float* xr = c.out + (size_t)m * DM;
        float4 v[4]; float s = 0.f;
#pragma unroll
        for (int j = 0; j < 4; ++j) { v[j] = *(const float4*)(xr + 4 * lane + 256 * j); s += (v[j].x * v[j].x + v[j].y * v[j].y) + (v[j].z * v[j].z + v[j].w * v[j].w); }
        const float rstd = 1.f / sqrtf(wave_sum(s) * (1.f / DM) + RMS_EPS);
#pragma unroll
        for (int j = 0; j < 4; ++j) { const float4 gg = *(const float4*)(c.final_norm + 4 * lane + 256 * j);
            float4 o; o.x = v[j].x * rstd * gg.x; o.y = v[j].y * rstd * gg.y; o.z = v[j].z * rstd * gg.z; o.w = v[j].w * rstd * gg.w;
            *(float4*)(xr + 4 * lane + 256 * j) = o; }
    }
}

__device__ __forceinline__ void ph9_lat_norm(const Ctx& c) {
    const int lane = threadIdx.x & 63, gw = blockIdx.x * NWV + (threadIdx.x >> 6), NGW = gridDim.x * NWV;
    for (int m = gw; m < M; m += NGW) {
        const bf16_t* r = c.PC + (size_t)m * PC_LD;
#pragma unroll
        for (int w = 0; w < 2; ++w) {
            const ushort4 v = *(const ushort4*)(r + (w ? PC_CKV : PC_CQ) + 4 * lane);
            const float a0 = bf2f(v.x), a1 = bf2f(v.y), a2 = bf2f(v.z), a3 = bf2f(v.w);
            const float rstd = 1.f / sqrtf(wave_sum(a0 * a0 + a1 * a1 + a2 * a2 + a3 * a3) * (1.f / 256.f) + RMS_EPS);
            const float4 gg = *(const float4*)((w ? c.kv_norm : c.q_norm) + 4 * lane);
            ushort4 o; o.x = f2bf(a0 * rstd * gg.x); o.y = f2bf(a1 * rstd * gg.y); o.z = f2bf(a2 * rstd * gg.z); o.w = f2bf(a3 * rstd * gg.w);
            *(ushort4*)((w ? c.CKVN : c.CQN) + (size_t)m * 256 + 4 * lane) = o;
        }
        if (lane < 32) {
            const float x1 = bf2f(r[PC_KR + lane]), x2 = bf2f(r[PC_KR + lane + 32]); const float2 cs = c.CS[(size_t)m * 32 + lane];
            c.KPE[(size_t)m * 64 + lane] = f2bf(x1 * cs.x - x2 * cs.y); c.KPE[(size_t)m * 64 + lane + 32] = f2bf(x2 * cs.x + x1 * cs.y);
        }
    }
}
__device__ __forceinline__ void ph11_rope_q1(const Ctx& c) {
    for (size_t idx = (size_t)blockIdx.x * NTHR + threadIdx.x; idx < (size_t)M * 8 * 96; idx += (size_t)gridDim.x * NTHR) {
        const int e = (int)(idx % 96); const size_t r = idx / 96; const int h = (int)(r & 7); const int m = (int)(r >> 3);
        bf16_t* q = c.Q1 + (size_t)m * 1536 + h * 192;
        if (e < 64) { q[e] = f2bf(bf2f(q[e]) * QSCALE_C); q[e + 64] = f2bf(bf2f(q[e + 64]) * QSCALE_C); }
        else { const int i = e - 64; const float2 cs = c.CS[(size_t)m * 32 + i];
            const float x1 = bf2f(q[128 + i]), x2 = bf2f(q[160 + i]);
            q[128 + i] = f2bf((x1 * cs.x - x2 * cs.y) * QSCALE_C); q[160 + i] = f2bf((x2 * cs.x + x1 * cs.y) * QSCALE_C); }
    }
}
__device__ __forceinline__ void ph12_mla(const Ctx& c, unsigned char* lds) {
    const int lane = threadIdx.x & 63, wave = threadIdx.x >> 6;
    float* wq = (float*)(lds + wave * 2048);
    float* wp = wq + 192;
    const int gw = blockIdx.x * NWV + wave, NGW = gridDim.x * NWV;
    for (int item = gw; item < M * 8; item += NGW) {
        const int h = item & 7, m = item >> 3; const int b = m / SEQ, t = m % SEQ;
        WSYNC();
        const bf16_t* qrow = c.Q1 + (size_t)m * 1536 + h * 192;
        wq[lane] = bf2f(qrow[lane]); wq[64 + lane] = bf2f(qrow[64 + lane]); wq[128 + lane] = bf2f(qrow[128 + lane]);
        WSYNC();
        float mrun = -1e30f, l = 0.f, o0 = 0.f, o1 = 0.f;
        const bf16_t* kvb = c.KV1 + (size_t)b * SEQ * 2048 + h * 256; const bf16_t* kpb = c.KPE + (size_t)b * SEQ * 64;
        for (int k0 = 0; k0 <= t; k0 += 64) {
            const int key = k0 + lane;
            float s = -INFINITY;
            if (key <= t) { const bf16_t* kr = kvb + (size_t)key * 2048; s = dot64(kr, wq) + dot64(kr + 64, wq + 64) + dot64(kpb + (size_t)key * 64, wq + 128); }
            const float cm = wave_max(s);
            const float mn = fmaxf(mrun, cm); const float alpha = exp2f(mrun - mn); mrun = mn;
            const float p = exp2f(s - mn);
            l = l * alpha + wave_sum(p); o0 *= alpha; o1 *= alpha;
            WSYNC(); wp[lane] = p; WSYNC();
            const int kmax = min(63, t - k0);
            for (int kk = 0; kk <= kmax; ++kk) { const bf16_t* vr = kvb + (size_t)(k0 + kk) * 2048 + 128; const float pp = wp[kk]; o0 = fmaf(pp, bf2f(vr[lane]), o0); o1 = fmaf(pp, bf2f(vr[64 + lane]), o1); }
        }
        const float inv = 1.f / l;
        const bf16_t* gr = c.PC + (size_t)m * PC_LD + PC_G + h * 128;
        c.O1[(size_t)m * DM + h * 128 + lane] = f2bf(siluf(bf2f(gr[lane])) * o0 * inv);
        c.O1[(size_t)m * DM + h * 128 + 64 + lane] = f2bf(siluf(bf2f(gr[64 + lane])) * o1 * inv);
    }
}

constexpr int NPHASE = 15;
__global__ void __launch_bounds__(NTHR, 2) mk_fwd(Args a) {
    extern __shared__ __attribute__((aligned(16))) unsigned char lds[];
    Ctx c;
    c.x = (const float*)a.in[0]; c.pos = (const int*)a.in[1]; c.a_norm = (const float*)a.in[2]; c.a_w_in = (const float*)a.in[3]; c.pe_k = (const float*)a.in[4]; c.pe_v = (const float*)a.in[5];
    c.w_ck1 = (const float*)a.in[6]; c.w_ck2 = (const float*)a.in[7]; c.w_cv1 = (const float*)a.in[8]; c.w_cv2 = (const float*)a.in[9]; c.conv_w = (const float*)a.in[10]; c.a_w_out = (const float*)a.in[11];
    c.c_norm = (const float*)a.in[12]; c.c_w_in = (const float*)a.in[13]; c.q_norm = (const float*)a.in[14]; c.kv_norm = (const float*)a.in[15]; c.w_uq = (const float*)a.in[16]; c.w_ukv = (const float*)a.in[17];
    c.c_w_out = (const float*)a.in[18]; c.final_norm = (const float*)a.in[19];
    c.out = a.out; c.ws = a.ws;
    c.CS = (float2*)(a.ws + WS_CS); c.KCMP = (bf16_t*)(a.ws + WS_KCMP); c.VCMP = (bf16_t*)(a.ws + WS_VCMP); c.XN = (bf16_t*)(a.ws + WS_XN); c.PA = (bf16_t*)(a.ws + WS_PA);
    c.MIX = (bf16_t*)(a.ws + WS_MIX); c.PC = (bf16_t*)(a.ws + WS_PC); c.Q1 = (bf16_t*)(a.ws + WS_Q1); c.KV1 = (bf16_t*)(a.ws + WS_KV1); c.CQN = (bf16_t*)(a.ws + WS_CQN);
    c.CKVN = (bf16_t*)(a.ws + WS_CKVN); c.KPE = (bf16_t*)(a.ws + WS_KPE); c.O1 = (bf16_t*)(a.ws + WS_O1);

    volatile LAS unsigned* misc = (volatile LAS unsigned*)((LAS unsigned char*)lds + (LDS_BYTES - 64));
    if (threadIdx.x < 16) misc[threadIdx.x] = 0u;
    __syncthreads();
    XcdBarrier bar; bar.bar = (unsigned*)(a.ws + WS_CTL) + 4096; bar.x = 0; bar.st = misc;
    const bool multi = (a.hi - a.lo) > 1;
    if (multi) bar = xcd_barrier_post((unsigned*)(a.ws + WS_CTL) + 4096, misc);

#ifndef PROBE_DUP
#define PROBE_DUP -1
#endif
#define PHASE(k, ...) if (a.lo <= (k) && (k) < a.hi) { __VA_ARGS__; if ((k) == PROBE_DUP) { xcd_barrier(bar); __VA_ARGS__; } if ((k) + 1 < a.hi) xcd_barrier(bar); }
    LAS unsigned char* ldsl = (LAS unsigned char*)lds;
    PHASE(0, { ph0_weights(c, lds); ph0_prologue(c); })
    PHASE(1, { pg8::Gemm g{c.XN, (const bf16_t*)(c.ws + WS_WTA), M, 4096, 1024}; pg8::StaticOrder S; S.init(M, 4096, gridDim.x, blockIdx.x);
               pg8::EpiPA E{c.PA, c.CS}; pg8::gemm_phase<pg8::EpiPA, pg8::StaticOrder, true, true>(ldsl, g, S, E); })
    PHASE(3, cmpr::phase(c, lds))
    PHASE(4, nsa::phase(c, lds))
    PHASE(6, { pg8::Gemm g{c.MIX, (const bf16_t*)(c.ws + WS_WTOA), M, 1024, 1024}; pg8::StaticOrder S; S.init(M, 1024, gridDim.x, blockIdx.x);
               pg8::EpiRes2 E{c.x, c.out, c.XN, c.c_norm, (float*)(c.ws + WS_STAT1)}; pg8::gemm_phase<pg8::EpiRes2, pg8::StaticOrder, true, true>(ldsl, g, S, E); })
    PHASE(8, { pg8::Gemm g{c.XN, (const bf16_t*)(c.ws + WS_WTC), M, 1792, 1024}; pg8::StaticOrder S; S.init(M, 1792, gridDim.x, blockIdx.x);
               pg8::EpiPC2 E{c.PC, c.CQN, c.CKVN, c.KPE, c.q_norm, c.kv_norm, (const float*)(c.ws + WS_STAT1), (float*)(c.ws + WS_STAT2), c.CS};
               pg8::gemm_phase<pg8::EpiPC2, pg8::StaticOrder, true, true>(ldsl, g, S, E); })
    PHASE(10, { { pg8::Gemm g{c.CQN, (const bf16_t*)(c.ws + WS_WTUQ), M, 1536, 256}; pg8::StaticOrder S; S.init(M, 1536, gridDim.x, blockIdx.x);
                  pg8::EpiQ1 E{c.Q1, (const float*)(c.ws + WS_STAT2), c.CS}; pg8::gemm_phase<pg8::EpiQ1, pg8::StaticOrder, true, true>(ldsl, g, S, E); }
                __syncthreads();
                { pg8::Gemm g{c.CKVN, (const bf16_t*)(c.ws + WS_WTUKV), M, 2048, 256}; pg8::StaticOrder S; S.init(M, 2048, gridDim.x, blockIdx.x);
                  pg8::EpiKV1 E{c.KV1, (const float*)(c.ws + WS_STAT2)}; pg8::gemm_phase<pg8::EpiKV1, pg8::StaticOrder, true, true>(ldsl, g, S, E); } })
    PHASE(12, mla::phase(c, lds))
    PHASE(13, { pg8::Gemm g{c.O1, (const bf16_t*)(c.ws + WS_WTOC), M, 1024, 1024}; pg8::StaticOrder S; S.init(M, 1024, gridDim.x, blockIdx.x);
               pg8::EpiRes E{c.out, c.out}; pg8::gemm_phase<pg8::EpiRes, pg8::StaticOrder, true, true>(ldsl, g, S, E); })
    PHASE(14, ph_final(c))
#undef PHASE
}

extern "C" void kernel_launch(void* const* d_in, const int* in_sizes, int n_in, void* d_out, int out_size, void* d_ws, size_t ws_size, hipStream_t stream) {
    static int grid = 0;
    if (grid == 0) {
        if (n_in != 20 || in_sizes[0] != M * DM || out_size != M * DM || ws_size < WS_END) {
            fprintf(stderr, "kernel_launch: unexpected shapes (n_in %d, in0 %d, out %d, ws %zu)\n", n_in, n_in > 0 ? in_sizes[0] : -1, out_size, ws_size); grid = -1; return; }
        int dev = 0, cus = 0;
        if (hipGetDevice(&dev) != hipSuccess || hipDeviceGetAttribute(&cus, hipDeviceAttributeMultiprocessorCount, dev) != hipSuccess || cus <= 0) { grid = -1; return; }
        if (hipFuncSetAttribute((const void*)mk_fwd, hipFuncAttributeMaxDynamicSharedMemorySize, LDS_BYTES) != hipSuccess) { fprintf(stderr, "kernel_launch: hipFuncSetAttribute failed\n"); grid = -1; return; }
        (void)hipGetLastError();
        grid = cus;
    }
    if (grid < 0) return;
    (void)hipMemsetAsync((char*)d_ws + WS_CTL, 0, CTL_BYTES, stream);
    Args a{};
    for (int i = 0; i < 20; ++i) a.in[i] = d_in[i];
    a.out = (float*)d_out; a.ws = (unsigned char*)d_ws;
#if MK_ONE_LAUNCH
    a.lo = 0; a.hi = NPHASE;
    hipLaunchKernelGGL(mk_fwd, dim3(grid), dim3(NTHR), LDS_BYTES, stream, a);
#else
    for (int ph = 0; ph < NPHASE; ++ph) { a.lo = ph; a.hi = ph + 1; hipLaunchKernelGGL(mk_fwd, dim3(grid), dim3(NTHR), LDS_BYTES, stream, a); }
#endif
}
```
